# Optimizing an MI355X kernel written in HIP

```python
import math
import jax, jax.numpy as jnp
from jax import lax
import numpy as np

D_MODEL = 1024
BATCH = 2
SEQ = 8192
DEPTH = 2

HEAD_DIM = 64
MIX_W = D_MODEL
MIX_HALF = MIX_W // 2
FOX_HEADS = MIX_HALF // HEAD_DIM
FOX_W = FOX_HEADS * HEAD_DIM
SSD_HD = HEAD_DIM
SSD_HEADS = MIX_HALF // SSD_HD
SSD_W = SSD_HEADS * SSD_HD
SSD_GROUPS = 2
SSD_STATE = 64
SSD_CONV = 4
SSD_CONV_DIM = SSD_W + 2 * SSD_GROUPS * SSD_STATE
SSD_CHUNK = 128
SB_HEADS = MIX_HALF // HEAD_DIM
SB_W = SB_HEADS * HEAD_DIM
GLA_HEADS = 4
GLA_DV = MIX_HALF // GLA_HEADS
GLA_DK = GLA_DV // 2
GLA_RANK = 16
GLA_CHUNK = 16
GLA_GATE_NORM = 16.0
D_FF = 4 * D_MODEL
Q_BLOCK = 128
EPS = 1e-5
N_EVEN = (DEPTH + 1) // 2
N_ODD = DEPTH // 2

AB_SPLITS = (FOX_W, FOX_W, FOX_W, FOX_HEADS, SSD_W, SSD_CONV_DIM, SSD_HEADS)
AB_IN = sum(AB_SPLITS)
CD_SPLITS = (SB_W, SB_W, SB_W, GLA_HEADS * GLA_DK, GLA_HEADS * GLA_DK,
             GLA_HEADS * GLA_DV, GLA_RANK, GLA_HEADS * GLA_DV)
CD_IN = sum(CD_SPLITS)

kernel_name = 'hybrid_fox_ssd_stickbreak_gla_trunk'


def _split(h, sizes):
    idx = [int(i) for i in np.cumsum(sizes)[:-1]]
    return jnp.split(h, idx, axis=-1)


def rms_norm(x, w):
    xf = x.astype(jnp.float32)
    y = xf * lax.rsqrt(jnp.mean(xf * xf, axis=-1, keepdims=True) + EPS)
    return (y * w.astype(jnp.float32)).astype(x.dtype)


def _to_heads(t, n_heads):
    b, l, _ = t.shape
    return t.reshape(b, l, n_heads, -1).transpose(0, 2, 1, 3)


def _from_heads(t):
    b, h, l, d = t.shape
    return t.transpose(0, 2, 1, 3).reshape(b, l, h * d)


def _gather_blocks(out):
    nb, b, h, q, d = out.shape
    return out.transpose(1, 2, 0, 3, 4).reshape(b, h, nb * q, d)


def forgetting_attention(q, k, v, log_f):
    L = q.shape[2]
    scale = HEAD_DIM ** -0.5
    F = jnp.cumsum(log_f, axis=-1)
    key_pos = jnp.arange(L)

    def block(i):
        start = i * Q_BLOCK
        qb = lax.dynamic_slice_in_dim(q, start, Q_BLOCK, axis=2)
        Fb = lax.dynamic_slice_in_dim(F, start, Q_BLOCK, axis=2)
        s = jnp.einsum('bhqd,bhkd->bhqk', qb, k).astype(jnp.float32) * scale
        s = s + Fb[..., :, None] - F[..., None, :]
        qpos = start + jnp.arange(Q_BLOCK)
        mask = qpos[:, None] >= key_pos[None, :]
        p = jax.nn.softmax(jnp.where(mask, s, -jnp.inf), axis=-1)
        return jnp.einsum('bhqk,bhkd->bhqd', p.astype(v.dtype), v)

    return _gather_blocks(lax.map(block, jnp.arange(L // Q_BLOCK)))


def stick_breaking_attention(q, k, v):
    L = q.shape[2]
    scale = HEAD_DIM ** -0.5
    key_pos = jnp.arange(L)

    def block(i):
        start = i * Q_BLOCK
        qb = lax.dynamic_slice_in_dim(q, start, Q_BLOCK, axis=2)
        z = jnp.einsum('bhqd,bhkd->bhqk', qb, k).astype(jnp.float32) * scale
        qpos = start + jnp.arange(Q_BLOCK)
        mask = key_pos[None, :] < qpos[:, None]
        log_beta = jax.nn.log_sigmoid(z)
        log_rest = jnp.where(mask, jax.nn.log_sigmoid(-z), 0.0)
        suffix = lax.cumsum(log_rest, axis=3, reverse=True) - log_rest
        a = jnp.where(mask, jnp.exp(log_beta + suffix), 0.0)
        return jnp.einsum('bhqk,bhkd->bhqd', a.astype(v.dtype), v)

    return _gather_blocks(lax.map(block, jnp.arange(L // Q_BLOCK)))


def causal_depthwise_conv(x, w, b):
    c = x.shape[-1]
    y = lax.conv_general_dilated(
        x, w[:, None, :].astype(x.dtype), window_strides=(1,),
        padding=[(w.shape[0] - 1, 0)], dimension_numbers=('NWC', 'WIO', 'NWC'),
        feature_group_count=c)
    return y + b.astype(x.dtype)


def _chunk_recurrence(decay, local):
    def step(s, inp):
        d, loc = inp
        return s * d + loc, s
    init = jnp.zeros_like(local[:, 0])
    _, prev = lax.scan(step, init, (jnp.moveaxis(decay, 1, 0), jnp.moveaxis(local, 1, 0)))
    return jnp.moveaxis(prev, 0, 1)


def ssd_chunked(x, dt, A, Bm, Cm, d_skip):
    b, L, H, P = x.shape
    rep = H // SSD_GROUPS
    Q = SSD_CHUNK
    nc = L // Q
    Bh = jnp.repeat(Bm, rep, axis=2).reshape(b, nc, Q, H, SSD_STATE)
    Ch = jnp.repeat(Cm, rep, axis=2).reshape(b, nc, Q, H, SSD_STATE)
    xc = x.reshape(b, nc, Q, H, P)
    dtc = dt.reshape(b, nc, Q, H)
    xdt = xc * dtc[..., None]
    a_cum = jnp.cumsum(dtc * A, axis=2)
    causal = (jnp.arange(Q)[:, None] >= jnp.arange(Q)[None, :])[:, :, None]
    seg = a_cum[:, :, :, None, :] - a_cum[:, :, None, :, :]
    lmat = jnp.exp(jnp.where(causal, seg, -jnp.inf))
    scores = jnp.einsum('bclhn,bcshn->bclsh', Ch, Bh) * lmat
    y_diag = jnp.einsum('bclsh,bcshp->bclhp', scores, xdt)
    decay_to_end = jnp.exp(a_cum[:, :, -1:, :] - a_cum)
    local = jnp.einsum('bcshn,bcsh,bcshp->bchpn', Bh, decay_to_end, xdt)
    chunk_decay = jnp.exp(a_cum[:, :, -1, :])[..., None, None]
    prev = _chunk_recurrence(chunk_decay, local)
    y_off = jnp.einsum('bclhn,bchpn,bclh->bclhp', Ch, prev, jnp.exp(a_cum))
    y = y_diag + y_off + d_skip[None, None, None, :, None] * xc
    return y.reshape(b, L, H, P)


def gla_chunked(q, k, v, log_a):
    b, L, H, K = q.shape
    V = v.shape[-1]
    Q = GLA_CHUNK
    nc = L // Q
    qc = q.reshape(b, nc, Q, H, K)
    kc = k.reshape(b, nc, Q, H, K)
    vc = v.reshape(b, nc, Q, H, V)
    g = jnp.cumsum(log_a.reshape(b, nc, Q, H, K), axis=2)
    causal = (jnp.arange(Q)[:, None] >= jnp.arange(Q)[None, :])[:, :, None, None]
    rel = g[:, :, :, None] - g[:, :, None, :]
    decay = jnp.exp(jnp.where(causal, rel, -jnp.inf))
    attn = jnp.einsum('bcthk,bcshk,bctshk->bctsh', qc, kc, decay)
    o_intra = jnp.einsum('bctsh,bcshv->bcthv', attn, vc)
    g_last = g[:, :, -1]
    k_dec = kc * jnp.exp(g_last[:, :, None] - g)
    local = jnp.einsum('bcshk,bcshv->bchkv', k_dec, vc)
    prev = _chunk_recurrence(jnp.exp(g_last)[..., None], local)
    o_inter = jnp.einsum('bcthk,bchkv->bcthv', qc * jnp.exp(g), prev)
    return (o_intra + o_inter).reshape(b, L, H, V)


def mixer_fox_ssd(h, w_in, f_bias, conv_w, conv_b, dt_bias, a_log, d_skip, ssd_norm_w, w_out):
    b, L, _ = h.shape
    proj = h @ w_in
    fq, fk, fv, f_logit, z, xbc, dt_raw = _split(proj, AB_SPLITS)
    log_f = jax.nn.log_sigmoid((f_logit + f_bias).astype(jnp.float32)).transpose(0, 2, 1)
    y_fox = forgetting_attention(_to_heads(fq, FOX_HEADS), _to_heads(fk, FOX_HEADS),
                                 _to_heads(fv, FOX_HEADS), log_f)
    y_fox = _from_heads(y_fox)
    xbc = jax.nn.silu(causal_depthwise_conv(xbc, conv_w, conv_b))
    xs, bm, cm = _split(xbc, (SSD_W, SSD_GROUPS * SSD_STATE, SSD_GROUPS * SSD_STATE))
    dt = jax.nn.softplus((dt_raw + dt_bias).astype(jnp.float32))
    A = -jnp.exp(a_log.astype(jnp.float32))
    y = ssd_chunked(xs.reshape(b, L, SSD_HEADS, SSD_HD), dt, A,
                    bm.reshape(b, L, SSD_GROUPS, SSD_STATE),
                    cm.reshape(b, L, SSD_GROUPS, SSD_STATE), d_skip.astype(jnp.float32))
    y = y.reshape(b, L, SSD_W) * jax.nn.silu(z.astype(jnp.float32))
    y = rms_norm(y.reshape(b, L, SSD_GROUPS, SSD_W // SSD_GROUPS),
                 ssd_norm_w.reshape(SSD_GROUPS, SSD_W // SSD_GROUPS)).reshape(b, L, SSD_W)
    cat = jnp.concatenate([y_fox.astype(h.dtype), y.astype(h.dtype)], axis=-1)
    return cat @ w_out


def mixer_sb_gla(h, w_in, gate_w2, gate_b, gla_norm_w, w_out):
    b, L, _ = h.shape
    proj = h @ w_in
    sq, sk, sv, gq, gk, gv, g_low, gr = _split(proj, CD_SPLITS)
    y_sb = _from_heads(stick_breaking_attention(_to_heads(sq, SB_HEADS), _to_heads(sk, SB_HEADS),
                                                _to_heads(sv, SB_HEADS)))
    gate_logits = (g_low @ gate_w2 + gate_b).astype(jnp.float32).reshape(b, L, GLA_HEADS, GLA_DK)
    log_a = jax.nn.log_sigmoid(gate_logits) / GLA_GATE_NORM
    o = gla_chunked(gq.reshape(b, L, GLA_HEADS, GLA_DK) * (GLA_DK ** -0.5),
                    gk.reshape(b, L, GLA_HEADS, GLA_DK),
                    gv.reshape(b, L, GLA_HEADS, GLA_DV), log_a)
    o = rms_norm(o, gla_norm_w).reshape(b, L, GLA_HEADS * GLA_DV) * jax.nn.silu(gr)
    cat = jnp.concatenate([y_sb.astype(h.dtype), o.astype(h.dtype)], axis=-1)
    return cat @ w_out


def squared_relu_mlp(h, w_up, w_down):
    u = jax.nn.relu(h @ w_up)
    return (u * u) @ w_down


def setup_inputs(seed: int = 0) -> dict:
    key = jax.random.key(seed)
    ks = jax.random.split(key, 20)
    f32 = jnp.float32

    def nrm(k, shape, fan):
        return jax.random.normal(k, shape, f32) * (fan ** -0.5)

    def gain(k, shape):
        return 1.0 + 0.02 * jax.random.normal(k, shape, f32)

    x = jax.random.normal(ks[0], (BATCH, SEQ, D_MODEL), f32)
    norm_mix = gain(ks[1], (DEPTH, D_MODEL))
    norm_mlp = gain(ks[2], (DEPTH, D_MODEL))
    norm_final = gain(ks[3], (D_MODEL,))
    w_in_ab = nrm(ks[4], (N_EVEN, D_MODEL, AB_IN), D_MODEL)
    fox_f_bias = jax.random.uniform(ks[5], (N_EVEN, FOX_HEADS), f32, 1.0, 4.0)
    ssd_conv_w = nrm(ks[6], (N_EVEN, SSD_CONV, SSD_CONV_DIM), SSD_CONV)
    ssd_conv_b = 0.02 * jax.random.normal(ks[7], (N_EVEN, SSD_CONV_DIM), f32)
    dt0 = jnp.exp(jax.random.uniform(ks[8], (N_EVEN, SSD_HEADS), f32,
                                     math.log(1e-3), math.log(1e-1)))
    ssd_dt_bias = dt0 + jnp.log(-jnp.expm1(-dt0))
    ssd_a_log = jnp.log(jax.random.uniform(ks[9], (N_EVEN, SSD_HEADS), f32, 1.0, 16.0))
    ssd_d = gain(ks[10], (N_EVEN, SSD_HEADS))
    ssd_norm = gain(ks[11], (N_EVEN, SSD_W))
    w_out_ab = nrm(ks[12], (N_EVEN, MIX_W, D_MODEL), MIX_W)
    w_in_cd = nrm(ks[13], (N_ODD, D_MODEL, CD_IN), D_MODEL)
    gla_gate_w2 = nrm(ks[14], (N_ODD, GLA_RANK, GLA_HEADS * GLA_DK), GLA_RANK)
    gla_gate_b = 0.02 * jax.random.normal(ks[15], (N_ODD, GLA_HEADS * GLA_DK), f32)
    gla_norm = gain(ks[16], (N_ODD, GLA_DV))
    w_out_cd = nrm(ks[17], (N_ODD, MIX_W, D_MODEL), MIX_W)
    w_mlp_up = nrm(ks[18], (DEPTH, D_MODEL, D_FF), D_MODEL)
    w_mlp_down = nrm(ks[19], (DEPTH, D_FF, D_MODEL), D_FF)
    return {'x': x, 'norm_mix': norm_mix, 'norm_mlp': norm_mlp, 'norm_final': norm_final,
            'w_in_ab': w_in_ab, 'fox_f_bias': fox_f_bias, 'ssd_conv_w': ssd_conv_w,
            'ssd_conv_b': ssd_conv_b, 'ssd_dt_bias': ssd_dt_bias, 'ssd_a_log': ssd_a_log,
            'ssd_d': ssd_d, 'ssd_norm': ssd_norm, 'w_out_ab': w_out_ab,
            'w_in_cd': w_in_cd, 'gla_gate_w2': gla_gate_w2, 'gla_gate_b': gla_gate_b,
            'gla_norm': gla_norm, 'w_out_cd': w_out_cd,
            'w_mlp_up': w_mlp_up, 'w_mlp_down': w_mlp_down}


def reference(x, norm_mix, norm_mlp, norm_final, w_in_ab, fox_f_bias, ssd_conv_w, ssd_conv_b,
              ssd_dt_bias, ssd_a_log, ssd_d, ssd_norm, w_out_ab, w_in_cd, gla_gate_w2,
              gla_gate_b, gla_norm, w_out_cd, w_mlp_up, w_mlp_down):
    h = x
    for i in range(DEPTH):
        j = i // 2
        u = rms_norm(h, norm_mix[i])
        if i % 2 == 0:
            mix = mixer_fox_ssd(u, w_in_ab[j], fox_f_bias[j], ssd_conv_w[j], ssd_conv_b[j],
                                ssd_dt_bias[j], ssd_a_log[j], ssd_d[j], ssd_norm[j], w_out_ab[j])
        else:
            mix = mixer_sb_gla(u, w_in_cd[j], gla_gate_w2[j], gla_gate_b[j], gla_norm[j],
                               w_out_cd[j])
        h = h + mix.astype(h.dtype)
        u = rms_norm(h, norm_mlp[i])
        h = h + squared_relu_mlp(u, w_mlp_up[i], w_mlp_down[i]).astype(h.dtype)
    return rms_norm(h, norm_final)
```

```cpp
#include <hip/hip_runtime.h>
#include <cstdio>
#include <cstdint>

typedef unsigned short bf16;
typedef unsigned v4u __attribute__((ext_vector_type(4)));
typedef float f32x4 __attribute__((ext_vector_type(4)));

constexpr int BATCH = 2, T = 8192, D = 1024, M = BATCH * T, FF = 4096;
constexpr int NH = 8, HD = 64;
constexpr int AB_IN = 2832, CD_IN = 3088;
constexpr int NAB = 3072, NCD = 3328;
constexpr float EPS = 1e-5f;
constexpr float LOG2E = 1.4426950408889634f;
constexpr float C2 = 0.125f * LOG2E;

constexpr size_t MiB = 1u << 20;
constexpr size_t WS_CTL = 0;
constexpr size_t WS_SSQ = 1 * MiB;
constexpr size_t WS_WAB = 2 * MiB;
constexpr size_t WS_WOA = 8 * MiB;
constexpr size_t WS_WU0 = 10 * MiB;
constexpr size_t WS_WD0 = 18 * MiB;
constexpr size_t WS_WCD = 26 * MiB;
constexpr size_t WS_WOC = 33 * MiB;
constexpr size_t WS_WU1 = 35 * MiB;
constexpr size_t WS_WD1 = 43 * MiB;
constexpr size_t WS_HB = 52 * MiB;
constexpr size_t WS_TMP = 52 * MiB;
constexpr size_t WS_Q = 84 * MiB, WS_K = 100 * MiB, WS_V = 116 * MiB;
constexpr size_t WS_Z = 132 * MiB;
constexpr size_t WS_XBC = 148 * MiB;
constexpr size_t WS_XC = 172 * MiB;
constexpr size_t WS_GR = 164 * MiB;
constexpr size_t WS_GLOW = 180 * MiB;
constexpr size_t WS_CAT = 196 * MiB;
constexpr size_t WS_LA = 228 * MiB;
constexpr size_t WS_FD = 244 * MiB;
constexpr size_t WS_FL = 246 * MiB;
constexpr size_t WS_U = 84 * MiB;
constexpr size_t WS_END = 256 * MiB;

struct Bufs {
    const float* in[20];
    float* h;
    unsigned char* ws;
};
__device__ __forceinline__ float* ws_f(const Bufs& b, size_t off) { return (float*)(b.ws + off); }
__device__ __forceinline__ bf16* ws_b(const Bufs& b, size_t off) { return (bf16*)(b.ws + off); }

enum { I_X = 0, I_NMIX, I_NMLP, I_NFIN, I_WAB, I_FBIAS, I_CONVW, I_CONVB, I_DTB, I_ALOG, I_SSD_D, I_SSDN, I_WOA, I_WCD, I_GW2, I_GB, I_GLAN, I_WOC, I_WUP, I_WDN };

__device__ __forceinline__ unsigned f2bf(float f) { unsigned u = __builtin_bit_cast(unsigned, f); return (u + 0x7fffu + ((u >> 16) & 1u)) >> 16; }
__device__ __forceinline__ float bf2f(unsigned short b) { return __builtin_bit_cast(float, (unsigned)b << 16); }
__device__ __forceinline__ float softplus_f(float x) { return fmaxf(x, 0.f) + log1pf(__expf(-fabsf(x))); }
__device__ __forceinline__ float logsig_f(float x) { return fminf(x, 0.f) - log1pf(__expf(-fabsf(x))); }
__device__ __forceinline__ float silu_f(float x) { return x / (1.f + __expf(-x)); }
__device__ __forceinline__ float row_rstd(const float* ssq, int row) {
    const f32x4* p = (const f32x4*)(ssq + (size_t)row * 16);
    f32x4 a = p[0], b = p[1], c = p[2], d = p[3];
    float s = ((a.x + a.y) + (a.z + a.w)) + ((b.x + b.y) + (b.z + b.w)) + ((c.x + c.y) + (c.z + c.w)) + ((d.x + d.y) + (d.z + d.w));
    return 1.0f / sqrtf(s * (1.0f / D) + EPS);
}
__device__ __forceinline__ size_t qkv_off(int row, int head, int d) { const int b = row / T, t = row % T; return ((size_t)(b * NH + head) * T + t) * HD + d; }

__device__ __forceinline__ int src_col_ab(int n) { if (n < 1536) return n; if (n < 2816) return n + 8; if (n < 2824) return n - 1280; if (n < 2832) return n; return -1; }
__device__ __forceinline__ int src_col_cd(int n) { if (n < 2560) return n; if (n < 3072) return n + 16; if (n < 3088) return n - 512; return -1; }

__global__ void k_wprep(const float* W, const float* gain, bf16* WT, int K, int Nsrc, int Ndst, int mode) {
    const size_t idx = (size_t)blockIdx.x * blockDim.x + threadIdx.x;
    if (idx >= (size_t)K * Ndst) return;
    const int n = (int)(idx % Ndst), k = (int)(idx / Ndst);
    const int s = mode == 0 ? n : (mode == 1 ? src_col_ab(n) : src_col_cd(n));
    float v = 0.f;
    if (s >= 0) v = W[(size_t)k * Nsrc + s] * (gain ? gain[k] : 1.f);
    WT[(size_t)n * K + k] = (bf16)f2bf(v);
}

__global__ void k_init(Bufs B) {
    const int row = blockIdx.x * 4 + (threadIdx.x >> 6), lane = threadIdx.x & 63;
    const float* x = B.in[I_X] + (size_t)row * D; float* h = B.h + (size_t)row * D; bf16* hb = ws_b(B, WS_HB) + (size_t)row * D;
    float s = 0.f;
    for (int j = lane; j < D; j += 64) { const float v = x[j]; h[j] = v; hb[j] = (bf16)f2bf(v); s += v * v; }
    for (int o = 32; o > 0; o >>= 1) s += __shfl_xor(s, o);
    float* q = ws_f(B, WS_SSQ) + (size_t)row * 16;
    if (lane < 16) q[lane] = lane == 0 ? s : 0.f;
}
__global__ void k_ssq(Bufs B) {
    const int row = blockIdx.x * 4 + (threadIdx.x >> 6), lane = threadIdx.x & 63;
    const float* h = B.h + (size_t)row * D; float s = 0.f;
    for (int j = lane; j < D; j += 64) { const float v = h[j]; s += v * v; }
    for (int o = 32; o > 0; o >>= 1) s += __shfl_xor(s, o);
    float* q = ws_f(B, WS_SSQ) + (size_t)row * 16;
    if (lane < 16) q[lane] = lane == 0 ? s : 0.f;
}

enum { MODE_PROJ0 = 0, MODE_PROJ1 = 1, MODE_RES = 2, MODE_UP = 3 };
template <int MODE> __device__ __forceinline__ void store_out(const Bufs& B, int row, int n, float acc, float rstd) {
    if (MODE == MODE_PROJ0) {
        const float v = acc * rstd;
        if (n < 512) ws_b(B, WS_Q)[qkv_off(row, n >> 6, n & 63)] = (bf16)f2bf(v * C2);
        else if (n < 1024) ws_b(B, WS_K)[qkv_off(row, (n - 512) >> 6, n & 63)] = (bf16)f2bf(v);
        else if (n < 1536) ws_b(B, WS_V)[qkv_off(row, (n - 1024) >> 6, n & 63)] = (bf16)f2bf(v);
        else if (n < 2048) ws_b(B, WS_Z)[(size_t)row * 512 + n - 1536] = (bf16)f2bf(v);
        else if (n < 2816) ws_b(B, WS_XBC)[(size_t)row * 768 + n - 2048] = (bf16)f2bf(v);
        else if (n < 2832) ws_f(B, WS_FD)[(size_t)row * 16 + n - 2816] = v;
    } else if (MODE == MODE_PROJ1) {
        const float v = acc * rstd;
        if (n < 512) ws_b(B, WS_Q)[qkv_off(row, n >> 6, n & 63)] = (bf16)f2bf(v * C2);
        else if (n < 1024) ws_b(B, WS_K)[qkv_off(row, (n - 512) >> 6, n & 63)] = (bf16)f2bf(v);
        else if (n < 1536) ws_b(B, WS_V)[qkv_off(row, (n - 1024) >> 6, n & 63)] = (bf16)f2bf(v);
        else if (n < 1792) ws_b(B, WS_XBC)[(size_t)row * 256 + n - 1536] = (bf16)f2bf(v * 0.125f);
        else if (n < 2048) ws_b(B, WS_XBC + 8 * MiB)[(size_t)row * 256 + n - 1792] = (bf16)f2bf(v);
        else if (n < 2560) ws_b(B, WS_Z)[(size_t)row * 512 + n - 2048] = (bf16)f2bf(v);
        else if (n < 3072) ws_b(B, WS_GR)[(size_t)row * 512 + n - 2560] = (bf16)f2bf(v);
        else if (n < 3088) ws_f(B, WS_GLOW)[(size_t)row * 16 + n - 3072] = v;
    } else if (MODE == MODE_RES) {
        const size_t o = (size_t)row * D + n; const float v = B.h[o] + acc; B.h[o] = v; ws_b(B, WS_HB)[o] = (bf16)f2bf(v);
    } else {
        const float r = fmaxf(acc, 0.f) * rstd; ws_b(B, WS_U)[(size_t)row * FF + n] = (bf16)f2bf(r * r);
    }
}
template <int MODE> __global__ void __launch_bounds__(256) k_gemm_naive(Bufs B, const bf16* A, const bf16* WT, int K, int N) {
    __shared__ float As[32][65], Bs[32][65];
    const int tx = threadIdx.x & 15, ty = threadIdx.x >> 4, row0 = blockIdx.y * 64, col0 = blockIdx.x * 64;
    float acc[4][4];
#pragma unroll
    for (int i = 0; i < 4; ++i)
#pragma unroll
        for (int j = 0; j < 4; ++j) acc[i][j] = 0.f;
    for (int k0 = 0; k0 < K; k0 += 32) {
#pragma unroll
        for (int i = 0; i < 8; ++i) { const int idx = threadIdx.x + i * 256, r = idx >> 5, kk = idx & 31;
            As[kk][r] = bf2f(A[(size_t)(row0 + r) * K + k0 + kk]); Bs[kk][r] = bf2f(WT[(size_t)(col0 + r) * K + k0 + kk]); }
        __syncthreads();
#pragma unroll
        for (int kk = 0; kk < 32; ++kk) { float a[4], b[4];
#pragma unroll
            for (int i = 0; i < 4; ++i) { a[i] = As[kk][ty * 4 + i]; b[i] = Bs[kk][tx * 4 + i]; }
#pragma unroll
            for (int i = 0; i < 4; ++i)
#pragma unroll
                for (int j = 0; j < 4; ++j) acc[i][j] += a[i] * b[j]; }
        __syncthreads();
    }
#pragma unroll
    for (int i = 0; i < 4; ++i) { const int row = row0 + ty * 4 + i; const float rstd = (MODE == MODE_RES) ? 1.f : row_rstd(ws_f(B, WS_SSQ), row);
#pragma unroll
        for (int j = 0; j < 4; ++j) store_out<MODE>(B, row, col0 + tx * 4 + j, acc[i][j], rstd); }
}

__global__ void k_fox_scan(Bufs B) {
    const int bh = threadIdx.x; if (bh >= 16) return; const int b = bh >> 3, h = bh & 7;
    const float* fd = ws_f(B, WS_FD); float* fl = ws_f(B, WS_FL) + (size_t)bh * T; const float bias = B.in[I_FBIAS][h];
    float s = 0.f;
    for (int t = 0; t < T; ++t) { s += logsig_f(fd[(size_t)(b * T + t) * 16 + h] + bias); fl[t] = s * LOG2E; }
}
__global__ void __launch_bounds__(64) k_fox_naive(Bufs B) {
    const int bh = blockIdx.y, b = bh >> 3, h = bh & 7, t0 = blockIdx.x * 64, t = t0 + threadIdx.x;
    const bf16* Q = ws_b(B, WS_Q) + ((size_t)bh * T + t) * HD; const bf16* Kp = ws_b(B, WS_K) + (size_t)bh * T * HD; const bf16* Vp = ws_b(B, WS_V) + (size_t)bh * T * HD;
    const float* fl = ws_f(B, WS_FL) + (size_t)bh * T;
    float q[64], acc[64];
#pragma unroll
    for (int d = 0; d < 64; ++d) { q[d] = bf2f(Q[d]); acc[d] = 0.f; }
    float m = -1e30f, l = 0.f; const float fq = fl[t];
    for (int k = 0; k <= t0 + 63; ++k) {
        if (k <= t) {
            const v4u* kr = (const v4u*)(Kp + (size_t)k * HD); float s = 0.f;
#pragma unroll
            for (int c = 0; c < 8; ++c) { const v4u w = kr[c];
#pragma unroll
                for (int e = 0; e < 4; ++e) { s += q[c * 8 + 2 * e] * __builtin_bit_cast(float, w[e] << 16) + q[c * 8 + 2 * e + 1] * __builtin_bit_cast(float, w[e] & 0xffff0000u); } }
            s += fq - fl[k];
            const float mn = fmaxf(m, s), sc = exp2f(m - mn), p = exp2f(s - mn); m = mn; l = l * sc + p;
            const v4u* vr = (const v4u*)(Vp + (size_t)k * HD);
#pragma unroll
            for (int c = 0; c < 8; ++c) { const v4u w = vr[c];
#pragma unroll
                for (int e = 0; e < 4; ++e) { acc[c * 8 + 2 * e] = acc[c * 8 + 2 * e] * sc + p * __builtin_bit_cast(float, w[e] << 16); acc[c * 8 + 2 * e + 1] = acc[c * 8 + 2 * e + 1] * sc + p * __builtin_bit_cast(float, w[e] & 0xffff0000u); } }
        }
    }
    bf16* o = ws_b(B, WS_CAT) + (size_t)(b * T + t) * D + h * HD; const float il = 1.f / l;
#pragma unroll
    for (int d = 0; d < 64; ++d) o[d] = (bf16)f2bf(acc[d] * il);
}
__global__ void k_conv_naive(Bufs B) {
    const size_t idx = (size_t)blockIdx.x * blockDim.x + threadIdx.x; if (idx >= (size_t)M * 768) return;
    const int c = (int)(idx % 768), row = (int)(idx / 768), t = row % T;
    const bf16* x = ws_b(B, WS_XBC); const float* w = B.in[I_CONVW]; float s = B.in[I_CONVB][c];
#pragma unroll
    for (int k = 0; k < 4; ++k) { const int tt = t - 3 + k; if (tt >= 0) s += w[k * 768 + c] * bf2f(x[(size_t)(row - 3 + k) * 768 + c]); }
    ws_b(B, WS_XC)[idx] = (bf16)f2bf(silu_f(s));
}
__global__ void __launch_bounds__(64) k_ssd_naive(Bufs B) {
    const int bh = blockIdx.x, b = bh >> 3, h = bh & 7, g = h >> 2, p = threadIdx.x;
    const bf16* xc = ws_b(B, WS_XC); const float* fd = ws_f(B, WS_FD); const bf16* z = ws_b(B, WS_Z); float* yg = ws_f(B, WS_TMP);
    const float A = -__expf(B.in[I_ALOG][h]), dtb = B.in[I_DTB][h], Dk = B.in[I_SSD_D][h];
    float S[64];
#pragma unroll
    for (int n = 0; n < 64; ++n) S[n] = 0.f;
    for (int t = 0; t < T; ++t) {
        const size_t row = (size_t)b * T + t;
        const float dt = softplus_f(fd[row * 16 + 8 + h] + dtb), dec = __expf(dt * A), x = bf2f(xc[row * 768 + h * 64 + p]), xdt = x * dt;
        const v4u* Br = (const v4u*)(xc + row * 768 + 512 + g * 64); const v4u* Cr = (const v4u*)(xc + row * 768 + 640 + g * 64);
        float y = 0.f;
#pragma unroll
        for (int c = 0; c < 8; ++c) { const v4u bw = Br[c], cw = Cr[c];
#pragma unroll
            for (int e = 0; e < 4; ++e) {
                const int n = c * 8 + 2 * e;
                S[n] = S[n] * dec + xdt * __builtin_bit_cast(float, bw[e] << 16); y += S[n] * __builtin_bit_cast(float, cw[e] << 16);
                S[n + 1] = S[n + 1] * dec + xdt * __builtin_bit_cast(float, bw[e] & 0xffff0000u); y += S[n + 1] * __builtin_bit_cast(float, cw[e] & 0xffff0000u); } }
        y += Dk * x;
        yg[row * 512 + h * 64 + p] = y * silu_f(bf2f(z[row * 512 + h * 64 + p]));
    }
}
__global__ void k_ssd_norm(Bufs B) {
    const int wv = blockIdx.x * 4 + (threadIdx.x >> 6), lane = threadIdx.x & 63, row = wv >> 1, g = wv & 1;
    const float* yg = ws_f(B, WS_TMP) + (size_t)row * 512 + g * 256; float v[4]; float s = 0.f;
#pragma unroll
    for (int j = 0; j < 4; ++j) { v[j] = yg[lane + 64 * j]; s += v[j] * v[j]; }
    for (int o = 32; o > 0; o >>= 1) s += __shfl_xor(s, o);
    const float r = 1.0f / sqrtf(s * (1.f / 256.f) + EPS); const float* w = B.in[I_SSDN] + g * 256;
    bf16* o = ws_b(B, WS_CAT) + (size_t)row * D + 512 + g * 256;
#pragma unroll
    for (int j = 0; j < 4; ++j) o[lane + 64 * j] = (bf16)f2bf(v[j] * r * w[lane + 64 * j]);
}

__global__ void __launch_bounds__(64) k_sb_naive(Bufs B) {
    const int bh = blockIdx.y, b = bh >> 3, h = bh & 7, t0 = blockIdx.x * 64, t = t0 + threadIdx.x;
    const bf16* Q = ws_b(B, WS_Q) + ((size_t)bh * T + t) * HD; const bf16* Kp = ws_b(B, WS_K) + (size_t)bh * T * HD; const bf16* Vp = ws_b(B, WS_V) + (size_t)bh * T * HD;
    float q[64], acc[64];
#pragma unroll
    for (int d = 0; d < 64; ++d) { q[d] = bf2f(Q[d]); acc[d] = 0.f; }
    float R = 0.f;
    for (int k = t0 + 62; k >= 0; --k) {
        if (k < t) {
            const v4u* kr = (const v4u*)(Kp + (size_t)k * HD); float s = 0.f;
#pragma unroll
            for (int c = 0; c < 8; ++c) { const v4u w = kr[c];
#pragma unroll
                for (int e = 0; e < 4; ++e) { s += q[c * 8 + 2 * e] * __builtin_bit_cast(float, w[e] << 16) + q[c * 8 + 2 * e + 1] * __builtin_bit_cast(float, w[e] & 0xffff0000u); } }
            const float sp2 = fmaxf(s, 0.f) + log2f(1.f + exp2f(-fabsf(s)));
            const float a = exp2f(s - sp2 + R); R -= sp2;
            const v4u* vr = (const v4u*)(Vp + (size_t)k * HD);
#pragma unroll
            for (int c = 0; c < 8; ++c) { const v4u w = vr[c];
#pragma unroll
                for (int e = 0; e < 4; ++e) { acc[c * 8 + 2 * e] += a * __builtin_bit_cast(float, w[e] << 16); acc[c * 8 + 2 * e + 1] += a * __builtin_bit_cast(float, w[e] & 0xffff0000u); } }
        }
    }
    bf16* o = ws_b(B, WS_CAT) + (size_t)(b * T + t) * D + h * HD;
#pragma unroll
    for (int d = 0; d < 64; ++d) o[d] = (bf16)f2bf(acc[d]);
}
__global__ void k_gla_gate(Bufs B) {
    const size_t idx = (size_t)blockIdx.x * blockDim.x + threadIdx.x; if (idx >= (size_t)M * 256) return;
    const int c = (int)(idx & 255), row = (int)(idx >> 8);
    const float* gl = ws_f(B, WS_GLOW) + (size_t)row * 16; const float* w2 = B.in[I_GW2]; float s = B.in[I_GB][c];
#pragma unroll
    for (int r = 0; r < 16; ++r) s += gl[r] * w2[r * 256 + c];
    ws_f(B, WS_LA)[idx] = logsig_f(s) * (1.f / 16.f);
}
__global__ void __launch_bounds__(128) k_gla_naive(Bufs B) {
    const int bh = blockIdx.x, b = bh >> 2, h = bh & 3, v = threadIdx.x;
    const bf16* gq = ws_b(B, WS_XBC); const bf16* gk = ws_b(B, WS_XBC + 8 * MiB); const bf16* gv = ws_b(B, WS_Z); const float* la = ws_f(B, WS_LA); float* og = ws_f(B, WS_TMP);
    float S[64];
#pragma unroll
    for (int k = 0; k < 64; ++k) S[k] = 0.f;
    for (int t = 0; t < T; ++t) {
        const size_t row = (size_t)b * T + t;
        const float vv = bf2f(gv[row * 512 + h * 128 + v]);
        const v4u* qr = (const v4u*)(gq + row * 256 + h * 64); const v4u* kr = (const v4u*)(gk + row * 256 + h * 64); const f32x4* ar = (const f32x4*)(la + row * 256 + h * 64);
        float o = 0.f;
#pragma unroll
        for (int c = 0; c < 8; ++c) { const v4u qw = qr[c], kw = kr[c]; const f32x4 a0 = ar[2 * c], a1 = ar[2 * c + 1];
            const float av[8] = {a0.x, a0.y, a0.z, a0.w, a1.x, a1.y, a1.z, a1.w};
#pragma unroll
            for (int e = 0; e < 4; ++e) {
                const int k = c * 8 + 2 * e;
                S[k] = S[k] * __expf(av[2 * e]) + vv * __builtin_bit_cast(float, kw[e] << 16); o += S[k] * __builtin_bit_cast(float, qw[e] << 16);
                S[k + 1] = S[k + 1] * __expf(av[2 * e + 1]) + vv * __builtin_bit_cast(float, kw[e] & 0xffff0000u); o += S[k + 1] * __builtin_bit_cast(float, qw[e] & 0xffff0000u); } }
        og[row * 512 + h * 128 + v] = o;
    }
}
__global__ void k_gla_norm(Bufs B) {
    const int wv = blockIdx.x * 4 + (threadIdx.x >> 6), lane = threadIdx.x & 63, row = wv >> 2, h = wv & 3;
    const float* og = ws_f(B, WS_TMP) + (size_t)row * 512 + h * 128; const float v0 = og[lane], v1 = og[lane + 64];
    float s = v0 * v0 + v1 * v1;
    for (int o = 32; o > 0; o >>= 1) s += __shfl_xor(s, o);
    const float r = 1.0f / sqrtf(s * (1.f / 128.f) + EPS); const float* w = B.in[I_GLAN];
    const bf16* gr = ws_b(B, WS_GR) + (size_t)row * 512 + h * 128; bf16* o = ws_b(B, WS_CAT) + (size_t)row * D + 512 + h * 128;
    o[lane] = (bf16)f2bf(v0 * r * w[lane] * silu_f(bf2f(gr[lane]))); o[lane + 64] = (bf16)f2bf(v1 * r * w[lane + 64] * silu_f(bf2f(gr[lane + 64])));
}
__global__ void k_final(Bufs B) {
    const int row = blockIdx.x * 4 + (threadIdx.x >> 6), lane = threadIdx.x & 63;
    float* h = B.h + (size_t)row * D; float v[16]; float s = 0.f;
#pragma unroll
    for (int j = 0; j < 16; ++j) { v[j] = h[lane + 64 * j]; s += v[j] * v[j]; }
    for (int o = 32; o > 0; o >>= 1) s += __shfl_xor(s, o);
    const float r = 1.0f / sqrtf(s * (1.f / D) + EPS); const float* w = B.in[I_NFIN];
#pragma unroll
    for (int j = 0; j < 16; ++j) h[lane + 64 * j] = v[j] * r * w[lane + 64 * j];
}

extern "C" void kernel_launch(void* const* d_in, const int* in_sizes, int n_in, void* d_out, int out_size, void* d_ws, size_t ws_size, hipStream_t stream) {
    if (n_in != 20 || out_size != M * D || ws_size < WS_END) { fprintf(stderr, "kernel_launch: unexpected shapes n_in %d out %d ws %zu\n", n_in, out_size, ws_size); return; }
    Bufs B{};
    for (int i = 0; i < 20; ++i) B.in[i] = (const float*)d_in[i];
    B.h = (float*)d_out; B.ws = (unsigned char*)d_ws;
    unsigned char* ws = B.ws;
    auto wprep = [&](const float* W, const float* gain, size_t off, int K, int Nsrc, int Ndst, int mode) {
        const size_t n = (size_t)K * Ndst; k_wprep<<<dim3((unsigned)((n + 255) / 256)), 256, 0, stream>>>(W, gain, (bf16*)(ws + off), K, Nsrc, Ndst, mode); };
    const float* nmix = B.in[I_NMIX]; const float* nmlp = B.in[I_NMLP];
    wprep(B.in[I_WAB], nmix, WS_WAB, D, AB_IN, NAB, 1);
    wprep(B.in[I_WOA], nullptr, WS_WOA, D, D, D, 0);
    wprep(B.in[I_WUP], nmlp, WS_WU0, D, FF, FF, 0);
    wprep(B.in[I_WDN], nullptr, WS_WD0, FF, D, D, 0);
    wprep(B.in[I_WCD], nmix + D, WS_WCD, D, CD_IN, NCD, 2);
    wprep(B.in[I_WOC], nullptr, WS_WOC, D, D, D, 0);
    wprep(B.in[I_WUP] + (size_t)D * FF, nmlp + D, WS_WU1, D, FF, FF, 0);
    wprep(B.in[I_WDN] + (size_t)FF * D, nullptr, WS_WD1, FF, D, D, 0);
    k_init<<<M / 4, 256, 0, stream>>>(B);
    const bf16* HB = (const bf16*)(ws + WS_HB); const bf16* CAT = (const bf16*)(ws + WS_CAT); const bf16* U = (const bf16*)(ws + WS_U);
    k_gemm_naive<MODE_PROJ0><<<dim3(NAB / 64, M / 64), 256, 0, stream>>>(B, HB, (const bf16*)(ws + WS_WAB), D, NAB);
    k_fox_scan<<<1, 64, 0, stream>>>(B);
    k_fox_naive<<<dim3(T / 64, 16), 64, 0, stream>>>(B);
    k_conv_naive<<<(unsigned)(((size_t)M * 768 + 255) / 256), 256, 0, stream>>>(B);
    k_ssd_naive<<<16, 64, 0, stream>>>(B);
    k_ssd_norm<<<M * 2 / 4, 256, 0, stream>>>(B);
    k_gemm_naive<MODE_RES><<<dim3(D / 64, M / 64), 256, 0, stream>>>(B, CAT, (const bf16*)(ws + WS_WOA), D, D);
    k_ssq<<<M / 4, 256, 0, stream>>>(B);
    k_gemm_naive<MODE_UP><<<dim3(FF / 64, M / 64), 256, 0, stream>>>(B, HB, (const bf16*)(ws + WS_WU0), D, FF);
    k_gemm_naive<MODE_RES><<<dim3(D / 64, M / 64), 256, 0, stream>>>(B, U, (const bf16*)(ws + WS_WD0), FF, D);
    k_ssq<<<M / 4, 256, 0, stream>>>(B);
    k_gemm_naive<MODE_PROJ1><<<dim3(NCD / 64, M / 64), 256, 0, stream>>>(B, HB, (const bf16*)(ws + WS_WCD), D, NCD);
    k_sb_naive<<<dim3(T / 64, 16), 64, 0, stream>>>(B);
    k_gla_gate<<<(unsigned)(((size_t)M * 256 + 255) / 256), 256, 0, stream>>>(B);
    k_gla_naive<<<8, 128, 0, stream>>>(B);
    k_gla_norm<<<M * 4 / 4, 256, 0, stream>>>(B);
    k_gemm_naive<MODE_RES><<<dim3(D / 64, M / 64), 256, 0, stream>>>(B, CAT, (const bf16*)(ws + WS_WOC), D, D);
    k_ssq<<<M / 4, 256, 0, stream>>>(B);
    k_gemm_naive<MODE_UP><<<dim3(FF / 64, M / 64), 256, 0, stream>>>(B, HB, (const bf16*)(ws + WS_WU1), D, FF);
    k_gemm_naive<MODE_RES><<<dim3(D / 64, M / 64), 256, 0, stream>>>(B, U, (const bf16*)(ws + WS_WD1), FF, D);
    k_final<<<M / 4, 256, 0, stream>>>(B);
}
```

```cpp
#include <hip/hip_runtime.h>
#include <cstdio>
#include <cstdint>
#define GAS __attribute__((address_space(1)))
#define LAS __attribute__((address_space(3)))
typedef unsigned short bf16;
typedef unsigned v4u __attribute__((ext_vector_type(4)));
typedef float f32x4 __attribute__((ext_vector_type(4)));
typedef short bf16x8 __attribute__((ext_vector_type(8)));
typedef GAS unsigned gu32;
typedef GAS unsigned long long gu64;
#define RLX_AGENT __ATOMIC_RELAXED, __HIP_MEMORY_SCOPE_AGENT
#define LDS_WAIT() asm volatile("s_waitcnt lgkmcnt(0)" ::: "memory")
#define VM_WAIT() asm volatile("s_waitcnt vmcnt(0)" ::: "memory")
__device__ __forceinline__ unsigned long long rt() { return __builtin_amdgcn_s_memrealtime(); }
__device__ __forceinline__ unsigned f2bf(float f) { unsigned u = __builtin_bit_cast(unsigned, f); return (u + 0x7fffu + ((u >> 16) & 1u)) >> 16; }
__device__ __forceinline__ unsigned pk2(float lo, float hi) { return f2bf(lo) | (f2bf(hi) << 16); }

#define XB_TMO      128
#define XB_XCNT(j)  (256  + 64 * (j))
#define XB_XSUB(j)  (1280 + 64 * (j))
#define XB_XGEN(j)  (2304 + 64 * (j))
#define XB_TOP      3328
#define XB_TOPGEN   3392
#define XCD_BAR_WORDS 3456
#define XB_SPIN_CAP (1u << 18)

__device__ __forceinline__ unsigned xb_ld(unsigned* p)              { return __hip_atomic_load(p, __ATOMIC_RELAXED, __HIP_MEMORY_SCOPE_AGENT); }
__device__ __forceinline__ unsigned xb_add(unsigned* p, unsigned v) { return __hip_atomic_fetch_add(p, v, __ATOMIC_RELAXED, __HIP_MEMORY_SCOPE_AGENT); }
__device__ __forceinline__ unsigned xb_xcc_id() { return (unsigned)__builtin_amdgcn_s_getreg((3 << 11) | 20) & 0xFu; }
#define XB_SPIN(cond, bar) do { unsigned _sp = 0; while (cond) { __builtin_amdgcn_s_sleep(1); \
    if ((++_sp & 255u) == 0u) { if (xb_ld(&(bar)[XB_TMO])) break; if (_sp > XB_SPIN_CAP) { atomicAdd(&(bar)[XB_TMO], 1u); break; } } } } while (0)

struct XcdBarrier {
    unsigned* bar; unsigned x;
    volatile LAS unsigned* st;
};

__device__ __forceinline__ XcdBarrier xcd_barrier_post(unsigned* bar, volatile LAS unsigned* st) {
    XcdBarrier b; b.bar = bar; b.x = xb_xcc_id(); b.st = st;
    if (threadIdx.x == 0) (void)xb_add(&bar[XB_XCNT(b.x)], 1u);
    return b;
}
__device__ __forceinline__ void xcd_barrier_complete(unsigned* bar, unsigned x, unsigned& nloc, unsigned& nx) {
    const unsigned G = gridDim.x * gridDim.y * gridDim.z;
    unsigned sum, cnt, mine, sp = 0u;
    for (;;) {
        sum = 0u; cnt = 0u; mine = 0u;
#pragma unroll
        for (unsigned j = 0; j < 16; ++j) { const unsigned c = xb_ld(&bar[XB_XCNT(j)]); sum += c; cnt += (c > 0u) ? 1u : 0u; mine = (j == x) ? c : mine; }
        if (sum == G) break;
        __builtin_amdgcn_s_sleep(1);
        if ((++sp & 255u) == 0u) { if (xb_ld(&bar[XB_TMO])) break; if (sp > XB_SPIN_CAP) { atomicAdd(&bar[XB_TMO], 1u); break; } }
    }
    nloc = mine > 0u ? mine : 1u; nx = cnt > 0u ? cnt : 1u;
}

__device__ __forceinline__ void xcd_barrier(const XcdBarrier& b) {
    asm volatile("s_waitcnt vmcnt(0)" ::: "memory");
    __syncthreads();
    if (threadIdx.x == 0) {
        unsigned* bar = b.bar;
        __builtin_amdgcn_s_waitcnt(0);
        unsigned nloc = b.st[0], nx = b.st[1];
        if (nloc == 0u) { xcd_barrier_complete(bar, b.x, nloc, nx); b.st[0] = nloc; b.st[1] = nx; }
        const unsigned old = xb_add(&bar[XB_XSUB(b.x)], 1u);
        const unsigned gen = old / nloc;
        if (old + 1u == (gen + 1u) * nloc) {
            __builtin_amdgcn_fence(__ATOMIC_RELEASE, "agent");
            asm volatile("s_waitcnt vmcnt(0)" ::: "memory");
            const unsigned og = xb_add(&bar[XB_TOP], 1u);
            const unsigned tg = og / nx;
            if (og + 1u == (tg + 1u) * nx) xb_add(&bar[XB_TOPGEN], 1u);
            else XB_SPIN(xb_ld(&bar[XB_TOPGEN]) == tg, bar);
            __builtin_amdgcn_fence(__ATOMIC_ACQUIRE, "agent");
            xb_add(&bar[XB_XGEN(b.x)], 1u);
            asm volatile("s_waitcnt vmcnt(0)" ::: "memory");
        } else {
            XB_SPIN(xb_ld(&bar[XB_XGEN(b.x)]) == gen, bar);
            __builtin_amdgcn_fence(__ATOMIC_ACQUIRE, "agent");
            asm volatile("s_waitcnt vmcnt(0)" ::: "memory");
        }
    }
    __syncthreads();
}

__device__ __forceinline__ int xl_lane() { int l = __builtin_amdgcn_mbcnt_hi(~0u, __builtin_amdgcn_mbcnt_lo(~0u, 0u)); asm volatile("" : "+v"(l)); return l; }
__device__ __forceinline__ float bperm(int srclane, float v) { return __builtin_bit_cast(float, __builtin_amdgcn_ds_bpermute(srclane << 2, __builtin_bit_cast(int, v))); }
__device__ __forceinline__ float red16_sum(float v) { const int l = xl_lane(); v += bperm(l ^ 1, v); v += bperm(l ^ 2, v); v += bperm(l ^ 4, v); v += bperm(l ^ 8, v); return v; }
__device__ __forceinline__ float red16_max(float v) { const int l = xl_lane(); v = fmaxf(v, bperm(l ^ 1, v)); v = fmaxf(v, bperm(l ^ 2, v)); v = fmaxf(v, bperm(l ^ 4, v)); v = fmaxf(v, bperm(l ^ 8, v)); return v; }
__device__ __forceinline__ float swap16_sum(float v) { const int l = xl_lane(); return v + bperm(l ^ 16, v); }
__device__ __forceinline__ float swap32_sum(float v) { const int l = xl_lane(); return v + bperm(l ^ 32, v); }
__device__ __forceinline__ float swap32_max(float v) { const int l = xl_lane(); return fmaxf(v, bperm(l ^ 32, v)); }
__device__ __forceinline__ float swap32_other(float v, int hi) { const int l = xl_lane(); return bperm(l ^ 32, v); }
__device__ __forceinline__ float red32_sum(float v) { return swap16_sum(red16_sum(v)); }
__device__ __forceinline__ float red64_sum(float v) { return swap32_sum(swap16_sum(red16_sum(v))); }
constexpr int BATCH = 2, T = 8192, D = 1024, M = BATCH * T, FF = 4096;
constexpr int NH = 8, HD = 64;
constexpr int AB_IN = 2832, CD_IN = 3088;
constexpr int NAB = 3072, NCD = 3072, NCDW = 3328;
constexpr float EPS = 1e-5f;
constexpr float LOG2E = 1.4426950408889634f;
constexpr float C2 = 0.125f * LOG2E;

constexpr size_t MiB = 1u << 20;
constexpr size_t WS_CTL = 0;
constexpr size_t WS_KMAX = 512 * 1024;
constexpr size_t WS_SSQ = 1 * MiB;
constexpr size_t WS_WAB = 2 * MiB;
constexpr size_t WS_WOA = 8 * MiB;
constexpr size_t WS_WU0 = 10 * MiB;
constexpr size_t WS_WD0 = 18 * MiB;
constexpr size_t WS_WCD = 26 * MiB;
constexpr size_t WS_WOC = 33 * MiB;
constexpr size_t WS_WU1 = 35 * MiB;
constexpr size_t WS_WD1 = 43 * MiB;
constexpr size_t WS_HB = 52 * MiB;
constexpr size_t WS_TMP = 52 * MiB;
constexpr size_t WS_Q = 84 * MiB, WS_K = 100 * MiB, WS_V = 116 * MiB;
constexpr size_t WS_Z = 132 * MiB;
constexpr size_t WS_XBC = 148 * MiB;
constexpr size_t WS_XC = 172 * MiB;
constexpr size_t WS_GR = 164 * MiB;
constexpr size_t WS_GLOW = 180 * MiB;
constexpr size_t WS_CAT = 196 * MiB;
constexpr size_t WS_LA = 228 * MiB;
constexpr size_t WS_FD = 244 * MiB;
constexpr size_t WS_FL = 246 * MiB;
constexpr size_t WS_DTA = 246 * MiB;
constexpr size_t WS_CHD = 520 * 1024;
constexpr size_t WS_SLOC = 52 * MiB;
constexpr size_t WS_SPREV = 68 * MiB;
constexpr size_t WS_GDEC = 640 * 1024;
constexpr size_t WS_GLOC = 228 * MiB;
constexpr size_t WS_GPREV = 244 * MiB;
constexpr size_t WS_QCTR = 900 * 1024;
constexpr size_t WS_CNTA = 910 * 1024;
constexpr size_t WS_TS = 800 * 1024;
constexpr size_t WS_FLOC = 247 * MiB;
constexpr size_t WS_FTOT = 920 * 1024;
constexpr size_t WS_XBUF = 248 * MiB;
constexpr size_t WS_FCNT = 928 * 1024;
constexpr size_t WS_U = 84 * MiB;
constexpr size_t WS_END = 256 * MiB;

struct Bufs {
    const float* in[20];
    float* h;
    unsigned char* ws;
};
__device__ __forceinline__ float* ws_f(const Bufs& b, size_t off) { return (float*)(b.ws + off); }
__device__ __forceinline__ bf16* ws_b(const Bufs& b, size_t off) { return (bf16*)(b.ws + off); }

enum { I_X = 0, I_NMIX, I_NMLP, I_NFIN, I_WAB, I_FBIAS, I_CONVW, I_CONVB, I_DTB, I_ALOG, I_SSD_D, I_SSDN, I_WOA, I_WCD, I_GW2, I_GB, I_GLAN, I_WOC, I_WUP, I_WDN };

__device__ __forceinline__ float bf2f(unsigned short b) { return __builtin_bit_cast(float, (unsigned)b << 16); }
__device__ __forceinline__ float softplus_f(float x) { return fmaxf(x, 0.f) + log1pf(__expf(-fabsf(x))); }
__device__ __forceinline__ float logsig_f(float x) { return fminf(x, 0.f) - log1pf(__expf(-fabsf(x))); }
__device__ __forceinline__ float silu_f(float x) { return x / (1.f + __expf(-x)); }
__device__ __forceinline__ float row_rstd(const float* ssq, int row) {
    const f32x4 a = *(const f32x4*)(ssq + (size_t)row * 4);
    return 1.0f / sqrtf(((a.x + a.y) + (a.z + a.w)) * (1.0f / D) + EPS);
}
__device__ __forceinline__ size_t qkv_off(int row, int head, int d) { const int b = row / T, t = row % T; return ((size_t)(b * NH + head) * T + t) * HD + d; }

__device__ __forceinline__ int src_col_ab(int n) { if (n < 1536) return n; if (n < 2816) return n + 8; if (n < 2824) return n - 1280; if (n < 2832) return n; return -1; }
__device__ __forceinline__ int src_col_cd(int n) { if (n < 2560) return n; if (n < 3072) return n + 16; if (n < 3088) return n - 512; return -1; }

namespace pg8 {
#define PG8_LAS __attribute__((address_space(3)))
typedef unsigned short bf16_t;
typedef short bf16x8 __attribute__((ext_vector_type(8)));
typedef float f32x4 __attribute__((ext_vector_type(4)));
typedef unsigned u32x4 __attribute__((ext_vector_type(4)));
constexpr int BM = 256, BK = 64, HALF = 128, HTB = HALF * BK * 2  , STAGE_BYTES = 8 * HTB, NXCD = 8, WGM = 8;

__host__ __device__ __forceinline__ int lds_byte(int r, int c) { const int st = (r >> 4) * 2 + (c >> 5), rr = r & 15, cc = c & 31, ob = rr * 64 + cc * 2; return st * 1024 + (ob ^ (((ob >> 9) & 1) << 5)); }
__host__ __device__ __forceinline__ void stage_rc(int b, int& R, int& C) { const int st = b / 1024, sb = b % 1024, swz = sb ^ (((sb >> 9) & 1) << 5); R = (st >> 1) * 16 + swz / 64; C = (st & 1) * 32 + (swz % 64) / 2; }
__host__ __device__ __forceinline__ int perm32(int rho) { const int n = rho >> 4, i = rho & 15; return 8 * (i >> 2) + 4 * n + (i & 3); }

struct Unit { int pm, pn; };
struct Gemm { const bf16_t* A; const bf16_t* Bt; int M, N, K; };

struct StaticOrder {
    int nM, nN, nwg, G, c;
    __host__ __device__ void init(int M, int N, int G_, int c_) { nM = M / BM; nN = N / BM; nwg = nM * nN; G = G_; c = c_; }
    __host__ __device__ bool next(int i, Unit& u) const {
        const long L = (long)i * G + c; if (L >= nwg) return false;
        int wgid = (int)L; { const int q = nwg / NXCD, r = nwg % NXCD, xcd = wgid % NXCD, off = wgid / NXCD; wgid = (xcd < r ? xcd * (q + 1) : r * (q + 1) + (xcd - r) * q) + off; }
        const int nig = WGM * nN, gid = wgid / nig, fm = gid * WGM, gsz = (nM - fm) < WGM ? (nM - fm) : WGM;
        u.pm = fm + ((wgid % nig) % gsz); u.pn = (wgid % nig) / gsz; return true;
    }
    __device__ __forceinline__ void a_ready(const Unit&) const {}
    __device__ __forceinline__ void done(const Unit&) const {}
};
__device__ __forceinline__ unsigned cvt_pk_bf16(float lo, float hi) { unsigned r; asm volatile("v_cvt_pk_bf16_f32 %0, %1, %2" : "=v"(r) : "v"(lo), "v"(hi)); return r; }
typedef float f32x2 __attribute__((ext_vector_type(2)));
__device__ __forceinline__ u32x4 pack8(f32x4 v0, f32x4 v1) { u32x4 w; w.x = cvt_pk_bf16(v0[0], v0[1]); w.y = cvt_pk_bf16(v0[2], v0[3]); w.z = cvt_pk_bf16(v1[0], v1[1]); w.w = cvt_pk_bf16(v1[2], v1[3]); return w; }
template <int LAYER> __device__ __forceinline__ void proj_store8(unsigned char* ws, int row, int c, f32x4 v0, f32x4 v1) {
    if (c < 1536) {
        const int which = c >> 9, cc = c & 511, head = cc >> 6, d = cc & 63; const float sc = which == 0 ? C2 : 1.f;
        bf16_t* dst = (bf16_t*)(ws + WS_Q + (size_t)which * (16 * MiB)) + qkv_off(row, head, d);
        *(u32x4*)dst = pack8(v0 * sc, v1 * sc); return;
    }
    if (LAYER == 0) {
        if (c < 2048) { *(u32x4*)((bf16_t*)(ws + WS_Z) + (size_t)row * 512 + (c - 1536)) = pack8(v0, v1); }
        else if (c < 2816) { *(u32x4*)((bf16_t*)(ws + WS_XBC) + (size_t)row * 768 + (c - 2048)) = pack8(v0, v1); }
        else if (c < 2832) { float* p = (float*)(ws + WS_FD) + (size_t)row * 16 + (c - 2816); *(f32x4*)p = v0; *(f32x4*)(p + 4) = v1; }
    } else {
        if (c < 1792) { *(u32x4*)((bf16_t*)(ws + WS_XBC) + (size_t)row * 256 + (c - 1536)) = pack8(v0 * 0.125f, v1 * 0.125f); }
        else if (c < 2048) { *(u32x4*)((bf16_t*)(ws + WS_XBC + 8 * MiB) + (size_t)row * 256 + (c - 1792)) = pack8(v0, v1); }
        else if (c < 2560) { *(u32x4*)((bf16_t*)(ws + WS_Z) + (size_t)row * 512 + (c - 2048)) = pack8(v0, v1); }
        else if (c < 3072) { *(u32x4*)((bf16_t*)(ws + WS_GR) + (size_t)row * 512 + (c - 2560)) = pack8(v0, v1); }
        else if (c < 3088) { float* p = (float*)(ws + WS_GLOW) + (size_t)row * 16 + (c - 3072); *(f32x4*)p = v0; *(f32x4*)(p + 4) = v1; }
    }
}
template <int LAYER> struct EpiProj {
    static constexpr bool PERM = true, AFTER_DRAIN = false;
    unsigned char* ws; const float* ssq;
    __device__ __forceinline__ void operator()(const f32x4 (&acc)[2][2][4][2], const Unit& u, int wr, int wc, int fr, int fq) const {
        const int row0 = u.pm * BM + wr * 64 + fr, col0 = u.pn * BM + wc * 32 + 8 * fq;
        float kmx[2] = {0.f, 0.f};
        float rsv[2][4];
#pragma unroll
        for (int ai = 0; ai < 2; ++ai)
#pragma unroll
            for (int m = 0; m < 4; ++m) rsv[ai][m] = row_rstd(ssq, row0 + ai * HALF + m * 16);
#pragma unroll
        for (int ai = 0; ai < 2; ++ai)
#pragma unroll
            for (int m = 0; m < 4; ++m) { const int row = row0 + ai * HALF + m * 16; const float rs = rsv[ai][m];
#pragma unroll
                for (int bj = 0; bj < 2; ++bj) { const f32x4 v0 = acc[ai][bj][m][0] * rs, v1 = acc[ai][bj][m][1] * rs;
                    proj_store8<LAYER>(ws, row, col0 + bj * HALF, v0, v1);
                    if (LAYER == 0) kmx[bj] = fmaxf(kmx[bj], ((v0[0] * v0[0] + v0[1] * v0[1]) + (v0[2] * v0[2] + v0[3] * v0[3])) + ((v1[0] * v1[0] + v1[1] * v1[1]) + (v1[2] * v1[2] + v1[3] * v1[3]))); } }
        if (LAYER == 0 && (u.pn == 2 || u.pn == 3)) {
#pragma unroll
            for (int bj = 0; bj < 2; ++bj) { float v = kmx[bj];
                v = red16_max(v);
                if (fr == 0) { const int c = col0 + bj * HALF - 512, head = c >> 6, chunk = (c & 63) >> 3, b = (u.pm * BM) / T;
                    atomicMax((unsigned*)(ws + WS_KMAX) + (b * NH + head) * 8 + chunk, __builtin_bit_cast(unsigned, sqrtf(v))); } }
        }
    }
};
struct EpiRes {
    static constexpr bool PERM = false, AFTER_DRAIN = false;
    const float* base; float* h; bf16_t* hb; float* ssq; PG8_LAS float* red;
    __device__ __forceinline__ void operator()(f32x4 (&acc)[2][2][4][2], const Unit& u, int wr, int wc, int fr, int fq) const {
        typedef unsigned u32x2v __attribute__((ext_vector_type(2)));
        const int row0 = u.pm * BM + wr * 64 + fr, col0 = u.pn * BM + wc * 32 + 4 * fq;
#pragma unroll
        for (int ai = 0; ai < 2; ++ai)
#pragma unroll
            for (int m = 0; m < 4; ++m)
#pragma unroll
                for (int bj = 0; bj < 2; ++bj)
#pragma unroll
                    for (int n = 0; n < 2; ++n) { acc[ai][bj][m][n] += *(const f32x4*)(base + (size_t)(row0 + ai * HALF + m * 16) * D + col0 + bj * HALF + n * 16);
                        if (bj == 1 && n == 1 && (m & 1))
                            asm volatile("" : "+v"(acc[ai][0][m - 1][0]), "+v"(acc[ai][0][m - 1][1]), "+v"(acc[ai][1][m - 1][0]), "+v"(acc[ai][1][m - 1][1]), "+v"(acc[ai][0][m][0]), "+v"(acc[ai][0][m][1]), "+v"(acc[ai][1][m][0]), "+v"(acc[ai][1][m][1]) :: "memory"); }
#pragma unroll
        for (int ai = 0; ai < 2; ++ai)
#pragma unroll
            for (int m = 0; m < 4; ++m) { const int row = row0 + ai * HALF + m * 16; float s = 0.f;
#pragma unroll
                for (int bj = 0; bj < 2; ++bj)
#pragma unroll
                    for (int n = 0; n < 2; ++n) { const size_t off = (size_t)row * D + col0 + bj * HALF + n * 16;
                        const f32x4 v = acc[ai][bj][m][n]; *(f32x4*)(h + off) = v;
                        s += (v[0] * v[0] + v[1] * v[1]) + (v[2] * v[2] + v[3] * v[3]);
                        u32x2v w; w.x = cvt_pk_bf16(v[0], v[1]); w.y = cvt_pk_bf16(v[2], v[3]); *(u32x2v*)(hb + off) = w; }
                s = swap32_sum(swap16_sum(s));
                if (fq == 0) red[(ai * HALF + wr * 64 + m * 16 + fr) * 4 + wc] = s; }
        asm volatile("s_waitcnt lgkmcnt(0)" ::: "memory"); __builtin_amdgcn_s_barrier(); asm volatile("" ::: "memory");
        { const int t = (wr * 4 + wc) * 64 + fq * 16 + fr;
          if (t < 256) { const f32x4 p = *(const PG8_LAS f32x4*)(red + t * 4); ssq[(size_t)(u.pm * BM + t) * 4 + u.pn] = (p[0] + p[1]) + (p[2] + p[3]); } }
        asm volatile("s_waitcnt lgkmcnt(0)" ::: "memory"); __builtin_amdgcn_s_barrier(); asm volatile("" ::: "memory");
    }
};
struct EpiFinal {
    static constexpr bool PERM = false, AFTER_DRAIN = false;
    const float* base; float* out; const float* wn; float* xbuf; unsigned* cnt; PG8_LAS float* red;
    __device__ __forceinline__ void operator()(f32x4 (&acc)[2][2][4][2], const Unit& u, int wr, int wc, int fr, int fq) const {
        const int row0 = u.pm * BM + wr * 64 + fr, col0 = u.pn * BM + wc * 32 + 4 * fq;
#pragma unroll
        for (int ai = 0; ai < 2; ++ai)
#pragma unroll
            for (int m = 0; m < 4; ++m)
#pragma unroll
                for (int bj = 0; bj < 2; ++bj)
#pragma unroll
                    for (int n = 0; n < 2; ++n) { acc[ai][bj][m][n] += *(const f32x4*)(base + (size_t)(row0 + ai * HALF + m * 16) * D + col0 + bj * HALF + n * 16);
                        if (bj == 1 && n == 1 && (m & 1))
                            asm volatile("" : "+v"(acc[ai][0][m - 1][0]), "+v"(acc[ai][0][m - 1][1]), "+v"(acc[ai][1][m - 1][0]), "+v"(acc[ai][1][m - 1][1]), "+v"(acc[ai][0][m][0]), "+v"(acc[ai][0][m][1]), "+v"(acc[ai][1][m][0]), "+v"(acc[ai][1][m][1]) :: "memory"); }
#pragma unroll
        for (int ai = 0; ai < 2; ++ai)
#pragma unroll
            for (int m = 0; m < 4; ++m) { float s = 0.f;
#pragma unroll
                for (int bj = 0; bj < 2; ++bj)
#pragma unroll
                    for (int n = 0; n < 2; ++n) { const f32x4 v = acc[ai][bj][m][n]; s += (v[0] * v[0] + v[1] * v[1]) + (v[2] * v[2] + v[3] * v[3]); }
                s = swap32_sum(swap16_sum(s));
                if (fq == 0) red[(ai * HALF + wr * 64 + m * 16 + fr) * 4 + wc] = s; }
        asm volatile("s_waitcnt lgkmcnt(0)" ::: "memory"); __builtin_amdgcn_s_barrier(); asm volatile("" ::: "memory");
        const int wid = wr * 4 + wc, t = wid * 64 + fq * 16 + fr;
        if (t < 256) { const f32x4 p = *(const PG8_LAS f32x4*)(red + t * 4);
            __hip_atomic_store(xbuf + (size_t)(u.pm * BM + t) * 4 + u.pn, (p[0] + p[1]) + (p[2] + p[3]), __ATOMIC_RELAXED, __HIP_MEMORY_SCOPE_AGENT); }
        asm volatile("s_waitcnt vmcnt(0)" ::: "memory");
        if (wid < 4 && fq * 16 + fr == 0) __hip_atomic_fetch_add(cnt + 64 * u.pm, 1u, __ATOMIC_RELAXED, __HIP_MEMORY_SCOPE_AGENT);
        if (wid == 0) { unsigned sp = 0u;
            while ((unsigned)__builtin_amdgcn_readfirstlane(__hip_atomic_load(cnt + 64 * u.pm, __ATOMIC_RELAXED, __HIP_MEMORY_SCOPE_AGENT)) < 16u) { __builtin_amdgcn_s_sleep(2); if (++sp > (1u << 22)) break; }
            __builtin_amdgcn_fence(__ATOMIC_ACQUIRE, "agent"); }
        asm volatile("s_waitcnt vmcnt(0) lgkmcnt(0)" ::: "memory"); __builtin_amdgcn_s_barrier(); asm volatile("" ::: "memory");
        if (t < 256) { const float* sl = xbuf + (size_t)(u.pm * BM + t) * 4; float q = 0.f;
#pragma unroll
            for (int i = 0; i < 4; ++i) q += __hip_atomic_load(sl + i, __ATOMIC_RELAXED, __HIP_MEMORY_SCOPE_AGENT);
            red[1024 + t] = 1.0f / sqrtf(q * (1.0f / D) + EPS); }
        asm volatile("s_waitcnt vmcnt(0) lgkmcnt(0)" ::: "memory"); __builtin_amdgcn_s_barrier(); asm volatile("" ::: "memory");
        f32x4 wv[2][2];
#pragma unroll
        for (int bj = 0; bj < 2; ++bj)
#pragma unroll
            for (int n = 0; n < 2; ++n) wv[bj][n] = *(const f32x4*)(wn + col0 + bj * HALF + n * 16);
#pragma unroll
        for (int ai = 0; ai < 2; ++ai)
#pragma unroll
            for (int m = 0; m < 4; ++m) { const int rl = ai * HALF + wr * 64 + m * 16 + fr; const float rs = red[1024 + rl];
#pragma unroll
                for (int bj = 0; bj < 2; ++bj)
#pragma unroll
                    for (int n = 0; n < 2; ++n) *(f32x4*)(out + (size_t)(u.pm * BM + rl) * D + col0 + bj * HALF + n * 16) = acc[ai][bj][m][n] * rs * wv[bj][n]; }
        asm volatile("s_waitcnt lgkmcnt(0)" ::: "memory"); __builtin_amdgcn_s_barrier(); asm volatile("" ::: "memory");
    }
};
struct EpiUp {
    static constexpr bool PERM = true, AFTER_DRAIN = false;
    bf16_t* U; const float* ssq;
    __device__ __forceinline__ void operator()(const f32x4 (&acc)[2][2][4][2], const Unit& u, int wr, int wc, int fr, int fq) const {
        const int row0 = u.pm * BM + wr * 64 + fr, col0 = u.pn * BM + wc * 32 + 8 * fq;
        float rsv[2][4];
#pragma unroll
        for (int ai = 0; ai < 2; ++ai)
#pragma unroll
            for (int m = 0; m < 4; ++m) rsv[ai][m] = row_rstd(ssq, row0 + ai * HALF + m * 16);
#pragma unroll
        for (int ai = 0; ai < 2; ++ai)
#pragma unroll
            for (int m = 0; m < 4; ++m) { const int row = row0 + ai * HALF + m * 16; const float rs = rsv[ai][m];
#pragma unroll
                for (int bj = 0; bj < 2; ++bj) { f32x4 a = acc[ai][bj][m][0], b = acc[ai][bj][m][1];
#pragma unroll
                    for (int e = 0; e < 4; ++e) { const float x = fmaxf(a[e], 0.f) * rs, y = fmaxf(b[e], 0.f) * rs; a[e] = x * x; b[e] = y * y; }
                    *(u32x4*)(U + (size_t)row * FF + col0 + bj * HALF) = pack8(a, b); } }
    }
};
template <class Epi, class Sched, bool ALIGN_EPI = false, bool SP2 = false>
__device__ __forceinline__ void gemm_phase(PG8_LAS unsigned char* lds, const Gemm g, const Sched& S, const Epi& E, int tid_in) {
    int tid_l = tid_in; asm volatile("" : "+v"(tid_l));
    const int tid = tid_l, wid = __builtin_amdgcn_readfirstlane(tid >> 6), lane = tid & 63, wr = wid >> 2, wc = wid & 3, fr = lane & 15, fq = lane >> 4;
    const int K = g.K, nt = K / BK;
    unsigned voffA[2], voffB[2];
#pragma unroll
    for (int i = 0; i < 2; ++i) { int R, C; stage_rc(tid * 16 + i * 8192, R, C); const int Rb = Epi::PERM ? ((R & ~31) + perm32(R & 31)) : R;
        voffA[i] = (unsigned)(R * K + C) * 2u; voffB[i] = (unsigned)(Rb * K + C) * 2u; }
    const size_t kstep = (size_t)(BK * 2);
    const size_t hstep = (size_t)HALF * K * 2;
    const size_t tstep = 2 * hstep;
    const unsigned ldsw = (unsigned)wid * 1024u;
    const int aoff = lds_byte(wr * 64 + fr, fq * 8), boff = lds_byte(wc * 32 + fr, fq * 8);
#define PG8_SA(b, h) (((b) * 2 + (h)) * HTB)
#define PG8_SB(b, h) ((4 + (b) * 2 + (h)) * HTB)
#define PG8_STAGE(bufoff, gbase, voff) do { _Pragma("unroll") for (int _i = 0; _i < 2; ++_i) \
        __builtin_amdgcn_global_load_lds((const unsigned*)((const char*)(gbase) + (voff)[_i]), (PG8_LAS unsigned*)(lds + (bufoff) + ldsw + _i * 8192), 16, 0, 0); } while (0)
#define PG8_LDA(dst, b, h) do { _Pragma("unroll") for (int m = 0; m < 4; ++m) _Pragma("unroll") for (int k = 0; k < 2; ++k) dst[m][k] = *(const PG8_LAS bf16x8*)(lds + PG8_SA(b, h) + aoff + m * 2048 + k * 1024); } while (0)
#define PG8_LDB(dst, b, h) do { _Pragma("unroll") for (int n = 0; n < 2; ++n) _Pragma("unroll") for (int k = 0; k < 2; ++k) dst[n][k] = *(const PG8_LAS bf16x8*)(lds + PG8_SB(b, h) + boff + n * 2048 + k * 1024); } while (0)
#define PG8_MMA(ai, bj, At, Bt) do { __builtin_amdgcn_s_setprio(1); _Pragma("unroll") for (int m = 0; m < 4; ++m) _Pragma("unroll") for (int n = 0; n < 2; ++n) _Pragma("unroll") for (int k = 0; k < 2; ++k) \
        acc[ai][bj][m][n] = __builtin_amdgcn_mfma_f32_16x16x32_bf16(Bt[n][k], At[m][k], acc[ai][bj][m][n], 0, 0, 0); __builtin_amdgcn_s_setprio(0); } while (0)
#define PG8_WAIT_V(n) asm volatile("s_waitcnt vmcnt(" #n ")" ::: "memory")
#define PG8_WAIT_L(n) asm volatile("s_waitcnt lgkmcnt(" #n ")" ::: "memory")
#define PG8_BAR __builtin_amdgcn_s_barrier()
#define PG8_SCHED __builtin_amdgcn_sched_barrier(0)
    Unit cur, nxt; int ui = 0;
    if (!S.next(0, cur)) return;
    f32x4 acc[2][2][4][2];
#pragma unroll
    for (int a = 0; a < 2; ++a)
#pragma unroll
        for (int b = 0; b < 2; ++b)
#pragma unroll
            for (int m = 0; m < 4; ++m)
#pragma unroll
                for (int n = 0; n < 2; ++n) acc[a][b][m][n] = (f32x4){0.f, 0.f, 0.f, 0.f};
    bf16x8 At[4][2], B0[2][2], B1[2][2];
    const char* cA = (const char*)g.A + (size_t)cur.pm * tstep; const char* cB = (const char*)g.Bt + (size_t)cur.pn * tstep;
    S.a_ready(cur);
    if constexpr (SP2) {
        PG8_STAGE(PG8_SB(0, 0), cB, voffB); PG8_STAGE(PG8_SB(0, 1), cB + hstep, voffB); PG8_STAGE(PG8_SA(0, 0), cA, voffA); PG8_STAGE(PG8_SA(0, 1), cA + hstep, voffA);
        if (wr == 1) PG8_BAR;
        PG8_WAIT_V(2); PG8_BAR;
        PG8_STAGE(PG8_SB(1, 0), cB + kstep, voffB); PG8_STAGE(PG8_SA(1, 0), cA + kstep, voffA); PG8_STAGE(PG8_SB(1, 1), cB + hstep + kstep, voffB);
        PG8_WAIT_V(6); PG8_BAR;
    } else {
        PG8_STAGE(PG8_SB(0, 0), cB, voffB); PG8_STAGE(PG8_SA(0, 0), cA, voffA); PG8_STAGE(PG8_SB(0, 1), cB + hstep, voffB); PG8_STAGE(PG8_SA(0, 1), cA + hstep, voffA);
        if (wr == 1) PG8_BAR;
        PG8_WAIT_V(4); PG8_BAR;
        PG8_STAGE(PG8_SB(1, 0), cB + kstep, voffB); PG8_STAGE(PG8_SA(1, 0), cA + kstep, voffA); PG8_STAGE(PG8_SB(1, 1), cB + hstep + kstep, voffB);
        PG8_WAIT_V(6); PG8_BAR;
    }
    for (;;) {
        const bool has_next = S.next(ui + 1, nxt);
        const char* nA = has_next ? (const char*)g.A + (size_t)nxt.pm * tstep : cA; const char* nB = has_next ? (const char*)g.Bt + (size_t)nxt.pn * tstep : cB;
        for (int t = 0; t < nt; t += 2) {
            const bool last = (t == nt - 2);
            const char* a1 = cA + (size_t)(t + 1) * kstep;
            const char* a2 = last ? nA : cA + (size_t)(t + 2) * kstep; const char* b2 = last ? nB : cB + (size_t)(t + 2) * kstep;
            const char* a3 = a2 + kstep; const char* b3 = b2 + kstep;
            if (last && has_next) S.a_ready(nxt);
            if constexpr (SP2) {
            PG8_LDB(B0, 0, 0); PG8_LDB(B1, 0, 1); PG8_SCHED; PG8_LDA(At, 0, 0); PG8_STAGE(PG8_SA(1, 1), a1 + hstep, voffA);
            PG8_WAIT_V(8); PG8_WAIT_L(0); PG8_BAR; PG8_MMA(0, 0, At, B0); PG8_MMA(0, 1, At, B1); PG8_BAR; PG8_SCHED;
            PG8_LDA(At, 0, 1); PG8_STAGE(PG8_SB(0, 0), b2, voffB); PG8_STAGE(PG8_SB(0, 1), b2 + hstep, voffB); PG8_STAGE(PG8_SA(0, 0), a2, voffA);
            PG8_WAIT_V(8); PG8_WAIT_L(0); PG8_BAR; PG8_MMA(1, 0, At, B0); PG8_MMA(1, 1, At, B1); PG8_BAR; PG8_SCHED;
            PG8_LDB(B0, 1, 0); PG8_LDB(B1, 1, 1); PG8_SCHED; PG8_LDA(At, 1, 0); PG8_STAGE(PG8_SA(0, 1), a2 + hstep, voffA);
            PG8_WAIT_V(8); PG8_WAIT_L(0); PG8_BAR; PG8_MMA(0, 0, At, B0); PG8_MMA(0, 1, At, B1); PG8_BAR; PG8_SCHED;
            PG8_LDA(At, 1, 1); PG8_STAGE(PG8_SB(1, 0), b3, voffB); PG8_STAGE(PG8_SB(1, 1), b3 + hstep, voffB); PG8_STAGE(PG8_SA(1, 0), a3, voffA);
            PG8_WAIT_V(8); PG8_WAIT_L(0); PG8_BAR; PG8_MMA(1, 0, At, B0); PG8_MMA(1, 1, At, B1); PG8_BAR; PG8_SCHED;
            } else {
            PG8_LDB(B0, 0, 0); PG8_SCHED; PG8_LDA(At, 0, 0); PG8_STAGE(PG8_SA(1, 1), a1 + hstep, voffA);
            PG8_WAIT_L(8); PG8_BAR; PG8_WAIT_L(0); PG8_MMA(0, 0, At, B0); PG8_BAR; PG8_SCHED;
            PG8_LDB(B1, 0, 1); PG8_STAGE(PG8_SB(0, 0), b2, voffB);
            PG8_BAR; PG8_WAIT_L(0); PG8_MMA(0, 1, At, B1); PG8_BAR;
            PG8_LDA(At, 0, 1); PG8_STAGE(PG8_SA(0, 0), a2, voffA);
            PG8_BAR; PG8_WAIT_L(0); PG8_MMA(1, 0, At, B0); PG8_BAR; PG8_SCHED;
            PG8_STAGE(PG8_SB(0, 1), b2 + hstep, voffB);
            PG8_WAIT_V(6); PG8_BAR; PG8_MMA(1, 1, At, B1); PG8_BAR;
            PG8_LDB(B0, 1, 0); PG8_SCHED; PG8_LDA(At, 1, 0); PG8_STAGE(PG8_SA(0, 1), a2 + hstep, voffA);
            PG8_WAIT_L(8); PG8_BAR; PG8_WAIT_L(0); PG8_MMA(0, 0, At, B0); PG8_BAR; PG8_SCHED;
            PG8_LDB(B1, 1, 1); PG8_STAGE(PG8_SB(1, 0), b3, voffB);
            PG8_BAR; PG8_WAIT_L(0); PG8_MMA(0, 1, At, B1); PG8_BAR;
            PG8_LDA(At, 1, 1); PG8_STAGE(PG8_SA(1, 0), a3, voffA);
            PG8_BAR; PG8_WAIT_L(0); PG8_MMA(1, 0, At, B0); PG8_BAR; PG8_SCHED;
            PG8_STAGE(PG8_SB(1, 1), b3 + hstep, voffB);
            PG8_WAIT_V(6); PG8_BAR; PG8_MMA(1, 1, At, B1); PG8_BAR;
            }
        }
        if constexpr (ALIGN_EPI) { if (wr == 0) PG8_BAR; }
        if constexpr (!Epi::AFTER_DRAIN) { E(acc, cur, wr, wc, fr, fq); S.done(cur); }
        if (!has_next) break;
#pragma unroll
        for (int a = 0; a < 2; ++a)
#pragma unroll
            for (int b = 0; b < 2; ++b)
#pragma unroll
                for (int m = 0; m < 4; ++m)
#pragma unroll
                    for (int n = 0; n < 2; ++n) acc[a][b][m][n] = (f32x4){0.f, 0.f, 0.f, 0.f};
        cur = nxt; cA = nA; cB = nB; ++ui;
        if constexpr (ALIGN_EPI) { if (wr == 1) PG8_BAR; }
    }
    PG8_WAIT_V(0);
    if constexpr (!ALIGN_EPI) { if (wr == 0) PG8_BAR; }
    PG8_BAR;
    if constexpr (Epi::AFTER_DRAIN) { E.fused(acc, cur, wr, wc, fr, fq, lds, wid, lane); S.done(cur); }
#undef PG8_SA
#undef PG8_SB
#undef PG8_STAGE
#undef PG8_LDA
#undef PG8_LDB
#undef PG8_MMA
#undef PG8_WAIT_V
#undef PG8_WAIT_L
#undef PG8_BAR
#undef PG8_SCHED
}
}

namespace att {
typedef short bf16x8 __attribute__((ext_vector_type(8)));
typedef short s16x4 __attribute__((ext_vector_type(4)));
typedef float f32x16 __attribute__((ext_vector_type(16)));
constexpr int KCH = 1040, KBUF = 8 * KCH, VBUF = 8192;
constexpr int NSL = 5;
constexpr int OFF_K = 0, OFF_V = NSL * KBUF, OFF_G = OFF_V + NSL * VBUF, OFF_FLAG = OFF_G + NSL * 272, OFF_WS = OFF_FLAG + 96, OFF_OST = OFF_WS + 8 * 256 + 128;
static_assert(OFF_V % 16 == 0 && OFF_G % 16 == 0 && OFF_WS % 16 == 0 && OFF_OST % 16 == 0 && OFF_OST + 8 * 4096 <= 131072, "att LDS map");
__device__ __forceinline__ int crow(int r, int hi) { return (r & 3) + 8 * (r >> 2) + 4 * hi; }
__device__ __forceinline__ s16x4 vtr(const LAS unsigned char* p) { typedef short v4i16_t __attribute__((ext_vector_type(4))); return __builtin_bit_cast(s16x4, __builtin_amdgcn_ds_read_tr16_b64_v4i16((LAS v4i16_t*)p)); }
__device__ __forceinline__ unsigned cvtpk(float lo, float hi) { typedef float f2 __attribute__((ext_vector_type(2))); typedef __bf16 b2 __attribute__((ext_vector_type(2))); f2 v = {lo, hi}; b2 b = __builtin_convertvector(v, b2); return __builtin_bit_cast(unsigned, b); }
__device__ __forceinline__ float ex2(float x) { return __builtin_amdgcn_exp2f(x); }
__device__ __forceinline__ float lg2(float x) { return __builtin_amdgcn_logf(x); }

__device__ __forceinline__ void gtile(LAS unsigned char* L, float fl, float cp, float fprev, int buf, int lane, float Fq) {
    LAS float* g = (LAS float*)(L + OFF_G + buf * 272);
    g[lane] = Fq - (fl + cp);
    if (lane == 0) g[64] = Fq - fprev;
}

template <int MODE>
__device__ __forceinline__ void attn_unit(LAS unsigned char* L, unsigned char* ws, const float* fbias, const float* kmaxc, int b, int h, int qb, int tid) {
    asm volatile("" : "+v"(tid));
    const int lane = tid & 63, r32 = lane & 31, hi = lane >> 5, w = __builtin_amdgcn_readfirstlane(tid >> 6);
    const int bh = b * NH + h, q0 = qb * 256;
    const bf16* Qp = (const bf16*)(ws + WS_Q) + ((size_t)bh * T + q0 + w * 32 + r32) * HD;
    const bf16* Kp = (const bf16*)(ws + WS_K) + (size_t)bh * T * HD;
    const bf16* Vp = (const bf16*)(ws + WS_V) + (size_t)bh * T * HD;
    bf16x8 qr[4];
#pragma unroll
    for (int d0 = 0; d0 < 4; ++d0) qr[d0] = *(const bf16x8*)(Qp + d0 * 16 + hi * 8);
    const int lkv = tid >> 3, lch = tid & 7;
    const unsigned kdst = OFF_K + lch * KCH + lkv * 16;
    const unsigned vdst = OFF_V + ((lch >> 2) * 4 + (lkv >> 4)) * 1024 + (lkv & 15) * 64 + (lch & 3) * 16;
    const bf16* kg = Kp + (size_t)lkv * HD + lch * 8; const bf16* vg = Vp + (size_t)lkv * HD + lch * 8;
    int j = 4 * qb;
    { v4u kb_[3], vb_[3];
#pragma unroll
      for (int i = 0; i < 3; ++i) { kb_[i] = *(const v4u*)(kg + (size_t)(j + 3 - i) * 4096); vb_[i] = *(const v4u*)(vg + (size_t)(j + 3 - i) * 4096); }
#pragma unroll
      for (int i = 0; i < 3; ++i) { *(LAS v4u*)(L + i * KBUF + kdst) = kb_[i]; *(LAS v4u*)(L + i * VBUF + vdst) = vb_[i]; } }
    v4u kreg = *(const v4u*)(kg + (size_t)j * 4096), vreg = *(const v4u*)(vg + (size_t)j * 4096), kreg2 = kreg, vreg2 = vreg;
    if (j > 0) { kreg2 = *(const v4u*)(kg + (size_t)(j - 1) * 4096); vreg2 = *(const v4u*)(vg + (size_t)(j - 1) * 4096); }
    const unsigned kfb = OFF_K + hi * KCH + r32 * 16;
    const unsigned vfb = OFF_V + ((lane >> 4) & 1) * 32 + (lane & 3) * 8 + (4 * hi + ((lane & 15) >> 2)) * 64;
    LAS float* wsf = (LAS float*)(L + OFF_WS) + w * 64;
    LAS unsigned* flags = (LAS unsigned*)(L + OFF_FLAG);
    float sbound = 0.f;
    if (MODE == 0) {
#pragma unroll
        for (int d0 = 0; d0 < 4; ++d0) { float s = 0.f;
#pragma unroll
            for (int e = 0; e < 8; ++e) { const float v = bf2f((unsigned short)qr[d0][e]); s += v * v; }
            sbound += sqrtf(s) * kmaxc[bh * 8 + 2 * d0 + hi]; }
        sbound = swap32_sum(sbound) * 1.02f;
    }
    const float sshift = fmaxf(sbound - 60.f, 0.f);
    const float sbound37 = sbound + 37.f;
    const float* flp = (const float*)(ws + WS_FLOC) + (size_t)bh * T;
    float cpre = 0.f, Fq = 0.f, fx1 = 0.f, fx2 = 0.f;
    if (MODE == 0 && w == 0) {
        const float t = ((const float*)(ws + WS_FTOT))[bh * 64 + lane]; float v = t; int ln = lane; asm volatile("" : "+v"(ln));
#pragma unroll
        for (int o = 1; o < 64; o <<= 1) { const float u = bperm(ln - o, v); if (ln >= o) v += u; }
        cpre = v - t;
        const int ql = q0 + 255;
        Fq = flp[ql] + __builtin_bit_cast(float, __builtin_amdgcn_readlane(__builtin_bit_cast(int, cpre), ql >> 7));
        float ft[5];
#pragma unroll
        for (int i = 0; i < 5; ++i) { const int t = j + 3 - i; ft[i] = t >= 0 ? flp[t * 64 + lane] : 0.f; }
#pragma unroll
        for (int i = 0; i < 4; ++i) { const int t = j + 3 - i;
            const float cp = __builtin_bit_cast(float, __builtin_amdgcn_readlane(__builtin_bit_cast(int, cpre), t >> 1));
            const float fpv = t > 0 ? __builtin_bit_cast(float, __builtin_amdgcn_readlane(__builtin_bit_cast(int, ft[i + 1]), 63)) + __builtin_bit_cast(float, __builtin_amdgcn_readlane(__builtin_bit_cast(int, cpre), (t - 1) >> 1)) : 0.f;
            gtile(L, ft[i], cp, fpv, i, lane, Fq); }
        fx1 = ft[4]; if (j > 1) fx2 = flp[(j - 2) * 64 + lane];
        if (lane == 0) { LAS float* fref = (LAS float*)(L + OFF_FLAG + 64); fref[0] = Fq;
            fref[1] = __builtin_bit_cast(float, __builtin_amdgcn_readlane(__builtin_bit_cast(int, cpre), q0 >> 7)); fref[2] = __builtin_bit_cast(float, __builtin_amdgcn_readlane(__builtin_bit_cast(int, cpre), (q0 >> 7) + 1)); }
    }
    const float flq = (MODE == 0) ? flp[q0 + 32 * w + r32] : 0.f;
    float cq = 0.f;
    if (lane == 0) { flags[w] = 0u; flags[8 + w] = 0u; }
    float m = -1e30f, l = 0.f, R = 0.f;
    f32x16 o0 = {}, o1 = {};
    bool wdone = false, it_first = true;
    int sw = 3, it = 0;
    const int pw_ = w >> 1, qloc = 32 * (w & 1) + r32;
    bool stop = false;
    const bool late = (w >= 4); bool pend = false;
    unsigned pws[16]; s16x4 vas[4][2], vcs[4][2];
#define ATT_PV(PW, VA, VC) { _Pragma("unroll") for (int s_ = 0; s_ < 4; ++s_) { \
        const v4u pa_ = {PW[4 * s_], PW[4 * s_ + 1], PW[4 * s_ + 2], PW[4 * s_ + 3]}; const bf16x8 pa = __builtin_bit_cast(bf16x8, pa_); \
        const bf16x8 v0_ = {VA[s_][0][0], VA[s_][0][1], VA[s_][0][2], VA[s_][0][3], VA[s_][1][0], VA[s_][1][1], VA[s_][1][2], VA[s_][1][3]}, v1_ = {VC[s_][0][0], VC[s_][0][1], VC[s_][0][2], VC[s_][0][3], VC[s_][1][0], VC[s_][1][1], VC[s_][1][2], VC[s_][1][3]}; \
        o0 = __builtin_amdgcn_mfma_f32_32x32x16_bf16(pa, v0_, o0, 0, 0, 0); o1 = __builtin_amdgcn_mfma_f32_32x32x16_bf16(pa, v1_, o1, 0, 0, 0); } }
#if DIAG && defined(DIAG_ATT)
    long long t0_ = 0, t1_ = 0, t2_ = 0, tm_ = 0;
#define DSTAMP(x) x = clock64()
#define DACC() do { if (MODE == DIAG_MODE && blockIdx.x == 0 && w == DIAG_WAVE && lane == 0) { atomicAdd((unsigned long long*)(ws + WS_TS) + 60, (unsigned long long)(t1_ - t0_)); atomicAdd((unsigned long long*)(ws + WS_TS) + 61, (unsigned long long)(t2_ - t1_)); atomicAdd((unsigned long long*)(ws + WS_TS) + 62, 1ull); atomicAdd((unsigned long long*)(ws + WS_TS) + 63, (unsigned long long)(tm_ - t0_)); } } while (0)
#else
#define DSTAMP(x) do {} while (0)
#define DACC() do {} while (0)
#endif
#define ATT_STEP(KR, VR) { \
        DSTAMP(t0_); if (j >= 0) { *(LAS v4u*)(L + sw * KBUF + kdst) = KR; *(LAS v4u*)(L + sw * VBUF + vdst) = VR; } asm volatile("s_waitcnt lgkmcnt(0)" ::: "memory"); DSTAMP(tm_); \
        asm volatile("s_waitcnt lgkmcnt(0)" ::: "memory"); __builtin_amdgcn_s_barrier(); asm volatile("" ::: "memory"); DSTAMP(t1_);     \
        if (it > 0) { const LAS unsigned* f = flags + ((it - 1) & 1) * 8; unsigned a = f[0] & f[1] & f[2] & f[3] & f[4] & f[5] & f[6] & f[7]; if (a) { stop = true; } } \
        if (!stop) { \
        if (j > 1) { KR = *(const v4u*)(kg + (size_t)(j - 2) * 4096); VR = *(const v4u*)(vg + (size_t)(j - 2) * 4096); }       \
        if (MODE == 0 && w == 0 && j > 0) { const float fxc = fx1; fx1 = fx2; if (j > 2) fx2 = flp[(j - 3) * 64 + lane]; const float cpc = __builtin_bit_cast(float, __builtin_amdgcn_readlane(__builtin_bit_cast(int, cpre), (j - 1) >> 1)); const float cpn = __builtin_bit_cast(float, __builtin_amdgcn_readlane(__builtin_bit_cast(int, cpre), (j > 1 ? j - 2 : 0) >> 1)); const float fpv = j > 1 ? __builtin_bit_cast(float, __builtin_amdgcn_readlane(__builtin_bit_cast(int, fx1), 63)) + cpn : 0.f; gtile(L, fxc, cpc, fpv, (sw == NSL - 1 ? 0 : sw + 1), lane, Fq); } \
        const int tw = j + pw_; int sr = sw - pw_; if (sr < 0) sr += NSL;       \
        if (tw < 0) wdone = true; \
        if (pend) { ATT_PV(pws, vas, vcs) pend = false; } \
        if (!wdone) { \
            const LAS unsigned char* Kb = L + sr * KBUF + kfb; const LAS unsigned char* Vb = L + sr * VBUF + vfb; \
            f32x16 p0, p1; \
            bf16x8 kf[8]; \
        _Pragma("unroll") \
            for (int d0 = 0; d0 < 4; ++d0) { kf[2 * d0] = *(const LAS bf16x8*)(Kb + d0 * 2 * KCH); kf[2 * d0 + 1] = *(const LAS bf16x8*)(Kb + d0 * 2 * KCH + 512); } \
            if (MODE == 0) { const LAS float* g = (const LAS float*)(L + OFF_G + sr * 272); \
        _Pragma("unroll") \
                for (int gq = 0; gq < 4; ++gq) { const f32x4 a = *(const LAS f32x4*)(g + 8 * gq + 4 * hi), c = *(const LAS f32x4*)(g + 32 + 8 * gq + 4 * hi); \
        _Pragma("unroll") \
                    for (int e = 0; e < 4; ++e) { p0[4 * gq + e] = a[e]; p1[4 * gq + e] = c[e]; } } \
            } else { p0 = f32x16{}; p1 = f32x16{}; } \
            __builtin_amdgcn_sched_barrier(0); \
        _Pragma("unroll") \
            for (int d0 = 0; d0 < 4; ++d0) { \
                p0 = __builtin_amdgcn_mfma_f32_32x32x16_bf16(kf[2 * d0], qr[d0], p0, 0, 0, 0); \
                p1 = __builtin_amdgcn_mfma_f32_32x32x16_bf16(kf[2 * d0 + 1], qr[d0], p1, 0, 0, 0); \
            } \
             \
        _Pragma("unroll") \
            for (int s = 0; s < 4; ++s) { vas[s][0] = vtr(Vb + s * 1024); vas[s][1] = vtr(Vb + s * 1024 + 512); vcs[s][0] = vtr(Vb + 4096 + s * 1024); vcs[s][1] = vtr(Vb + 4096 + s * 1024 + 512); } \
            __builtin_amdgcn_sched_barrier(0); \
            const bool diag = (it == 0); \
            if (MODE == 0) { \
                if (diag) { const int kb = 4 * hi; \
        _Pragma("unroll") \
                    for (int r = 0; r < 16; ++r) { const int kv = kb + (r & 3) + 8 * (r >> 2); if (kv > qloc) p0[r] = -INFINITY; if (kv + 32 > qloc) p1[r] = -INFINITY; } } \
                if (it_first) { const LAS float* fref = (const LAS float*)(L + OFF_FLAG + 64); cq = fref[0] - (flq + fref[1 + ((32 * w + r32) >> 7)]) + sshift; it_first = false; } \
                float ls = 0.f; \
        _Pragma("unroll") \
                for (int r = 0; r < 16; ++r) { p0[r] = ex2(p0[r] - cq); p1[r] = ex2(p1[r] - cq); ls += p0[r] + p1[r]; } \
                l += ls; \
                const float gnext = ((const LAS float*)(L + OFF_G + sr * 272))[64]; \
                wdone = __all(gnext <= cq - sbound37 + lg2(swap32_sum(l))); \
            } else { \
                const int kb = 4 * hi; \
                float sp0[16], sp1[16]; \
        _Pragma("unroll") \
                for (int r = 0; r < 16; ++r) { \
                    const float x0 = p0[r], x1 = p1[r]; \
                    sp0[r] = fmaxf(x0, 0.f) + lg2(1.f + ex2(-fabsf(x0))); sp1[r] = fmaxf(x1, 0.f) + lg2(1.f + ex2(-fabsf(x1))); \
                } \
                if (diag) { \
        _Pragma("unroll") \
                    for (int r = 0; r < 16; ++r) { const int kv = kb + (r & 3) + 8 * (r >> 2); if (kv >= qloc) { sp0[r] = 0.f; p0[r] = -INFINITY; } if (kv + 32 >= qloc) { sp1[r] = 0.f; p1[r] = -INFINITY; } } } \
                float To[8], Tp[8], PT[8]; \
        _Pragma("unroll") \
                for (int i = 0; i < 4; ++i) { To[i] = -((sp0[4 * i] + sp0[4 * i + 1]) + (sp0[4 * i + 2] + sp0[4 * i + 3])); To[4 + i] = -((sp1[4 * i] + sp1[4 * i + 1]) + (sp1[4 * i + 2] + sp1[4 * i + 3])); } \
        _Pragma("unroll") \
                for (int i = 0; i < 8; ++i) { Tp[i] = swap32_other(To[i], hi); PT[i] = To[i] + Tp[i]; } \
                float above[8]; float run = 0.f; \
        _Pragma("unroll") \
                for (int i = 7; i >= 0; --i) { above[i] = R + run + (hi == 0 ? Tp[i] : 0.f); run += PT[i]; } \
        _Pragma("unroll") \
                for (int i = 0; i < 4; ++i) { \
                    float s = above[i]; \
        _Pragma("unroll") \
                    for (int e = 3; e >= 0; --e) { const int r = 4 * i + e; p0[r] = ex2(p0[r] - sp0[r] + s); s -= sp0[r]; } \
                    s = above[4 + i]; \
        _Pragma("unroll") \
                    for (int e = 3; e >= 0; --e) { const int r = 4 * i + e; p1[r] = ex2(p1[r] - sp1[r] + s); s -= sp1[r]; } \
                } \
                R += run; \
                wdone = __all(R <= -40.f); \
            } \
        _Pragma("unroll") \
            for (int i = 0; i < 8; ++i) { pws[i] = cvtpk(p0[2 * i], p0[2 * i + 1]); pws[8 + i] = cvtpk(p1[2 * i], p1[2 * i + 1]); } \
            __builtin_amdgcn_sched_barrier(0); \
            if (late) { pend = true; } else ATT_PV(pws, vas, vcs) \
        } \
        if (lane == 0) flags[(it & 1) * 8 + w] = wdone ? 1u : 0u; \
        sw = (sw == NSL - 1) ? 0 : sw + 1; \
        --j; ++it; if (j + 3 < 0) stop = true; } \
        DSTAMP(t2_); DACC(); \
    }
    while (!stop) { ATT_STEP(kreg, vreg); if (stop) break; ATT_STEP(kreg2, vreg2); }
#undef ATT_STEP
    if (pend) { ATT_PV(pws, vas, vcs) pend = false; }
#undef ATT_PV
#if DIAG && defined(DIAG_ATT)
    if (MODE == 0 && blockIdx.x == 0 && tid == 0) atomicAdd((unsigned*)(ws + WS_TS) + 100, (unsigned)it);
#endif
    if (MODE == 0) {
        l = swap32_sum(l);
        if (hi == 0) wsf[r32] = 1.0f / l;
#pragma unroll
        for (int gq = 0; gq < 4; ++gq) { const f32x4 a = *(const LAS f32x4*)(wsf + 8 * gq + 4 * hi);
#pragma unroll
            for (int e = 0; e < 4; ++e) { o0[4 * gq + e] *= a[e]; o1[4 * gq + e] *= a[e]; } }
    }
    LAS bf16* stg = (LAS bf16*)(L + OFF_OST) + w * 2048;
#pragma unroll
    for (int r = 0; r < 16; ++r) { const int orow = crow(r, hi); stg[orow * 64 + r32] = (bf16)f2bf(o0[r]); stg[orow * 64 + 32 + r32] = (bf16)f2bf(o1[r]); }
    bf16* Ow = (bf16*)(ws + WS_CAT) + (size_t)(b * T + q0 + w * 32) * D + h * HD;
#pragma unroll
    for (int i = 0; i < 4; ++i) { const int row = i * 8 + (lane >> 3), ch = lane & 7; const v4u v = *(const LAS v4u*)(stg + row * 64 + ch * 8); __builtin_nontemporal_store(v, (v4u*)(Ow + (size_t)row * D + ch * 8)); }
    __syncthreads();
}
}

#if DIAG && defined(DIAG_STG)
#define STG_INIT() long long stg_t_ = clock64()
#define STG(k) do { const long long n_ = clock64(); if (blockIdx.x == 0 && (tid & 63) == 0 && (tid >> 6) == 0) atomicAdd((unsigned long long*)(ws + WS_TS) + 64 + (k), (unsigned long long)(n_ - stg_t_)); stg_t_ = n_; } while (0)
#else
#define STG_INIT() do {} while (0)
#define STG(k) do {} while (0)
#endif
namespace ssd {
using att::bf16x8; using att::s16x4; using att::f32x16; using att::vtr; using att::crow; using att::ex2; using att::cvtpk;
constexpr int TAB_DT = 0, TAB_A = 2048, TAB_X = 4096;
constexpr int A_XD = 8192, A_B = A_XD + 65536;
constexpr int BKCH = 2064, C_BK = 8192, C_XDT = 24832, C_ST = C_XDT + 65536;
static_assert(C_BK + 8 * BKCH <= C_XDT && C_ST + 8 * 4096 <= 131072 && A_B + 16384 <= 131072, "ssd LDS map");
__device__ __forceinline__ int vimg_off(int s, int col) { return (((col >> 5) << 2) + (s >> 4)) * 1024 + (s & 15) * 64 + (col & 31) * 2; }
__device__ __forceinline__ bf16x8 trpair(const LAS unsigned char* p) { const s16x4 a = vtr(p), c = vtr(p + 512); return (bf16x8){a[0], a[1], a[2], a[3], c[0], c[1], c[2], c[3]}; }
__device__ __forceinline__ void unpack8(v4u w, float (&f)[8]) {
#pragma unroll
    for (int e = 0; e < 4; ++e) { f[2 * e] = __builtin_bit_cast(float, w[e] << 16); f[2 * e + 1] = __builtin_bit_cast(float, w[e] & 0xffff0000u); } }
__device__ __forceinline__ v4u pack8f(const float (&f)[8]) { v4u w; w.x = cvtpk(f[0], f[1]); w.y = cvtpk(f[2], f[3]); w.z = cvtpk(f[4], f[5]); w.w = cvtpk(f[6], f[7]); return w; }

__device__ __forceinline__ void fl_unit(LAS unsigned char* L, unsigned char* ws, const float* fbias, int b, int g, int c, int tid) {
    asm volatile("" : "+v"(tid));
    const int lane = tid & 63, w = __builtin_amdgcn_readfirstlane(tid >> 6); LAS float* wtot = (LAS float*)(L + TAB_X);
    const int hh = tid >> 7, s = tid & 127, hd = 4 * g + hh, row0 = b * T + c * 128;
    const float fx = ((const float*)(ws + WS_FD))[(size_t)(row0 + s) * 16 + hd] + fbias[hd];
    float f = fminf(fx, 0.f) * LOG2E - att::lg2(1.f + ex2(-fabsf(fx) * LOG2E));
#pragma unroll
    for (int o = 1; o < 64; o <<= 1) { const float t2 = bperm(lane - o, f); if (lane >= o) f += t2; }
    if (lane == 63) wtot[w] = f;
    __syncthreads();
    if (w & 1) f += wtot[w - 1];
    __hip_atomic_store((float*)(ws + WS_FLOC) + (size_t)(b * 8 + hd) * T + c * 128 + s, f, __ATOMIC_RELAXED, __HIP_MEMORY_SCOPE_AGENT);
    if (s == 127) __hip_atomic_store((float*)(ws + WS_FTOT) + (b * 8 + hd) * 64 + c, f, __ATOMIC_RELAXED, __HIP_MEMORY_SCOPE_AGENT);
    __syncthreads();
}
__device__ __forceinline__ void pass_a_unit(LAS unsigned char* L, unsigned char* ws, const float* convw, const float* convb, const float* dtb, const float* alog, int b, int g, int c, int tid) {
    asm volatile("" : "+v"(tid));
    int lane = tid & 63; const int w = __builtin_amdgcn_readfirstlane(tid >> 6), r32 = lane & 31, hi = lane >> 5;
    const int row0 = b * T + c * 128;
    LAS float* dtab = (LAS float*)(L + TAB_DT); LAS float* atab = (LAS float*)(L + TAB_A); LAS float* wtot = (LAS float*)(L + TAB_X);
    float* DTA = (float*)(ws + WS_DTA); const float* FD = (const float*)(ws + WS_FD);
    {
        const int hh = tid >> 7, s = tid & 127, hd = 4 * g + hh;
        const float dt = softplus_f(FD[(size_t)(row0 + s) * 16 + 8 + hd] + dtb[hd]);
        float v = dt * (-__expf(alog[hd])) * LOG2E;
        int ln = lane; asm volatile("" : "+v"(ln));
#pragma unroll
        for (int o = 1; o < 64; o <<= 1) { const float t = bperm(ln - o, v); if (ln >= o) v += t; }
        if (ln == 63) wtot[w] = v;
        __syncthreads();
        if (w & 1) v += wtot[w - 1];
        dtab[hh * 128 + s] = dt; atab[hh * 128 + s] = v;
        DTA[(size_t)(row0 + s) * 16 + hd] = dt; DTA[(size_t)(row0 + s) * 16 + 8 + hd] = v;
        if (s == 127) __hip_atomic_store((float*)(ws + WS_CHD) + (b * 8 + hd) * 64 + c, v, __ATOMIC_RELAXED, __HIP_MEMORY_SCOPE_AGENT);
        __syncthreads();
    }
    if (lane < 48) {
        const int col = lane < 32 ? 256 * g + 8 * lane : (lane < 40 ? 512 + 64 * g + 8 * (lane - 32) : 640 + 64 * g + 8 * (lane - 40));
        float wk[4][8], bs[8];
#pragma unroll
        for (int e = 0; e < 8; ++e) { bs[e] = convb[col + e];
#pragma unroll
            for (int k = 0; k < 4; ++k) wk[k][e] = convw[k * 768 + col + e]; }
        const bf16* xb = (const bf16*)(ws + WS_XBC) + col; bf16* xc = (bf16*)(ws + WS_XC) + col;
        const int s0 = 16 * w, t0 = c * 128 + s0;
        v4u rw[19]; const v4u zz = {0u, 0u, 0u, 0u};
#pragma unroll
        for (int i = 0; i < 19; ++i) rw[i] = (t0 + i >= 3) ? *(const v4u*)(xb + (size_t)(row0 + s0 + i - 3) * 768) : zz;
        const int hh = lane >> 3;
        const float alast = lane < 32 ? atab[hh * 128 + 127] : 0.f;
#pragma unroll
        for (int i = 0; i < 16; ++i) { const int s = s0 + i;
            float r0[8], r1[8], r2[8], cu[8], o[8];
            unpack8(rw[i], r0); unpack8(rw[i + 1], r1); unpack8(rw[i + 2], r2); unpack8(rw[i + 3], cu);
#pragma unroll
            for (int e = 0; e < 8; ++e) { const float v = bs[e] + wk[0][e] * r0[e] + wk[1][e] * r1[e] + wk[2][e] * r2[e] + wk[3][e] * cu[e]; o[e] = silu_f(v); }
            __builtin_nontemporal_store(pack8f(o), (v4u*)(xc + (size_t)(row0 + s) * 768));
            if (lane < 32) { const float sc = dtab[hh * 128 + s] * ex2(alast - atab[hh * 128 + s]);
#pragma unroll
                for (int e = 0; e < 8; ++e) o[e] *= sc;
                *(LAS v4u*)(L + A_XD + ((s >> 6) * 4 + hh) * 8192 + vimg_off(s & 63, (8 * lane) & 63)) = pack8f(o);
            } else if (lane < 40) { *(LAS v4u*)(L + A_B + (s >> 6) * 8192 + vimg_off(s & 63, 8 * (lane - 32))) = pack8f(o); }
        }
    }
    __syncthreads();
    {
        const int hh = w >> 1, ph = w & 1;
        const unsigned vfb = ((lane >> 4) & 1) * 32 + (lane & 3) * 8 + (4 * hi + ((lane & 15) >> 2)) * 64;
        f32x16 acc0 = {}, acc1 = {};
#pragma unroll
        for (int ks = 0; ks < 8; ++ks) { const int sh = ks >> 2, k16 = ks & 3;
            const bf16x8 A = trpair(L + A_XD + (sh * 4 + hh) * 8192 + vfb + ph * 4096 + k16 * 1024);
            const bf16x8 B0 = trpair(L + A_B + sh * 8192 + vfb + k16 * 1024), B1 = trpair(L + A_B + sh * 8192 + vfb + 4096 + k16 * 1024);
            acc0 = __builtin_amdgcn_mfma_f32_32x32x16_bf16(A, B0, acc0, 0, 0, 0); acc1 = __builtin_amdgcn_mfma_f32_32x32x16_bf16(A, B1, acc1, 0, 0, 0); }
        float* loc = (float*)(ws + WS_SLOC) + ((size_t)((b * 8 + 4 * g + hh) * 64 + c)) * 4096;
#pragma unroll
        for (int r = 0; r < 16; ++r) { const int p = 32 * ph + crow(r, hi); __hip_atomic_store(loc + p * 64 + r32, acc0[r], __ATOMIC_RELAXED, __HIP_MEMORY_SCOPE_AGENT); __hip_atomic_store(loc + p * 64 + 32 + r32, acc1[r], __ATOMIC_RELAXED, __HIP_MEMORY_SCOPE_AGENT); }
    }
    __syncthreads();
}
__device__ __forceinline__ void pass_b(unsigned char* ws, int bx, int G, int tid) {
    if (tid >= 128) return;
    typedef float f32x2v __attribute__((ext_vector_type(2)));
    const float* loc = (const float*)(ws + WS_SLOC); const float* chd = (const float*)(ws + WS_CHD); bf16* prev = (bf16*)(ws + WS_SPREV);
    for (int e = bx * 256 + 2 * tid; e < 65536; e += G * 256) { const int bh = e >> 12, pn = e & 4095; f32x2v S = {0.f, 0.f};
        for (int c0 = 0; c0 < 64; c0 += 32) { f32x2v lv[32]; float dd[32];
#pragma unroll
            for (int i = 0; i < 32; ++i) { const int u = bh * 64 + c0 + i; lv[i] = *(const f32x2v*)(loc + (size_t)u * 4096 + pn); dd[i] = chd[u]; }
#pragma unroll
            for (int i = 0; i < 32; ++i) { const int u = bh * 64 + c0 + i; *(unsigned*)(prev + (size_t)u * 4096 + pn) = cvtpk(S[0], S[1]); S = S * ex2(dd[i]) + lv[i]; } } }
}
__device__ __forceinline__ void pass_c_unit(LAS unsigned char* L, unsigned char* ws, const float* dskip, const float* normw, int b, int g, int c, int tid) {
    asm volatile("" : "+v"(tid));
    const int w = __builtin_amdgcn_readfirstlane(tid >> 6);
    const int row0 = b * T + c * 128;
    STG_INIT();
    LAS float* dtab = (LAS float*)(L + TAB_DT); LAS float* atab = (LAS float*)(L + TAB_A); LAS float* part = (LAS float*)(L + TAB_X);
    const float* DTA = (const float*)(ws + WS_DTA); const bf16* XC = (const bf16*)(ws + WS_XC);
    { const int hh = tid >> 7, s = tid & 127; dtab[hh * 128 + s] = DTA[(size_t)(row0 + s) * 16 + 4 * g + hh]; atab[hh * 128 + s] = DTA[(size_t)(row0 + s) * 16 + 8 + 4 * g + hh]; }
    {
        const int s = tid >> 3, ch = tid & 7;
#pragma unroll
        for (int i = 0; i < 2; ++i) { const int ss = s + 64 * i; *(LAS v4u*)(L + C_BK + ch * BKCH + ss * 16) = *(const v4u*)(XC + (size_t)(row0 + ss) * 768 + 512 + 64 * g + 8 * ch); }
    }
    __syncthreads(); STG(0);
    asm volatile("" : "+v"(tid));
    {
#pragma unroll
        for (int i = 0; i < 8; ++i) { const int idx = tid + 512 * i, s = idx >> 5, oc = idx & 31, hh = oc >> 3; float f[8];
            unpack8(*(const v4u*)(XC + (size_t)(row0 + s) * 768 + 256 * g + 8 * oc), f); const float dt = dtab[hh * 128 + s];
#pragma unroll
            for (int e = 0; e < 8; ++e) f[e] *= dt;
            *(LAS v4u*)(L + C_XDT + ((s >> 6) * 4 + hh) * 8192 + vimg_off(s & 63, (8 * oc) & 63)) = pack8f(f); }
    }
    __syncthreads(); STG(1);
    asm volatile("" : "+v"(tid));
    const int lane = tid & 63, r32 = lane & 31, hi = lane >> 5;
    const int hh = w >> 1, pair = w & 1, hd = 4 * g + hh;
    const unsigned vfb = ((lane >> 4) & 1) * 32 + (lane & 3) * 8 + (4 * hi + ((lane & 15) >> 2)) * 64;
    const bf16* prevp = (const bf16*)(ws + WS_SPREV) + ((size_t)((b * 8 + hd) * 64 + c)) * 4096;
    const float Dk = dskip[hd];
    float yv[2][2][16];
#pragma unroll
    for (int i = 0; i < 2; ++i) { const int lb = i == 0 ? pair : 3 - pair;
        v4u zreg[4];
#pragma unroll
        for (int i4 = 0; i4 < 4; ++i4) { const int idx = lane + 64 * i4; zreg[i4] = *(const v4u*)((const bf16*)(ws + WS_Z) + (size_t)(row0 + 32 * lb + (idx >> 3)) * 512 + 256 * g + 64 * hh + 8 * (idx & 7)); }
        bf16x8 cf[4];
#pragma unroll
        for (int st = 0; st < 4; ++st) cf[st] = *(const bf16x8*)(XC + (size_t)(row0 + 32 * lb + r32) * 768 + 640 + 64 * g + 16 * st + 8 * hi);
        const float al = atab[hh * 128 + 32 * lb + r32];
        f32x16 Y0 = {}, Y1 = {};
        for (int sb = 0; sb <= lb; ++sb) {
            f32x16 X = {};
#pragma unroll
            for (int st = 0; st < 4; ++st) { const bf16x8 kf = *(const LAS bf16x8*)(L + C_BK + (2 * st + hi) * BKCH + (32 * sb + r32) * 16); X = __builtin_amdgcn_mfma_f32_32x32x16_bf16(kf, cf[st], X, 0, 0, 0); }
            unsigned pw[8];
#pragma unroll
            for (int gq = 0; gq < 4; ++gq) { const f32x4 as = *(const LAS f32x4*)(atab + hh * 128 + 32 * sb + 8 * gq + 4 * hi);
#pragma unroll
                for (int e = 0; e < 4; ++e) { const int r = 4 * gq + e; float p = X[r] * ex2(al - as[e]); if (sb == lb && crow(r, hi) > r32) p = 0.f; X[r] = p; } }
#pragma unroll
            for (int q = 0; q < 8; ++q) pw[q] = cvtpk(X[2 * q], X[2 * q + 1]);
            const LAS unsigned char* img = L + C_XDT + ((sb >> 1) * 4 + hh) * 8192 + vfb + (2 * (sb & 1)) * 1024;
#pragma unroll
            for (int k = 0; k < 2; ++k) { const v4u pa_ = {pw[4 * k], pw[4 * k + 1], pw[4 * k + 2], pw[4 * k + 3]}; const bf16x8 pa = __builtin_bit_cast(bf16x8, pa_);
                const bf16x8 v0 = trpair(img + k * 1024), v1 = trpair(img + 4096 + k * 1024);
                Y0 = __builtin_amdgcn_mfma_f32_32x32x16_bf16(pa, v0, Y0, 0, 0, 0); Y1 = __builtin_amdgcn_mfma_f32_32x32x16_bf16(pa, v1, Y1, 0, 0, 0); }
        }
        f32x16 Z0 = {}, Z1 = {};
        { bf16x8 pf0[4], pf1[4];
#pragma unroll
          for (int st = 0; st < 4; ++st) { pf0[st] = *(const bf16x8*)(prevp + (size_t)r32 * 64 + 16 * st + 8 * hi); pf1[st] = *(const bf16x8*)(prevp + (size_t)(32 + r32) * 64 + 16 * st + 8 * hi); }
          __builtin_amdgcn_sched_barrier(0);
#pragma unroll
          for (int st = 0; st < 4; ++st) { Z0 = __builtin_amdgcn_mfma_f32_32x32x16_bf16(cf[st], pf0[st], Z0, 0, 0, 0); Z1 = __builtin_amdgcn_mfma_f32_32x32x16_bf16(cf[st], pf1[st], Z1, 0, 0, 0); } }
        {   LAS unsigned char* zst = L + C_ST + w * 4096;
#pragma unroll
            for (int i4 = 0; i4 < 4; ++i4) { const int idx = lane + 64 * i4; *(LAS v4u*)(zst + (idx >> 3) * 128 + (idx & 7) * 16) = zreg[i4]; }
            unsigned short xr0[16], xr1[16], zr0[16], zr1[16]; float rdt[16];
#pragma unroll
            for (int gq = 0; gq < 4; ++gq) { const f32x4 d4 = *(const LAS f32x4*)(dtab + hh * 128 + 32 * lb + 8 * gq + 4 * hi);
#pragma unroll
                for (int e = 0; e < 4; ++e) { const int r = 4 * gq + e, ll = crow(r, hi), l = 32 * lb + ll;
                    const LAS unsigned char* xi = L + C_XDT + ((l >> 6) * 4 + hh) * 8192 + vimg_off(l & 63, r32);
                    xr0[r] = *(const LAS unsigned short*)xi; xr1[r] = *(const LAS unsigned short*)(xi + 4096);
                    zr0[r] = *(const LAS unsigned short*)(zst + ll * 128 + r32 * 2); zr1[r] = *(const LAS unsigned short*)(zst + ll * 128 + 64 + r32 * 2);
                    rdt[r] = 1.0f / d4[e]; } }
            float qs[16];
#pragma unroll
            for (int gq = 0; gq < 4; ++gq) { const f32x4 a4 = *(const LAS f32x4*)(atab + hh * 128 + 32 * lb + 8 * gq + 4 * hi);
#pragma unroll
                for (int e = 0; e < 4; ++e) { const int r = 4 * gq + e; const float el = ex2(a4[e]);
                    float y0 = Y0[r] + Z0[r] * el + Dk * rdt[r] * bf2f(xr0[r]), y1 = Y1[r] + Z1[r] * el + Dk * rdt[r] * bf2f(xr1[r]);
                    y0 *= silu_f(bf2f(zr0[r])); y1 *= silu_f(bf2f(zr1[r]));
                    yv[i][0][r] = y0; yv[i][1][r] = y1; qs[r] = y0 * y0 + y1 * y1; } }
            const int lx = lane;
#pragma unroll
            for (int o = 1; o < 32; o <<= 1) {
#pragma unroll
                for (int r = 0; r < 16; ++r) qs[r] += bperm(lx ^ o, qs[r]); }
#pragma unroll
            for (int r = 0; r < 16; ++r) if (r32 == 0) part[hh * 128 + 32 * lb + crow(r, hi)] = qs[r];
        }
    }
    __syncthreads(); STG(2);
    bf16* cat = (bf16*)(ws + WS_CAT);
    const int cc = 256 * g + 64 * hh + r32; const float nw0 = normw[cc], nw1 = normw[cc + 32];
    LAS unsigned char* ost = L + C_ST + w * 4096;
#pragma unroll
    for (int i = 0; i < 2; ++i) { const int lb = i == 0 ? pair : 3 - pair;
#pragma unroll
        for (int r = 0; r < 16; ++r) { const int ll = crow(r, hi), l = 32 * lb + ll; const float tot = (part[l] + part[128 + l]) + (part[256 + l] + part[384 + l]);
            const float rs = 1.0f / sqrtf(tot * (1.f / 256.f) + EPS);
            *(LAS bf16*)(ost + ll * 128 + r32 * 2) = (bf16)f2bf(yv[i][0][r] * rs * nw0); *(LAS bf16*)(ost + ll * 128 + 64 + r32 * 2) = (bf16)f2bf(yv[i][1][r] * rs * nw1); }
#pragma unroll
        for (int i4 = 0; i4 < 4; ++i4) { const int idx = lane + 64 * i4; const v4u v = *(const LAS v4u*)(ost + (idx >> 3) * 128 + (idx & 7) * 16);
            *(v4u*)(cat + (size_t)(row0 + 32 * lb + (idx >> 3)) * D + 512 + 256 * g + 64 * hh + 8 * (idx & 7)) = v; }
    }
    __syncthreads(); STG(3);
}
}

namespace gla {
using att::bf16x8; using att::s16x4; using att::f32x16; using att::vtr; using att::crow; using att::ex2; using att::cvtpk; using att::lg2;
using ssd::vimg_off; using ssd::trpair; using ssd::BKCH;
constexpr int A_GLOW = 0, A_WT = 8192, A_KI = 10240, A_VI = A_KI + 16384, A_GS = A_VI + 32768, A_PRE = A_GS + 32768;
constexpr int C_PART = 0, C_BK = 8192, C_VI = 24832;
static_assert(A_PRE + 2048 + 256 <= 131072 && C_BK + 8 * BKCH <= C_VI && C_VI + 32768 + 8 * 2048 <= 131072, "gla LDS map");
typedef float f32x4v __attribute__((ext_vector_type(4)));
__device__ __forceinline__ void pass_a_unit(LAS unsigned char* L, unsigned char* ws, const float* w2, const float* gb, int b, int h, int c, int tid) {
    asm volatile("" : "+v"(tid));
    const int lane = tid & 63, w = __builtin_amdgcn_readfirstlane(tid >> 6), r32 = lane & 31, hi = lane >> 5;
    const int row0 = b * T + c * 128, u = (b * 4 + h) * 64 + c;
    STG_INIT();
    LAS float* glow = (LAS float*)(L + A_GLOW); LAS float* wt = (LAS float*)(L + A_WT);
    {
        constexpr int WROW = 2064, AROW = 528, G_WG = 10240, G_AST = G_WG + 16 * WROW;
        static_assert(G_AST + 8 * 16 * AROW <= 131072, "gla g_low LDS map");
        const bf16* wgp = (const bf16*)(ws + WS_WCD) + (size_t)3072 * D;
#pragma unroll
        for (int i = 0; i < 4; ++i) { const int idx = tid + 512 * i, r = idx >> 7, pc = idx & 127; *(LAS v4u*)(L + G_WG + r * WROW + pc * 16) = *(const v4u*)(wgp + (size_t)r * D + pc * 8); }
        v4u areg[4][8];
        const bf16* hbw = (const bf16*)(ws + WS_HB) + (size_t)(row0 + 16 * w) * D;
#pragma unroll
        for (int q = 0; q < 4; ++q)
#pragma unroll
            for (int i = 0; i < 8; ++i) { const int idx = lane + 64 * i, r = idx >> 5, pc = idx & 31; areg[q][i] = *(const v4u*)(hbw + (size_t)r * D + q * 256 + pc * 8); }
        __syncthreads();
        LAS unsigned char* al = L + G_AST + w * (16 * AROW);
        const int fr = lane & 15, kq = lane >> 4;
        f32x4v acc = {0.f, 0.f, 0.f, 0.f};
#pragma unroll
        for (int q = 0; q < 4; ++q) {
#pragma unroll
            for (int i = 0; i < 8; ++i) { const int idx = lane + 64 * i, r = idx >> 5, pc = idx & 31; *(LAS v4u*)(al + r * AROW + pc * 16) = areg[q][i]; }
#pragma unroll
            for (int st = 0; st < 8; ++st) { const bf16x8 a = *(const LAS bf16x8*)(al + fr * AROW + (32 * st + 8 * kq) * 2), bb = *(const LAS bf16x8*)(L + G_WG + fr * WROW + (q * 256 + 32 * st + 8 * kq) * 2);
                acc = __builtin_amdgcn_mfma_f32_16x16x32_bf16(a, bb, acc, 0, 0, 0); }
        }
#pragma unroll
        for (int e = 0; e < 4; ++e) { const int s = 16 * w + 4 * (lane >> 4) + e; glow[s * 16 + (lane & 15)] = acc[e] * row_rstd((const float*)(ws + WS_SSQ), row0 + s); }
    }
    __syncthreads(); STG(4);
    {
        const bf16* gv = (const bf16*)(ws + WS_Z);
#pragma unroll
        for (int i = 0; i < 4; ++i) { const int idx = tid + 512 * i, s = idx >> 4, oc = idx & 15;
            *(LAS v4u*)(L + A_VI + ((s >> 6) * 2 + (oc >> 3)) * 8192 + vimg_off(s & 63, (8 * oc) & 63)) = *(const v4u*)(gv + (size_t)(row0 + s) * 512 + 128 * h + 8 * oc); }
    }
    const int k = lane;
    LAS float* gtab = (LAS float*)(L + A_GS); LAS float* pretab = (LAS float*)(L + A_PRE); LAS float* tottab = pretab + 512;
    {   float wc[16];
#pragma unroll
        for (int r = 0; r < 16; ++r) wc[r] = w2[r * 256 + 64 * h + k];
        const float bk = gb[64 * h + k]; float run = 0.f;
#pragma unroll
        for (int i = 0; i < 16; ++i) { const int s = 16 * w + i; float x = bk;
#pragma unroll
            for (int q = 0; q < 4; ++q) { const f32x4v gl4 = *(const LAS f32x4v*)(glow + s * 16 + 4 * q);
#pragma unroll
                for (int e = 0; e < 4; ++e) x += gl4[e] * wc[4 * q + e]; }
            const float la = (fminf(x, 0.f) * LOG2E - lg2(1.f + ex2(-fabsf(x) * LOG2E))) * (1.f / 16.f);
            run += la; gtab[s * 64 + k] = run; }
        wt[w * 64 + k] = run;
    }
    __syncthreads(); STG(5);
    {   float pre = 0.f;
#pragma unroll
        for (int q = 0; q < 8; ++q) { const float t = wt[q * 64 + k]; if (q < w) pre += t; }
        pretab[w * 64 + k] = pre; if (w == 7) tottab[k] = pre + wt[7 * 64 + k];
    }
    __syncthreads();
    {
        bf16* gq = (bf16*)(ws + WS_XBC) + 64 * h; bf16* gk = (bf16*)(ws + WS_XBC + 8 * MiB) + 64 * h;
        v4u qv[2], kv[2];
#pragma unroll
        for (int i = 0; i < 2; ++i) { const int idx = tid + 512 * i, s = idx >> 3, oc = idx & 7; const size_t o = (size_t)(row0 + s) * 256 + 8 * oc; qv[i] = *(const v4u*)(gq + o); kv[i] = *(const v4u*)(gk + o); }
#pragma unroll
        for (int i = 0; i < 2; ++i) { const int idx = tid + 512 * i, s = idx >> 3, oc = idx & 7; const size_t o = (size_t)(row0 + s) * 256 + 8 * oc;
            float qf_[8], kf_[8], gs[8], tt[8], oq[8], ok[8], okk[8];
            ssd::unpack8(qv[i], qf_); ssd::unpack8(kv[i], kf_);
#pragma unroll
            for (int hq = 0; hq < 2; ++hq) { const f32x4v g4 = *(const LAS f32x4v*)(gtab + s * 64 + 8 * oc + 4 * hq), p4 = *(const LAS f32x4v*)(pretab + (s >> 4) * 64 + 8 * oc + 4 * hq), t4 = *(const LAS f32x4v*)(tottab + 8 * oc + 4 * hq);
#pragma unroll
                for (int e = 0; e < 4; ++e) { gs[4 * hq + e] = g4[e] + p4[e]; tt[4 * hq + e] = t4[e]; } }
#pragma unroll
            for (int e = 0; e < 8; ++e) { oq[e] = qf_[e] * ex2(gs[e]); ok[e] = kf_[e] * ex2(-gs[e]); okk[e] = kf_[e] * ex2(tt[e] - gs[e]); }
            *(v4u*)(gq + o) = ssd::pack8f(oq); *(v4u*)(gk + o) = ssd::pack8f(ok);
            *(LAS v4u*)(L + A_KI + (s >> 6) * 8192 + vimg_off(s & 63, 8 * oc)) = ssd::pack8f(okk); }
        if (tid < 64) __hip_atomic_store((float*)(ws + WS_GDEC) + u * 64 + tid, tottab[tid], __ATOMIC_RELAXED, __HIP_MEMORY_SCOPE_AGENT);
    }
    __syncthreads(); STG(6);
    {
        const int vt = w >> 1, kh = w & 1;
        const unsigned vfb = ((lane >> 4) & 1) * 32 + (lane & 3) * 8 + (4 * hi + ((lane & 15) >> 2)) * 64;
        f32x16 acc = {};
#pragma unroll
        for (int ks = 0; ks < 8; ++ks) { const int sh = ks >> 2, k16 = ks & 3;
            const bf16x8 A = trpair(L + A_VI + (sh * 2 + (vt >> 1)) * 8192 + vfb + (vt & 1) * 4096 + k16 * 1024);
            const bf16x8 Bf = trpair(L + A_KI + sh * 8192 + vfb + kh * 4096 + k16 * 1024);
            acc = __builtin_amdgcn_mfma_f32_32x32x16_bf16(A, Bf, acc, 0, 0, 0); }
        float* loc = (float*)(ws + WS_GLOC) + (size_t)u * 8192;
#pragma unroll
        for (int r = 0; r < 16; ++r) __hip_atomic_store(loc + (32 * vt + crow(r, hi)) * 64 + 32 * kh + r32, acc[r], __ATOMIC_RELAXED, __HIP_MEMORY_SCOPE_AGENT);
    }
    __syncthreads(); STG(7);
}
__device__ __forceinline__ void pass_b(unsigned char* ws, int bx, int G, int tid) {
    if (tid >= 128) return;
    typedef float f32x2v __attribute__((ext_vector_type(2)));
    const float* loc = (const float*)(ws + WS_GLOC); const float* gdec = (const float*)(ws + WS_GDEC); bf16* prev = (bf16*)(ws + WS_GPREV);
    for (int e = bx * 256 + 2 * tid; e < 65536; e += G * 256) { const int bh = e >> 13, vk = e & 8191, k = e & 63; f32x2v S = {0.f, 0.f};
        for (int c0 = 0; c0 < 64; c0 += 16) { f32x2v lv[16], dd[16];
#pragma unroll
            for (int i = 0; i < 16; ++i) { const int u = bh * 64 + c0 + i; lv[i] = *(const f32x2v*)(loc + (size_t)u * 8192 + vk); dd[i] = *(const f32x2v*)(gdec + u * 64 + k); }
#pragma unroll
            for (int i = 0; i < 16; ++i) { const int u = bh * 64 + c0 + i; *(unsigned*)(prev + (size_t)u * 8192 + vk) = cvtpk(S[0], S[1]); S[0] = S[0] * ex2(dd[i][0]) + lv[i][0]; S[1] = S[1] * ex2(dd[i][1]) + lv[i][1]; } } }
}
__device__ __forceinline__ void pass_c_unit(LAS unsigned char* L, unsigned char* ws, const float* normw, int b, int h, int c, int tid) {
    asm volatile("" : "+v"(tid));
    const int w = __builtin_amdgcn_readfirstlane(tid >> 6);
    const int row0 = b * T + c * 128, u = (b * 4 + h) * 64 + c;
    LAS float* part = (LAS float*)(L + C_PART);
    const bf16* GQ = (const bf16*)(ws + WS_XBC); const bf16* GK = (const bf16*)(ws + WS_XBC + 8 * MiB); const bf16* GV = (const bf16*)(ws + WS_Z);
    {   const int s = tid >> 3, ch = tid & 7;
#pragma unroll
        for (int i = 0; i < 2; ++i) { const int ss = s + 64 * i; *(LAS v4u*)(L + C_BK + ch * BKCH + ss * 16) = *(const v4u*)(GK + (size_t)(row0 + ss) * 256 + 64 * h + 8 * ch); }
#pragma unroll
        for (int i = 0; i < 4; ++i) { const int idx = tid + 512 * i, s2 = idx >> 4, oc = idx & 15;
            *(LAS v4u*)(L + C_VI + ((s2 >> 6) * 2 + (oc >> 3)) * 8192 + vimg_off(s2 & 63, (8 * oc) & 63)) = *(const v4u*)(GV + (size_t)(row0 + s2) * 512 + 128 * h + 8 * oc); }
    }
    __syncthreads();
    asm volatile("" : "+v"(tid));
    const int lane = tid & 63, r32 = lane & 31, hi = lane >> 5;
    const int pair = w & 1, vt = w >> 1;
    const unsigned vfb = ((lane >> 4) & 1) * 32 + (lane & 3) * 8 + (4 * hi + ((lane & 15) >> 2)) * 64;
    const bf16* prevp = (const bf16*)(ws + WS_GPREV) + (size_t)u * 8192 + (size_t)(32 * vt + r32) * 64 + 8 * hi;
    f32x16 O[2];
#pragma unroll
    for (int i = 0; i < 2; ++i) { const int tb = i == 0 ? pair : 3 - pair;
        bf16x8 qf[4];
#pragma unroll
        for (int st = 0; st < 4; ++st) qf[st] = *(const bf16x8*)(GQ + (size_t)(row0 + 32 * tb + r32) * 256 + 64 * h + 16 * st + 8 * hi);
        f32x16 Oa = {};
        for (int sb = 0; sb <= tb; ++sb) {
            f32x16 X = {};
#pragma unroll
            for (int st = 0; st < 4; ++st) { const bf16x8 kf = *(const LAS bf16x8*)(L + C_BK + (2 * st + hi) * BKCH + (32 * sb + r32) * 16); X = __builtin_amdgcn_mfma_f32_32x32x16_bf16(kf, qf[st], X, 0, 0, 0); }
            unsigned pw[8];
            if (sb == tb) {
#pragma unroll
                for (int r = 0; r < 16; ++r) if (crow(r, hi) > r32) X[r] = 0.f; }
#pragma unroll
            for (int q = 0; q < 8; ++q) pw[q] = cvtpk(X[2 * q], X[2 * q + 1]);
            const LAS unsigned char* img = L + C_VI + ((sb >> 1) * 2 + (vt >> 1)) * 8192 + vfb + (vt & 1) * 4096 + (2 * (sb & 1)) * 1024;
#pragma unroll
            for (int kk = 0; kk < 2; ++kk) { const v4u pa_ = {pw[4 * kk], pw[4 * kk + 1], pw[4 * kk + 2], pw[4 * kk + 3]}; const bf16x8 pa = __builtin_bit_cast(bf16x8, pa_);
                Oa = __builtin_amdgcn_mfma_f32_32x32x16_bf16(pa, trpair(img + kk * 1024), Oa, 0, 0, 0); }
        }
        { bf16x8 pf[4];
#pragma unroll
          for (int st = 0; st < 4; ++st) pf[st] = *(const bf16x8*)(prevp + 16 * st);
          __builtin_amdgcn_sched_barrier(0);
#pragma unroll
          for (int st = 0; st < 4; ++st) Oa = __builtin_amdgcn_mfma_f32_32x32x16_bf16(qf[st], pf[st], Oa, 0, 0, 0); }
        O[i] = Oa;
        { float qs[16]; const int lx = lane;
#pragma unroll
          for (int r = 0; r < 16; ++r) qs[r] = Oa[r] * Oa[r];
#pragma unroll
          for (int o = 1; o < 32; o <<= 1) {
#pragma unroll
              for (int r = 0; r < 16; ++r) qs[r] += bperm(lx ^ o, qs[r]); }
#pragma unroll
          for (int r = 0; r < 16; ++r) if (r32 == 0) part[vt * 128 + 32 * tb + crow(r, hi)] = qs[r]; }
    }
    __syncthreads();
    const bf16* GR = (const bf16*)(ws + WS_GR); bf16* cat = (bf16*)(ws + WS_CAT);
    const int v = 32 * vt + r32; const float nw = normw[v];
    LAS unsigned char* st_ = L + C_VI + 32768 + w * 2048;
    v4u grv4[2][2];
#pragma unroll
    for (int i = 0; i < 2; ++i) { const int tb = i == 0 ? pair : 3 - pair;
#pragma unroll
        for (int q = 0; q < 2; ++q) { const int idx = lane + 64 * q; grv4[i][q] = *(const v4u*)(GR + (size_t)(row0 + 32 * tb + (idx >> 2)) * 512 + 128 * h + 32 * vt + 8 * (idx & 3)); } }
#pragma unroll
    for (int i = 0; i < 2; ++i) { const int tb = i == 0 ? pair : 3 - pair;
#pragma unroll
        for (int q = 0; q < 2; ++q) { const int idx = lane + 64 * q; *(LAS v4u*)(st_ + (idx >> 2) * 64 + (idx & 3) * 16) = grv4[i][q]; }
        float ov[16];
#pragma unroll
        for (int r = 0; r < 16; ++r) { const int tl = crow(r, hi), t = 32 * tb + tl; const float tot = (part[t] + part[128 + t]) + (part[256 + t] + part[384 + t]);
            const float rs = 1.0f / sqrtf(tot * (1.f / 128.f) + EPS);
            ov[r] = O[i][r] * rs * nw * silu_f(bf2f(*(const LAS unsigned short*)(st_ + tl * 64 + r32 * 2))); }
#pragma unroll
        for (int r = 0; r < 16; ++r) *(LAS bf16*)(st_ + crow(r, hi) * 64 + r32 * 2) = (bf16)f2bf(ov[r]);
#pragma unroll
        for (int q = 0; q < 2; ++q) { const int idx = lane + 64 * q; const v4u o4 = *(const LAS v4u*)(st_ + (idx >> 2) * 64 + (idx & 3) * 16);
            *(v4u*)(cat + (size_t)(row0 + 32 * tb + (idx >> 2)) * D + 512 + 128 * h + 32 * vt + 8 * (idx & 3)) = o4; }
    }
    __syncthreads();
}
}
constexpr int NWAVES = 8;
constexpr int RING_OFF = 0, RING_BYTES = 131072;
constexpr int LDSCTL_OFF = RING_BYTES, MISC_OFF = LDSCTL_OFF + 320;
constexpr int LDS_BYTES = 147456;
constexpr int EPI_RED_OFF = LDSCTL_OFF + 1024;
static_assert(EPI_RED_OFF + 4096 + 1024 <= LDS_BYTES, "LDS map");
constexpr int CW_TMO = 0, CW_BAR = 4096;
constexpr size_t CTL_ZERO_BYTES = 1 * MiB;
constexpr int PH_PRO = 0, PH_FINAL = 15, N_PHASES = 16;

#ifndef DIAG
#define DIAG 0
#endif
#ifndef DIAG_WAVE
#define DIAG_WAVE 1
#endif
#ifndef DIAG_MODE
#define DIAG_MODE 0
#endif
#ifndef DIAG_MASK_A
#define DIAG_MASK_A 0
#define DIAG_MASK_B 0
#endif
#if DIAG
#define PROBE(k) do { if (__builtin_amdgcn_mbcnt_hi(~0u, __builtin_amdgcn_mbcnt_lo(~0u, 0u)) == 0 && wave == 0) { const unsigned long long t_ = rt(); if (blockIdx.x == 0) __hip_atomic_store((unsigned long long*)(ws + WS_TS) + 17 + (k), t_, RLX_AGENT); atomicMax((unsigned long long*)(ws + WS_TS) + 40 + (k), t_); } } while (0)
#else
#define PROBE(k) do {} while (0)
#endif
struct Args { Bufs B; int ph_lo, ph_hi, li, pad; };

__device__ __forceinline__ void p0_transpose_item(const float* W, const float* gain, int K, int Nsrc, int Ndst, int mode, bf16* WT, LAS float* scr, int item, int lane) {
    const int nblk = Ndst / 32, kb = item / nblk, nb = item % nblk, k0 = 64 * kb, n0 = 32 * nb;
    const int n4 = 4 * (lane & 7), ksub = lane >> 3, nn = n0 + n4; const int s = mode == 0 ? nn : (mode == 1 ? src_col_ab(nn) : src_col_cd(nn));
    const float* src = W + (size_t)(k0 + ksub) * Nsrc + (s >= 0 ? s : 0);
    f32x4 v[8];
#pragma unroll
    for (int i = 0; i < 8; ++i) v[i] = *(const f32x4*)(src + (size_t)(8 * i) * Nsrc);
    if (gain) {
#pragma unroll
        for (int i = 0; i < 8; ++i) v[i] = v[i] * gain[k0 + 8 * i + ksub]; }
#pragma unroll
    for (int i = 0; i < 8; ++i) { LAS float* d = scr + (8 * i + ksub) * 33 + n4; const f32x4 x = s >= 0 ? v[i] : (f32x4){0.f, 0.f, 0.f, 0.f}; d[0] = x[0]; d[1] = x[1]; d[2] = x[2]; d[3] = x[3]; }
    LDS_WAIT(); asm volatile("" ::: "memory");
    const int c = lane & 7;
#pragma unroll
    for (int j = 0; j < 4; ++j) { const int n = (lane >> 3) + 8 * j; const LAS float* sp = scr + (8 * c) * 33 + n;
        v4u o; o.x = pk2(sp[0 * 33], sp[1 * 33]); o.y = pk2(sp[2 * 33], sp[3 * 33]); o.z = pk2(sp[4 * 33], sp[5 * 33]); o.w = pk2(sp[6 * 33], sp[7 * 33]);
        __builtin_nontemporal_store(o, (GAS v4u*)(WT + (size_t)(n0 + n) * K + k0 + 8 * c)); }
    LDS_WAIT(); asm volatile("" ::: "memory");
}
__device__ __forceinline__ float wave_sum(float v) { return red64_sum(v); }
constexpr int WI0 = 16 * 96, WI1 = 16 * 32, WI2 = 16 * 128, WI3 = 64 * 32, WI4 = 16 * 104, W_NITEMS = WI0 + WI1 + WI2 + WI3 + WI4 + WI1 + WI2 + WI3;
template <class AP> __device__ __forceinline__ void wconv_item(AP ap, const float* nmix, const float* nmlp, unsigned char* ws, LAS float* scr, int it, int lane) {
    int r = it;
    if (r < WI0) { p0_transpose_item(ap->B.in[I_WAB], nmix, D, AB_IN, NAB, 1, (bf16*)(ws + WS_WAB), scr, r, lane); return; } r -= WI0;
    if (r < WI1) { p0_transpose_item(ap->B.in[I_WOA], nullptr, D, D, D, 0, (bf16*)(ws + WS_WOA), scr, r, lane); return; } r -= WI1;
    if (r < WI2) { p0_transpose_item(ap->B.in[I_WUP], nmlp, D, FF, FF, 0, (bf16*)(ws + WS_WU0), scr, r, lane); return; } r -= WI2;
    if (r < WI3) { p0_transpose_item(ap->B.in[I_WDN], nullptr, FF, D, D, 0, (bf16*)(ws + WS_WD0), scr, r, lane); return; } r -= WI3;
    if (r < WI4) { p0_transpose_item(ap->B.in[I_WCD], nmix + D, D, CD_IN, NCDW, 2, (bf16*)(ws + WS_WCD), scr, r, lane); return; } r -= WI4;
    if (r < WI1) { p0_transpose_item(ap->B.in[I_WOC], nullptr, D, D, D, 0, (bf16*)(ws + WS_WOC), scr, r, lane); return; } r -= WI1;
    if (r < WI2) { p0_transpose_item(ap->B.in[I_WUP] + (size_t)D * FF, nmlp + D, D, FF, FF, 0, (bf16*)(ws + WS_WU1), scr, r, lane); return; } r -= WI2;
    p0_transpose_item(ap->B.in[I_WDN] + (size_t)FF * D, nullptr, FF, D, D, 0, (bf16*)(ws + WS_WD1), scr, r, lane);
}
__device__ __forceinline__ void unit_done_signal(gu32* cnt, int tid) {
    asm volatile("s_waitcnt vmcnt(0)" ::: "memory"); __syncthreads();
    if (tid == 0) __hip_atomic_fetch_add(cnt, 1u, RLX_AGENT);
}
__device__ __forceinline__ void units_wait(gu32* cnt, unsigned want, int tid) {
    if (tid == 0) { unsigned sp = 0u; while (__hip_atomic_load(cnt, RLX_AGENT) < want) { __builtin_amdgcn_s_sleep(4); if (++sp > (1u << 22)) break; }
        __builtin_amdgcn_fence(__ATOMIC_ACQUIRE, "agent"); asm volatile("s_waitcnt vmcnt(0)" ::: "memory"); }
    __syncthreads();
}

__global__ void __launch_bounds__(NWAVES * 64, 2) mk_fwd(Args a) {
    extern __shared__ __attribute__((aligned(16))) unsigned char lds[];
    LAS unsigned char* L = (LAS unsigned char*)lds;
    const int tid = threadIdx.x, wave0 = __builtin_amdgcn_readfirstlane(tid >> 6);
    unsigned char* ws0 = a.B.ws;
    for (int u = tid; u < (LDS_BYTES - LDSCTL_OFF) / 4; u += NWAVES * 64) ((LAS unsigned*)(L + LDSCTL_OFF))[u] = 0u;
    __syncthreads();
    XcdBarrier bar = xcd_barrier_post((unsigned*)(ws0 + WS_CTL) + CW_BAR + a.li * XCD_BAR_WORDS, (volatile LAS unsigned*)(L + MISC_OFF) + 8);

#if DIAG
    if (blockIdx.x == 0 && tid == 0) __hip_atomic_store((unsigned long long*)(ws0 + WS_TS), rt(), RLX_AGENT);
#endif
    for (int ph = a.ph_lo; ph < a.ph_hi; ++ph) {
        int lane_p = __builtin_amdgcn_mbcnt_hi(~0u, __builtin_amdgcn_mbcnt_lo(~0u, 0u)); asm volatile("" : "+v"(lane_p));
        typedef const __attribute__((address_space(4))) Args* KArgPtr;
        KArgPtr ap = (KArgPtr)__builtin_amdgcn_kernarg_segment_ptr(); asm volatile("" : "+s"(ap));
        unsigned char* ws = ap->B.ws;
        int bx_p = blockIdx.x, G = gridDim.x, wave = wave0; asm volatile("" : "+s"(bx_p), "+s"(G), "+s"(wave));
        const int gw = bx_p * NWAVES + wave, NGW = G * NWAVES;
        if (ph == PH_PRO) {
            LAS float* scr = (LAS float*)(L + RING_OFF + wave * 16384);
            constexpr int I0 = WI0;
            const float* nmix = ap->B.in[I_NMIX]; const float* nmlp = ap->B.in[I_NMLP];
            for (int it = gw; it < I0; it += NGW) wconv_item(ap, nmix, nmlp, ws, scr, it, lane_p);
            for (int m = gw; m < M; m += 2 * NGW) {
                const int m1 = m + NGW < M ? m + NGW : m;
                const GAS f32x4* xr0 = (const GAS f32x4*)(ap->B.in[I_X] + (size_t)m * D) + lane_p; const GAS f32x4* xr1 = (const GAS f32x4*)(ap->B.in[I_X] + (size_t)m1 * D) + lane_p;
                f32x4 v0[4], v1[4];
#pragma unroll
                for (int j = 0; j < 4; ++j) { v0[j] = xr0[64 * j]; v1[j] = xr1[64 * j]; }
#pragma unroll
                for (int q = 0; q < 2; ++q) { const int mm = q ? m1 : m; if (q && m1 == m) break;
                    GAS unsigned long long* o8 = (GAS unsigned long long*)((bf16*)(ws + WS_HB) + (size_t)mm * D) + lane_p; float sq = 0.f;
#pragma unroll
                    for (int j = 0; j < 4; ++j) { const f32x4 v = q ? v1[j] : v0[j]; sq += (v.x * v.x + v.y * v.y) + (v.z * v.z + v.w * v.w);
                        o8[64 * j] = (unsigned long long)pk2(v.x, v.y) | ((unsigned long long)pk2(v.z, v.w) << 32); }
                    sq = wave_sum(sq);
                    if (lane_p < 4) ((float*)(ws + WS_SSQ))[(size_t)mm * 4 + lane_p] = lane_p == 0 ? sq : 0.f; }
            }
        } else if (ph == PH_FINAL) {
            const float* w = ap->B.in[I_NFIN];
            for (int m = gw; m < M; m += NGW) {
                GAS f32x4* hr = (GAS f32x4*)(ap->B.h + (size_t)m * D) + lane_p; f32x4 v[4]; float s = 0.f;
#pragma unroll
                for (int j = 0; j < 4; ++j) { v[j] = hr[64 * j]; s += (v[j].x * v[j].x + v[j].y * v[j].y) + (v[j].z * v[j].z + v[j].w * v[j].w); }
                const float r = 1.0f / sqrtf(wave_sum(s) * (1.f / D) + EPS);
#pragma unroll
                for (int j = 0; j < 4; ++j) { const f32x4 g = *((const f32x4*)w + lane_p + 64 * j); hr[64 * j] = v[j] * r * g; }
            }
        } else {
            const int layer = (ph - 1) / 7, kind = (ph - 1) % 7;
            if (kind == 2) {
#if DIAG
                if (blockIdx.x == 0 && __builtin_amdgcn_mbcnt_hi(~0u, __builtin_amdgcn_mbcnt_lo(~0u, 0u)) == 0 && wave == 0) __hip_atomic_store((unsigned long long*)(ws0 + WS_TS) + ph + 1, rt(), RLX_AGENT);
#endif
                continue; }
            if (kind == 0) {
                pg8::StaticOrder S;
                if (layer == 0) { pg8::Gemm g{(const bf16*)(ws + WS_HB), (const bf16*)(ws + WS_WAB), M, NAB, D}; S.init(M, NAB, G, bx_p);
                    pg8::EpiProj<0> E{ws, (const float*)(ws + WS_SSQ)}; pg8::gemm_phase<pg8::EpiProj<0>, pg8::StaticOrder, true, true>(L + RING_OFF, g, S, E, (wave << 6) | lane_p); }
                else { pg8::Gemm g{(const bf16*)(ws + WS_HB), (const bf16*)(ws + WS_WCD), M, NCD, D}; S.init(M, NCD, G, bx_p);
                    pg8::EpiProj<1> E{ws, (const float*)(ws + WS_SSQ)}; pg8::gemm_phase<pg8::EpiProj<1>, pg8::StaticOrder, true, true>(L + RING_OFF, g, S, E, (wave << 6) | lane_p); }
            } else if (kind == 1) {
                if (layer == 0) PROBE(0);
                int tid_p = (wave << 6) | lane_p; asm volatile("" : "+v"(tid_p));
                if (layer == 1) for (int u = bx_p; u < 512; u += G) { gla::pass_a_unit(L, ws, ap->B.in[I_GW2], ap->B.in[I_GB], u >> 8, (u >> 6) & 3, u & 63, tid_p); unit_done_signal((gu32*)(ws + WS_CNTA) + 64, tid_p); }
                if (layer == 1) PROBE(6);
                if (layer == 0) {
                    for (int u = bx_p; u < 256; u += G) { ssd::fl_unit(L, ws, ap->B.in[I_FBIAS], u >> 7, (u >> 6) & 1, u & 63, tid_p); unit_done_signal((gu32*)(ws + WS_CNTA) + 128, tid_p); }
                    PROBE(1);
                    units_wait((gu32*)(ws + WS_CNTA) + 128, 256u, tid_p);
                    PROBE(2);
                }
                unsigned order = 0x76543210u;
                if (layer == 0) { order = 0u; const float* fbp = ap->B.in[I_FBIAS];
                    for (int hh = 0; hh < 8; ++hh) { const float bv = fbp[hh]; int rk = 0;
                        for (int h2 = 0; h2 < 8; ++h2) { const float b2 = fbp[h2]; rk += (b2 > bv || (b2 == bv && h2 < hh)) ? 1 : 0; }
                        order |= (unsigned)hh << (4 * rk); } }
                gu32* qc = (gu32*)(ws + WS_QCTR) + 64 * ph;
                volatile LAS unsigned* qslot = (volatile LAS unsigned*)(L + MISC_OFF) + 24;
                unsigned nxt = 0u; if (tid_p == 0) nxt = __hip_atomic_fetch_add(qc, 1u, RLX_AGENT);
                for (;;) {
                    if (tid_p == 0) *qslot = nxt;
                    __syncthreads();
                    unsigned u = __builtin_amdgcn_readfirstlane(*qslot);
                    if (u >= (layer == 0 ? 768u : 512u)) break;
                    if (tid_p == 0) nxt = __hip_atomic_fetch_add(qc, 1u, RLX_AGENT);
                    if (layer == 0 && u >= 256u && u < 512u) {
                        const int v_ = (int)u - 256; ssd::pass_a_unit(L, ws, ap->B.in[I_CONVW], ap->B.in[I_CONVB], ap->B.in[I_DTB], ap->B.in[I_ALOG], v_ >> 7, (v_ >> 6) & 1, v_ & 63, tid_p);
                        unit_done_signal((gu32*)(ws + WS_CNTA), tid_p); continue; }
                    if (layer == 0 && u >= 512u) u -= 256u;
                    const int rk = u >> 6, rem = u & 63, qb = 31 - (rem >> 1), bb = rem & 1, hh = (order >> (4 * rk)) & 7;
                    if (layer == 0) att::attn_unit<0>(L, ws, ap->B.in[I_FBIAS], (const float*)(ws + WS_KMAX), bb, hh, qb, tid_p);
                    else att::attn_unit<1>(L, ws, nullptr, nullptr, bb, hh, qb, tid_p);
                }
                if (layer == 0) PROBE(3); else PROBE(7);
                units_wait((gu32*)(ws + WS_CNTA) + 64 * layer, layer ? 512u : 256u, tid_p);
                if (layer == 0) ssd::pass_b(ws, bx_p, G, tid_p); else gla::pass_b(ws, bx_p, G, tid_p);
                if (layer == 0) PROBE(4); else PROBE(8);
                if (layer == 0) {
                    LAS float* scr = (LAS float*)(L + RING_OFF + wave * 16384); gu32* wq = (gu32*)(ws + WS_QCTR) + 64 * 15;
                    const float* nmix = ap->B.in[I_NMIX]; const float* nmlp = ap->B.in[I_NMLP];
                    for (;;) { unsigned i0 = 0u; if (lane_p == 0) i0 = __hip_atomic_fetch_add(wq, 4u, RLX_AGENT); i0 = __builtin_amdgcn_readfirstlane(i0) + WI0;
                        if (i0 >= (unsigned)W_NITEMS) break;
                        for (unsigned q = 0; q < 4u && i0 + q < (unsigned)W_NITEMS; ++q) wconv_item(ap, nmix, nmlp, ws, scr, (int)(i0 + q), lane_p); }
                }
                if (layer == 0) PROBE(5);
            } else if (kind == 3 && layer == 1) {
                int tid_p = (wave << 6) | lane_p; asm volatile("" : "+v"(tid_p));
                for (int u = bx_p; u < 512; u += G) gla::pass_c_unit(L, ws, ap->B.in[I_GLAN], u >> 8, (u >> 6) & 3, u & 63, tid_p);
            } else if (kind == 3 && layer == 0) {
                int tid_p = (wave << 6) | lane_p; asm volatile("" : "+v"(tid_p));
                for (int u = bx_p; u < 256; u += G) ssd::pass_c_unit(L, ws, ap->B.in[I_SSD_D], ap->B.in[I_SSDN], u >> 7, (u >> 6) & 1, u & 63, tid_p);
            } else if (kind == 4 || kind == 6) {
                const bf16* A = kind == 4 ? (const bf16*)(ws + WS_CAT) : (const bf16*)(ws + WS_U);
                const bf16* Bt = (const bf16*)(ws + (kind == 4 ? (layer ? WS_WOC : WS_WOA) : (layer ? WS_WD1 : WS_WD0)));
                pg8::Gemm g{A, Bt, M, D, kind == 4 ? D : FF}; pg8::StaticOrder S; S.init(M, D, G, bx_p);
                if (ph == 14) {
                    pg8::EpiFinal E{(const float*)ap->B.h, ap->B.h, ap->B.in[I_NFIN], (float*)(ws + WS_XBUF), (unsigned*)(ws + WS_FCNT), (LAS float*)(L + EPI_RED_OFF)};
                    pg8::gemm_phase<pg8::EpiFinal, pg8::StaticOrder, true, true>(L + RING_OFF, g, S, E, (wave << 6) | lane_p);
                } else {
                pg8::EpiRes E{(ph == 5) ? ap->B.in[I_X] : (const float*)ap->B.h, ap->B.h, (bf16*)(ws + WS_HB), (float*)(ws + WS_SSQ), (LAS float*)(L + EPI_RED_OFF)};
                pg8::gemm_phase<pg8::EpiRes, pg8::StaticOrder, true, true>(L + RING_OFF, g, S, E, (wave << 6) | lane_p);
                }
            } else if (kind == 5) {
                pg8::Gemm g{(const bf16*)(ws + WS_HB), (const bf16*)(ws + (layer ? WS_WU1 : WS_WU0)), M, FF, D}; pg8::StaticOrder S; S.init(M, FF, G, bx_p);
                pg8::EpiUp E{(bf16*)(ws + WS_U), (const float*)(ws + WS_SSQ)};
                pg8::gemm_phase<pg8::EpiUp, pg8::StaticOrder, true, true>(L + RING_OFF, g, S, E, (wave << 6) | lane_p);
            }
        }
        if (DIAG || ph + 1 < a.ph_hi) { XcdBarrier bl = bar; asm volatile("" : "+s"(bl.bar), "+s"(bl.x)); xcd_barrier(bl); }
#if DIAG
        if (blockIdx.x == 0 && __builtin_amdgcn_mbcnt_hi(~0u, __builtin_amdgcn_mbcnt_lo(~0u, 0u)) == 0 && wave == 0) __hip_atomic_store((unsigned long long*)(ws0 + WS_TS) + ph + 1, rt(), RLX_AGENT);
#endif
    }
#if DIAG
    {
        XcdBarrier bl = bar; xcd_barrier(bl);
        float ta = 0.f, tb = 0.f;
        for (int ph = 0; ph < 30; ++ph) { if (ph == 16) continue; const unsigned long long t0 = __hip_atomic_load((unsigned long long*)(ws0 + WS_TS) + ph, RLX_AGENT), t1 = __hip_atomic_load((unsigned long long*)(ws0 + WS_TS) + ph + 1, RLX_AGENT);
            const float d = (float)(t1 - t0); if ((DIAG_MASK_A >> ph) & 1) ta += d; if ((DIAG_MASK_B >> ph) & 1) tb += d; }
        if (DIAG_MASK_B == 0x40000000u) tb = 200.f * (float)__hip_atomic_load((unsigned*)(ws0 + WS_TS) + 100, RLX_AGENT);
        if ((DIAG_MASK_B & 0xFFFFFFF0u) == 0x60000000u) { const float n_ = (float)__hip_atomic_load((unsigned long long*)(ws0 + WS_TS) + 62, RLX_AGENT), a_ = (float)__hip_atomic_load((unsigned long long*)(ws0 + WS_TS) + 60, RLX_AGENT), b_ = (float)__hip_atomic_load((unsigned long long*)(ws0 + WS_TS) + 61, RLX_AGENT);
            const float c_ = (float)__hip_atomic_load((unsigned long long*)(ws0 + WS_TS) + 63, RLX_AGENT); tb = ((DIAG_MASK_B & 3) == 0 ? a_ : (DIAG_MASK_B & 3) == 1 ? b_ : (DIAG_MASK_B & 3) == 2 ? a_ + b_ : c_) / fmaxf(n_, 1.f) * 2.f; }
        if ((DIAG_MASK_B & 0xFFFFFFF0u) == 0x80000000u) tb = (float)(__hip_atomic_load((unsigned long long*)(ws0 + WS_TS) + 40 + (DIAG_MASK_B & 15), RLX_AGENT) - __hip_atomic_load((unsigned long long*)(ws0 + WS_TS) + ((DIAG_MASK_B & 15) >= 6 ? 9 : 2), RLX_AGENT));
        if ((DIAG_MASK_B & 0xFFFFFFF0u) == 0x70000000u) tb = 0.1f * (float)__hip_atomic_load((unsigned long long*)(ws0 + WS_TS) + 64 + (DIAG_MASK_B & 15), RLX_AGENT);
        if ((DIAG_MASK_B & 0xFFFFFFF0u) == 0x50000000u) tb = 0.1f * (float)__hip_atomic_load((unsigned long long*)(ws0 + WS_TS) + 60 + (DIAG_MASK_B & 3), RLX_AGENT);
        const float sc = 1.f + ta * 1e-6f; const int lane = __builtin_amdgcn_mbcnt_hi(~0u, __builtin_amdgcn_mbcnt_lo(~0u, 0u));
        LAS unsigned* tk = (LAS unsigned*)(L + MISC_OFF) + 16; int wv = 0; if (lane == 0) wv = (int)atomicAdd((unsigned*)tk, 1u); wv = __builtin_amdgcn_readfirstlane(wv);
        const int gw = blockIdx.x * NWAVES + wv, NGW = gridDim.x * NWAVES;
        for (int m = gw; m < M; m += NGW) { GAS f32x4* hr = (GAS f32x4*)(a.B.h + (size_t)m * D) + lane;
#pragma unroll
            for (int j = 0; j < 4; ++j) { f32x4 v = hr[64 * j] * sc; if (m == 0 && lane == 0 && j == 0) v.x += tb * 5e-4f; hr[64 * j] = v; } }
    }
#endif
}
static int g_grid = 0;
static void launch_mk(const Bufs& B, int lo, int hi, int li, hipStream_t stream) {
    Args a{}; a.B = B; a.ph_lo = lo; a.ph_hi = hi; a.li = li; a.pad = 0;
    hipLaunchKernelGGL(mk_fwd, dim3(g_grid), dim3(NWAVES * 64), LDS_BYTES, stream, a);
}
extern "C" void kernel_launch(void* const* d_in, const int* in_sizes, int n_in, void* d_out, int out_size, void* d_ws, size_t ws_size, hipStream_t stream) {
    if (n_in != 20 || out_size != M * D || ws_size < WS_END) { fprintf(stderr, "kernel_launch: unexpected shapes n_in %d out %d ws %zu\n", n_in, out_size, ws_size); return; }
    if (g_grid == 0) {
        int dev = 0, cus = 0, per_cu = 0;
        if (hipGetDevice(&dev) != hipSuccess || hipDeviceGetAttribute(&cus, hipDeviceAttributeMultiprocessorCount, dev) != hipSuccess) { g_grid = -1; return; }
        if (hipFuncSetAttribute((const void*)mk_fwd, hipFuncAttributeMaxDynamicSharedMemorySize, LDS_BYTES) != hipSuccess) { fprintf(stderr, "hipFuncSetAttribute failed\n"); g_grid = -1; return; }
        if (hipOccupancyMaxActiveBlocksPerMultiprocessor(&per_cu, (const void*)mk_fwd, NWAVES * 64, LDS_BYTES) != hipSuccess || per_cu < 1) fprintf(stderr, "occupancy query says %d\n", per_cu);
        (void)hipGetLastError();
        g_grid = cus;
    }
    if (g_grid < 0) return;
    Bufs B{};
    for (int i = 0; i < 20; ++i) B.in[i] = (const float*)d_in[i];
    B.h = (float*)d_out; B.ws = (unsigned char*)d_ws;
    hipMemsetAsync((char*)d_ws + WS_CTL, 0, CTL_ZERO_BYTES, stream);
    launch_mk(B, 0, 15, 0, stream);
}
```

```cpp
#include <hip/hip_runtime.h>
#include <cstdio>
#include <cstdint>
#define GAS __attribute__((address_space(1)))
#define LAS __attribute__((address_space(3)))
typedef unsigned short bf16;
typedef unsigned v4u __attribute__((ext_vector_type(4)));
typedef float f32x4 __attribute__((ext_vector_type(4)));
typedef short bf16x8 __attribute__((ext_vector_type(8)));
typedef GAS unsigned gu32;
typedef GAS unsigned long long gu64;
#define RLX_AGENT __ATOMIC_RELAXED, __HIP_MEMORY_SCOPE_AGENT
#define LDS_WAIT() asm volatile("s_waitcnt lgkmcnt(0)" ::: "memory")
#define VM_WAIT() asm volatile("s_waitcnt vmcnt(0)" ::: "memory")
__device__ __forceinline__ unsigned long long rt() { return __builtin_amdgcn_s_memrealtime(); }
__device__ __forceinline__ unsigned f2bf(float f) { unsigned u = __builtin_bit_cast(unsigned, f); return (u + 0x7fffu + ((u >> 16) & 1u)) >> 16; }
__device__ __forceinline__ unsigned pk2(float lo, float hi) { return f2bf(lo) | (f2bf(hi) << 16); }

#define XB_TMO      128
#define XB_XCNT(j)  (256  + 64 * (j))
#define XB_XSUB(j)  (1280 + 64 * (j))
#define XB_XGEN(j)  (2304 + 64 * (j))
#define XB_TOP      3328
#define XB_TOPGEN   3392
#define XCD_BAR_WORDS 3456
#define XB_SPIN_CAP (1u << 18)

__device__ __forceinline__ unsigned xb_ld(unsigned* p)              { return __hip_atomic_load(p, __ATOMIC_RELAXED, __HIP_MEMORY_SCOPE_AGENT); }
__device__ __forceinline__ unsigned xb_add(unsigned* p, unsigned v) { return __hip_atomic_fetch_add(p, v, __ATOMIC_RELAXED, __HIP_MEMORY_SCOPE_AGENT); }
__device__ __forceinline__ unsigned xb_xcc_id() { return (unsigned)__builtin_amdgcn_s_getreg((3 << 11) | 20) & 0xFu; }
#define XB_SPIN(cond, bar) do { unsigned _sp = 0; while (cond) { __builtin_amdgcn_s_sleep(1); \
    if ((++_sp & 255u) == 0u) { if (xb_ld(&(bar)[XB_TMO])) break; if (_sp > XB_SPIN_CAP) { atomicAdd(&(bar)[XB_TMO], 1u); break; } } } } while (0)

struct XcdBarrier {
    unsigned* bar; unsigned x;
    volatile LAS unsigned* st;
};

__device__ __forceinline__ XcdBarrier xcd_barrier_post(unsigned* bar, volatile LAS unsigned* st) {
    XcdBarrier b; b.bar = bar; b.x = xb_xcc_id(); b.st = st;
    if (threadIdx.x == 0) (void)xb_add(&bar[XB_XCNT(b.x)], 1u);
    return b;
}
__device__ __forceinline__ void xcd_barrier_complete(unsigned* bar, unsigned x, unsigned& nloc, unsigned& nx) {
    const unsigned G = gridDim.x * gridDim.y * gridDim.z;
    unsigned sum, cnt, mine, sp = 0u;
    for (;;) {
        sum = 0u; cnt = 0u; mine = 0u;
#pragma unroll
        for (unsigned j = 0; j < 16; ++j) { const unsigned c = xb_ld(&bar[XB_XCNT(j)]); sum += c; cnt += (c > 0u) ? 1u : 0u; mine = (j == x) ? c : mine; }
        if (sum == G) break;
        __builtin_amdgcn_s_sleep(1);
        if ((++sp & 255u) == 0u) { if (xb_ld(&bar[XB_TMO])) break; if (sp > XB_SPIN_CAP) { atomicAdd(&bar[XB_TMO], 1u); break; } }
    }
    nloc = mine > 0u ? mine : 1u; nx = cnt > 0u ? cnt : 1u;
}

__device__ __forceinline__ void xcd_barrier(const XcdBarrier& b) {
    asm volatile("s_waitcnt vmcnt(0)" ::: "memory");
    __syncthreads();
    if (threadIdx.x == 0) {
        unsigned* bar = b.bar;
        __builtin_amdgcn_s_waitcnt(0);
        unsigned nloc = b.st[0], nx = b.st[1];
        if (nloc == 0u) { xcd_barrier_complete(bar, b.x, nloc, nx); b.st[0] = nloc; b.st[1] = nx; }
        const unsigned old = xb_add(&bar[XB_XSUB(b.x)], 1u);
        const unsigned gen = old / nloc;
        if (old + 1u == (gen + 1u) * nloc) {
            __builtin_amdgcn_fence(__ATOMIC_RELEASE, "agent");
            asm volatile("s_waitcnt vmcnt(0)" ::: "memory");
            const unsigned og = xb_add(&bar[XB_TOP], 1u);
            const unsigned tg = og / nx;
            if (og + 1u == (tg + 1u) * nx) xb_add(&bar[XB_TOPGEN], 1u);
            else XB_SPIN(xb_ld(&bar[XB_TOPGEN]) == tg, bar);
            __builtin_amdgcn_fence(__ATOMIC_ACQUIRE, "agent");
            xb_add(&bar[XB_XGEN(b.x)], 1u);
            asm volatile("s_waitcnt vmcnt(0)" ::: "memory");
        } else {
            XB_SPIN(xb_ld(&bar[XB_XGEN(b.x)]) == gen, bar);
            __builtin_amdgcn_fence(__ATOMIC_ACQUIRE, "agent");
            asm volatile("s_waitcnt vmcnt(0)" ::: "memory");
        }
    }
    __syncthreads();
}

__device__ __forceinline__ int xl_lane() { int l = __builtin_amdgcn_mbcnt_hi(~0u, __builtin_amdgcn_mbcnt_lo(~0u, 0u)); asm volatile("" : "+v"(l)); return l; }
__device__ __forceinline__ float bperm(int srclane, float v) { return __builtin_bit_cast(float, __builtin_amdgcn_ds_bpermute(srclane << 2, __builtin_bit_cast(int, v))); }
__device__ __forceinline__ float red16_sum(float v) { const int l = xl_lane(); v += bperm(l ^ 1, v); v += bperm(l ^ 2, v); v += bperm(l ^ 4, v); v += bperm(l ^ 8, v); return v; }
__device__ __forceinline__ float red16_max(float v) { const int l = xl_lane(); v = fmaxf(v, bperm(l ^ 1, v)); v = fmaxf(v, bperm(l ^ 2, v)); v = fmaxf(v, bperm(l ^ 4, v)); v = fmaxf(v, bperm(l ^ 8, v)); return v; }
__device__ __forceinline__ float swap16_sum(float v) { const int l = xl_lane(); return v + bperm(l ^ 16, v); }
__device__ __forceinline__ float swap32_sum(float v) { const int l = xl_lane(); return v + bperm(l ^ 32, v); }
__device__ __forceinline__ float swap32_max(float v) { const int l = xl_lane(); return fmaxf(v, bperm(l ^ 32, v)); }
__device__ __forceinline__ float swap32_other(float v, int hi) { const int l = xl_lane(); return bperm(l ^ 32, v); }
__device__ __forceinline__ float red32_sum(float v) { return swap16_sum(red16_sum(v)); }
__device__ __forceinline__ float red64_sum(float v) { return swap32_sum(swap16_sum(red16_sum(v))); }
constexpr int BATCH = 2, T = 8192, D = 1024, M = BATCH * T, FF = 4096;
constexpr int NH = 8, HD = 64;
constexpr int AB_IN = 2832, CD_IN = 3088;
constexpr int NAB = 3072, NCD = 3072, NCDW = 3328;
constexpr float EPS = 1e-5f;
constexpr float LOG2E = 1.4426950408889634f;
constexpr float C2 = 0.125f * LOG2E;

constexpr size_t MiB = 1u << 20;
constexpr size_t WS_CTL = 0;
constexpr size_t WS_KMAX = 512 * 1024;
constexpr size_t WS_SSQ = 1 * MiB;
constexpr size_t WS_WAB = 2 * MiB;
constexpr size_t WS_WOA = 8 * MiB;
constexpr size_t WS_WU0 = 10 * MiB;
constexpr size_t WS_WD0 = 18 * MiB;
constexpr size_t WS_WCD = 26 * MiB;
constexpr size_t WS_WOC = 33 * MiB;
constexpr size_t WS_WU1 = 35 * MiB;
constexpr size_t WS_WD1 = 43 * MiB;
constexpr size_t WS_HB = 52 * MiB;
constexpr size_t WS_TMP = 52 * MiB;
constexpr size_t WS_Q = 84 * MiB, WS_K = 100 * MiB, WS_V = 116 * MiB;
constexpr size_t WS_Z = 132 * MiB;
constexpr size_t WS_XBC = 148 * MiB;
constexpr size_t WS_XC = 172 * MiB;
constexpr size_t WS_GR = 164 * MiB;
constexpr size_t WS_GLOW = 180 * MiB;
constexpr size_t WS_CAT = 196 * MiB;
constexpr size_t WS_LA = 228 * MiB;
constexpr size_t WS_FD = 244 * MiB;
constexpr size_t WS_FL = 246 * MiB;
constexpr size_t WS_DTA = 246 * MiB;
constexpr size_t WS_CHD = 520 * 1024;
constexpr size_t WS_SLOC = 228 * MiB;
constexpr size_t WS_SPREV = 248 * MiB;
constexpr size_t WS_GDEC = 640 * 1024;
constexpr size_t WS_GLOC = 228 * MiB;
constexpr size_t WS_GPREV = 244 * MiB;
constexpr size_t WS_QCTR = 900 * 1024;
constexpr size_t WS_CNTA = 910 * 1024;
constexpr size_t WS_TS = 800 * 1024;
constexpr size_t WS_FLOC = 247 * MiB;
constexpr size_t WS_FTOT = 920 * 1024;
constexpr size_t WS_XBUF = 248 * MiB;
constexpr size_t WS_FCNT = 928 * 1024;
constexpr size_t WS_U = 84 * MiB;
constexpr size_t WS_END = 256 * MiB;

struct Bufs {
    const float* in[20];
    float* h;
    unsigned char* ws;
};
__device__ __forceinline__ float* ws_f(const Bufs& b, size_t off) { return (float*)(b.ws + off); }
__device__ __forceinline__ bf16* ws_b(const Bufs& b, size_t off) { return (bf16*)(b.ws + off); }

enum { I_X = 0, I_NMIX, I_NMLP, I_NFIN, I_WAB, I_FBIAS, I_CONVW, I_CONVB, I_DTB, I_ALOG, I_SSD_D, I_SSDN, I_WOA, I_WCD, I_GW2, I_GB, I_GLAN, I_WOC, I_WUP, I_WDN };

__device__ __forceinline__ float bf2f(unsigned short b) { return __builtin_bit_cast(float, (unsigned)b << 16); }
__device__ __forceinline__ float softplus_f(float x) { return fmaxf(x, 0.f) + log1pf(__expf(-fabsf(x))); }
__device__ __forceinline__ float logsig_f(float x) { return fminf(x, 0.f) - log1pf(__expf(-fabsf(x))); }
__device__ __forceinline__ float silu_f(float x) { return x / (1.f + __expf(-x)); }
__device__ __forceinline__ float row_rstd(const float* ssq, int row) {
    const f32x4 a = *(const f32x4*)(ssq + (size_t)row * 4);
    return 1.0f / sqrtf(((a.x + a.y) + (a.z + a.w)) * (1.0f / D) + EPS);
}
__device__ __forceinline__ size_t qkv_off(int row, int head, int d) { const int b = row / T, t = row % T; return ((size_t)(b * NH + head) * T + t) * HD + d; }

__device__ __forceinline__ int src_col_ab(int n) { if (n < 1536) return n; if (n < 2816) return n + 8; if (n < 2824) return n - 1280; if (n < 2832) return n; return -1; }
__device__ __forceinline__ int src_col_cd(int n) { if (n < 2560) return n; if (n < 3072) return n + 16; if (n < 3088) return n - 512; return -1; }

namespace pg8 {
#define PG8_LAS __attribute__((address_space(3)))
typedef unsigned short bf16_t;
typedef short bf16x8 __attribute__((ext_vector_type(8)));
typedef float f32x4 __attribute__((ext_vector_type(4)));
typedef unsigned u32x4 __attribute__((ext_vector_type(4)));
constexpr int BM = 256, BK = 64, HALF = 128, HTB = HALF * BK * 2  , STAGE_BYTES = 8 * HTB, NXCD = 8, WGM = 8;

__host__ __device__ __forceinline__ int lds_byte(int r, int c) { const int st = (r >> 4) * 2 + (c >> 5), rr = r & 15, cc = c & 31, ob = rr * 64 + cc * 2; return st * 1024 + (ob ^ (((ob >> 9) & 1) << 5)); }
__host__ __device__ __forceinline__ void stage_rc(int b, int& R, int& C) { const int st = b / 1024, sb = b % 1024, swz = sb ^ (((sb >> 9) & 1) << 5); R = (st >> 1) * 16 + swz / 64; C = (st & 1) * 32 + (swz % 64) / 2; }
__host__ __device__ __forceinline__ int perm32(int rho) { const int n = rho >> 4, i = rho & 15; return 8 * (i >> 2) + 4 * n + (i & 3); }

struct Unit { int pm, pn; };
struct Gemm { const bf16_t* A; const bf16_t* Bt; int M, N, K; };

struct StaticOrder {
    int nM, nN, nwg, G, c;
    __host__ __device__ void init(int M, int N, int G_, int c_) { nM = M / BM; nN = N / BM; nwg = nM * nN; G = G_; c = c_; }
    __host__ __device__ bool next(int i, Unit& u) const {
        const long L = (long)i * G + c; if (L >= nwg) return false;
        int wgid = (int)L; { const int q = nwg / NXCD, r = nwg % NXCD, xcd = wgid % NXCD, off = wgid / NXCD; wgid = (xcd < r ? xcd * (q + 1) : r * (q + 1) + (xcd - r) * q) + off; }
        const int nig = WGM * nN, gid = wgid / nig, fm = gid * WGM, gsz = (nM - fm) < WGM ? (nM - fm) : WGM;
        u.pm = fm + ((wgid % nig) % gsz); u.pn = (wgid % nig) / gsz; return true;
    }
    __device__ __forceinline__ void a_ready(const Unit&) const {}
    __device__ __forceinline__ void done(const Unit&) const {}
};
__device__ __forceinline__ unsigned cvt_pk_bf16(float lo, float hi) { unsigned r; asm volatile("v_cvt_pk_bf16_f32 %0, %1, %2" : "=v"(r) : "v"(lo), "v"(hi)); return r; }
typedef float f32x2 __attribute__((ext_vector_type(2)));
__device__ __forceinline__ u32x4 pack8(f32x4 v0, f32x4 v1) { u32x4 w; w.x = cvt_pk_bf16(v0[0], v0[1]); w.y = cvt_pk_bf16(v0[2], v0[3]); w.z = cvt_pk_bf16(v1[0], v1[1]); w.w = cvt_pk_bf16(v1[2], v1[3]); return w; }
template <int LAYER> __device__ __forceinline__ void proj_store8(unsigned char* ws, int row, int c, f32x4 v0, f32x4 v1) {
    if (c < 1536) {
        const int which = c >> 9, cc = c & 511, head = cc >> 6, d = cc & 63; const float sc = which == 0 ? C2 : 1.f;
        bf16_t* dst = (bf16_t*)(ws + WS_Q + (size_t)which * (16 * MiB)) + qkv_off(row, head, d);
        *(u32x4*)dst = pack8(v0 * sc, v1 * sc); return;
    }
    if (LAYER == 0) {
        if (c < 2048) { *(u32x4*)((bf16_t*)(ws + WS_Z) + (size_t)row * 512 + (c - 1536)) = pack8(v0, v1); }
        else if (c < 2816) { *(u32x4*)((bf16_t*)(ws + WS_XBC) + (size_t)row * 768 + (c - 2048)) = pack8(v0, v1); }
        else if (c < 2832) { float* p = (float*)(ws + WS_FD) + (size_t)row * 16 + (c - 2816); *(f32x4*)p = v0; *(f32x4*)(p + 4) = v1; }
    } else {
        if (c < 1792) { *(u32x4*)((bf16_t*)(ws + WS_XBC) + (size_t)row * 256 + (c - 1536)) = pack8(v0 * 0.125f, v1 * 0.125f); }
        else if (c < 2048) { *(u32x4*)((bf16_t*)(ws + WS_XBC + 8 * MiB) + (size_t)row * 256 + (c - 1792)) = pack8(v0, v1); }
        else if (c < 2560) { *(u32x4*)((bf16_t*)(ws + WS_Z) + (size_t)row * 512 + (c - 2048)) = pack8(v0, v1); }
        else if (c < 3072) { *(u32x4*)((bf16_t*)(ws + WS_GR) + (size_t)row * 512 + (c - 2560)) = pack8(v0, v1); }
        else if (c < 3088) { float* p = (float*)(ws + WS_GLOW) + (size_t)row * 16 + (c - 3072); *(f32x4*)p = v0; *(f32x4*)(p + 4) = v1; }
    }
}
template <int LAYER> struct EpiProj {
    static constexpr bool PERM = true, AFTER_DRAIN = false;
    unsigned char* ws; const float* ssq;
    __device__ __forceinline__ void operator()(const f32x4 (&acc)[2][2][4][2], const Unit& u, int wr, int wc, int fr, int fq) const {
        const int row0 = u.pm * BM + wr * 64 + fr, col0 = u.pn * BM + wc * 32 + 8 * fq;
        float kmx[2] = {0.f, 0.f};
        float rsv[2][4];
#pragma unroll
        for (int ai = 0; ai < 2; ++ai)
#pragma unroll
            for (int m = 0; m < 4; ++m) rsv[ai][m] = row_rstd(ssq, row0 + ai * HALF + m * 16);
#pragma unroll
        for (int ai = 0; ai < 2; ++ai)
#pragma unroll
            for (int m = 0; m < 4; ++m) { const int row = row0 + ai * HALF + m * 16; const float rs = rsv[ai][m];
#pragma unroll
                for (int bj = 0; bj < 2; ++bj) { const f32x4 v0 = acc[ai][bj][m][0] * rs, v1 = acc[ai][bj][m][1] * rs;
                    proj_store8<LAYER>(ws, row, col0 + bj * HALF, v0, v1);
                    if (LAYER == 0) kmx[bj] = fmaxf(kmx[bj], ((v0[0] * v0[0] + v0[1] * v0[1]) + (v0[2] * v0[2] + v0[3] * v0[3])) + ((v1[0] * v1[0] + v1[1] * v1[1]) + (v1[2] * v1[2] + v1[3] * v1[3]))); } }
        if (LAYER == 0 && (u.pn == 2 || u.pn == 3)) {
#pragma unroll
            for (int bj = 0; bj < 2; ++bj) { float v = kmx[bj];
                v = red16_max(v);
                if (fr == 0) { const int c = col0 + bj * HALF - 512, head = c >> 6, chunk = (c & 63) >> 3, b = (u.pm * BM) / T;
                    atomicMax((unsigned*)(ws + WS_KMAX) + (b * NH + head) * 8 + chunk, __builtin_bit_cast(unsigned, sqrtf(v))); } }
        }
    }
};
__device__ __forceinline__ void unpack_bf16x8(u32x4 w, f32x4& lo, f32x4& hi) {
    lo = (f32x4){__builtin_bit_cast(float, w.x << 16), __builtin_bit_cast(float, w.x & 0xffff0000u), __builtin_bit_cast(float, w.y << 16), __builtin_bit_cast(float, w.y & 0xffff0000u)};
    hi = (f32x4){__builtin_bit_cast(float, w.z << 16), __builtin_bit_cast(float, w.z & 0xffff0000u), __builtin_bit_cast(float, w.w << 16), __builtin_bit_cast(float, w.w & 0xffff0000u)};
}
struct EpiRes {
    static constexpr bool PERM = true, AFTER_DRAIN = false;
    bf16_t* hb; float* ssq; PG8_LAS float* red;
    __device__ __forceinline__ void operator()(f32x4 (&acc)[2][2][4][2], const Unit& u, int wr, int wc, int fr, int fq) const {
        const int row0 = u.pm * BM + wr * 64 + fr, col0 = u.pn * BM + wc * 32 + 8 * fq;
        u32x4 rv[2][4][2];
#pragma unroll
        for (int ai = 0; ai < 2; ++ai)
#pragma unroll
            for (int m = 0; m < 4; ++m)
#pragma unroll
                for (int bj = 0; bj < 2; ++bj) rv[ai][m][bj] = *(const u32x4*)(hb + (size_t)(row0 + ai * HALF + m * 16) * D + col0 + bj * HALF);
#pragma unroll
        for (int ai = 0; ai < 2; ++ai)
#pragma unroll
            for (int m = 0; m < 4; ++m) { const int row = row0 + ai * HALF + m * 16; float s = 0.f;
#pragma unroll
                for (int bj = 0; bj < 2; ++bj) { f32x4 lo, hi; unpack_bf16x8(rv[ai][m][bj], lo, hi);
                    const f32x4 v0 = lo + acc[ai][bj][m][0], v1 = hi + acc[ai][bj][m][1];
                    s += ((v0[0] * v0[0] + v0[1] * v0[1]) + (v0[2] * v0[2] + v0[3] * v0[3])) + ((v1[0] * v1[0] + v1[1] * v1[1]) + (v1[2] * v1[2] + v1[3] * v1[3]));
                    *(u32x4*)(hb + (size_t)row * D + col0 + bj * HALF) = pack8(v0, v1); }
                s = swap32_sum(swap16_sum(s));
                if (fq == 0) red[(ai * HALF + wr * 64 + m * 16 + fr) * 4 + wc] = s; }
        asm volatile("s_waitcnt lgkmcnt(0)" ::: "memory"); __builtin_amdgcn_s_barrier(); asm volatile("" ::: "memory");
        { const int t = (wr * 4 + wc) * 64 + fq * 16 + fr;
          if (t < 256) { const f32x4 p = *(const PG8_LAS f32x4*)(red + t * 4); ssq[(size_t)(u.pm * BM + t) * 4 + u.pn] = (p[0] + p[1]) + (p[2] + p[3]); } }
        asm volatile("s_waitcnt lgkmcnt(0)" ::: "memory"); __builtin_amdgcn_s_barrier(); asm volatile("" ::: "memory");
    }
};
struct EpiFinal {
    static constexpr bool PERM = true, AFTER_DRAIN = false;
    const bf16_t* base; float* out; const float* wn; float* xbuf; unsigned* cnt; PG8_LAS float* red;
    __device__ __forceinline__ void operator()(f32x4 (&acc)[2][2][4][2], const Unit& u, int wr, int wc, int fr, int fq) const {
        const int row0 = u.pm * BM + wr * 64 + fr, col0 = u.pn * BM + wc * 32 + 8 * fq;
        { u32x4 rv[2][4][2];
#pragma unroll
          for (int ai = 0; ai < 2; ++ai)
#pragma unroll
              for (int m = 0; m < 4; ++m)
#pragma unroll
                  for (int bj = 0; bj < 2; ++bj) rv[ai][m][bj] = *(const u32x4*)(base + (size_t)(row0 + ai * HALF + m * 16) * D + col0 + bj * HALF);
#pragma unroll
          for (int ai = 0; ai < 2; ++ai)
#pragma unroll
              for (int m = 0; m < 4; ++m)
#pragma unroll
                  for (int bj = 0; bj < 2; ++bj) { f32x4 lo, hi; unpack_bf16x8(rv[ai][m][bj], lo, hi); acc[ai][bj][m][0] += lo; acc[ai][bj][m][1] += hi; } }
#pragma unroll
        for (int ai = 0; ai < 2; ++ai)
#pragma unroll
            for (int m = 0; m < 4; ++m) { float s = 0.f;
#pragma unroll
                for (int bj = 0; bj < 2; ++bj)
#pragma unroll
                    for (int n = 0; n < 2; ++n) { const f32x4 v = acc[ai][bj][m][n]; s += (v[0] * v[0] + v[1] * v[1]) + (v[2] * v[2] + v[3] * v[3]); }
                s = swap32_sum(swap16_sum(s));
                if (fq == 0) red[(ai * HALF + wr * 64 + m * 16 + fr) * 4 + wc] = s; }
        asm volatile("s_waitcnt lgkmcnt(0)" ::: "memory"); __builtin_amdgcn_s_barrier(); asm volatile("" ::: "memory");
        const int wid = wr * 4 + wc, t = wid * 64 + fq * 16 + fr;
        if (t < 256) { const f32x4 p = *(const PG8_LAS f32x4*)(red + t * 4);
            __hip_atomic_store(xbuf + (size_t)(u.pm * BM + t) * 4 + u.pn, (p[0] + p[1]) + (p[2] + p[3]), __ATOMIC_RELAXED, __HIP_MEMORY_SCOPE_AGENT); }
        asm volatile("s_waitcnt vmcnt(0)" ::: "memory");
        if (wid < 4 && fq * 16 + fr == 0) __hip_atomic_fetch_add(cnt + 64 * u.pm, 1u, __ATOMIC_RELAXED, __HIP_MEMORY_SCOPE_AGENT);
        if (wid == 0) { unsigned sp = 0u;
            while ((unsigned)__builtin_amdgcn_readfirstlane(__hip_atomic_load(cnt + 64 * u.pm, __ATOMIC_RELAXED, __HIP_MEMORY_SCOPE_AGENT)) < 16u) { __builtin_amdgcn_s_sleep(2); if (++sp > (1u << 22)) break; }
            __builtin_amdgcn_fence(__ATOMIC_ACQUIRE, "agent"); }
        asm volatile("s_waitcnt vmcnt(0) lgkmcnt(0)" ::: "memory"); __builtin_amdgcn_s_barrier(); asm volatile("" ::: "memory");
        if (t < 256) { const float* sl = xbuf + (size_t)(u.pm * BM + t) * 4; float q = 0.f;
#pragma unroll
            for (int i = 0; i < 4; ++i) q += __hip_atomic_load(sl + i, __ATOMIC_RELAXED, __HIP_MEMORY_SCOPE_AGENT);
            red[1024 + t] = 1.0f / sqrtf(q * (1.0f / D) + EPS); }
        asm volatile("s_waitcnt vmcnt(0) lgkmcnt(0)" ::: "memory"); __builtin_amdgcn_s_barrier(); asm volatile("" ::: "memory");
        f32x4 wv[2][2];
#pragma unroll
        for (int bj = 0; bj < 2; ++bj)
#pragma unroll
            for (int n = 0; n < 2; ++n) wv[bj][n] = *(const f32x4*)(wn + col0 + bj * HALF + n * 4);
#pragma unroll
        for (int ai = 0; ai < 2; ++ai)
#pragma unroll
            for (int m = 0; m < 4; ++m) { const int rl = ai * HALF + wr * 64 + m * 16 + fr; const float rs = red[1024 + rl];
#pragma unroll
                for (int bj = 0; bj < 2; ++bj)
#pragma unroll
                    for (int n = 0; n < 2; ++n) *(f32x4*)(out + (size_t)(u.pm * BM + rl) * D + col0 + bj * HALF + n * 4) = acc[ai][bj][m][n] * rs * wv[bj][n]; }
        asm volatile("s_waitcnt lgkmcnt(0)" ::: "memory"); __builtin_amdgcn_s_barrier(); asm volatile("" ::: "memory");
    }
};
struct EpiUp {
    static constexpr bool PERM = true, AFTER_DRAIN = false;
    bf16_t* U; const float* ssq;
    __device__ __forceinline__ void operator()(const f32x4 (&acc)[2][2][4][2], const Unit& u, int wr, int wc, int fr, int fq) const {
        const int row0 = u.pm * BM + wr * 64 + fr, col0 = u.pn * BM + wc * 32 + 8 * fq;
        float rsv[2][4];
#pragma unroll
        for (int ai = 0; ai < 2; ++ai)
#pragma unroll
            for (int m = 0; m < 4; ++m) rsv[ai][m] = row_rstd(ssq, row0 + ai * HALF + m * 16);
#pragma unroll
        for (int ai = 0; ai < 2; ++ai)
#pragma unroll
            for (int m = 0; m < 4; ++m) { const int row = row0 + ai * HALF + m * 16; const float rs = rsv[ai][m];
#pragma unroll
                for (int bj = 0; bj < 2; ++bj) { f32x4 a = acc[ai][bj][m][0], b = acc[ai][bj][m][1];
#pragma unroll
                    for (int e = 0; e < 4; ++e) { const float x = fmaxf(a[e], 0.f) * rs, y = fmaxf(b[e], 0.f) * rs; a[e] = x * x; b[e] = y * y; }
                    *(u32x4*)(U + (size_t)row * FF + col0 + bj * HALF) = pack8(a, b); } }
    }
};
template <class Epi, class Sched, bool ALIGN_EPI = false, bool SP2 = false>
__device__ __forceinline__ void gemm_phase(PG8_LAS unsigned char* lds, const Gemm g, const Sched& S, const Epi& E, int tid_in) {
    int tid_l = tid_in; asm volatile("" : "+v"(tid_l));
    const int tid = tid_l, wid = __builtin_amdgcn_readfirstlane(tid >> 6), lane = tid & 63, wr = wid >> 2, wc = wid & 3, fr = lane & 15, fq = lane >> 4;
    const int K = g.K, nt = K / BK;
    unsigned voffA[2], voffB[2];
#pragma unroll
    for (int i = 0; i < 2; ++i) { int R, C; stage_rc(tid * 16 + i * 8192, R, C); const int Rb = Epi::PERM ? ((R & ~31) + perm32(R & 31)) : R;
        voffA[i] = (unsigned)(R * K + C) * 2u; voffB[i] = (unsigned)(Rb * K + C) * 2u; }
    const size_t kstep = (size_t)(BK * 2);
    const size_t hstep = (size_t)HALF * K * 2;
    const size_t tstep = 2 * hstep;
    const unsigned ldsw = (unsigned)wid * 1024u;
    const int aoff = lds_byte(wr * 64 + fr, fq * 8), boff = lds_byte(wc * 32 + fr, fq * 8);
#define PG8_SA(b, h) (((b) * 2 + (h)) * HTB)
#define PG8_SB(b, h) ((4 + (b) * 2 + (h)) * HTB)
#define PG8_STAGE(bufoff, gbase, voff) do { _Pragma("unroll") for (int _i = 0; _i < 2; ++_i) \
        __builtin_amdgcn_global_load_lds((const unsigned*)((const char*)(gbase) + (voff)[_i]), (PG8_LAS unsigned*)(lds + (bufoff) + ldsw + _i * 8192), 16, 0, 0); } while (0)
#define PG8_LDA(dst, b, h) do { _Pragma("unroll") for (int m = 0; m < 4; ++m) _Pragma("unroll") for (int k = 0; k < 2; ++k) dst[m][k] = *(const PG8_LAS bf16x8*)(lds + PG8_SA(b, h) + aoff + m * 2048 + k * 1024); } while (0)
#define PG8_LDB(dst, b, h) do { _Pragma("unroll") for (int n = 0; n < 2; ++n) _Pragma("unroll") for (int k = 0; k < 2; ++k) dst[n][k] = *(const PG8_LAS bf16x8*)(lds + PG8_SB(b, h) + boff + n * 2048 + k * 1024); } while (0)
#define PG8_MMA(ai, bj, At, Bt) do { __builtin_amdgcn_s_setprio(1); _Pragma("unroll") for (int m = 0; m < 4; ++m) _Pragma("unroll") for (int n = 0; n < 2; ++n) _Pragma("unroll") for (int k = 0; k < 2; ++k) \
        acc[ai][bj][m][n] = __builtin_amdgcn_mfma_f32_16x16x32_bf16(Bt[n][k], At[m][k], acc[ai][bj][m][n], 0, 0, 0); __builtin_amdgcn_s_setprio(0); } while (0)
#define PG8_WAIT_V(n) asm volatile("s_waitcnt vmcnt(" #n ")" ::: "memory")
#define PG8_WAIT_L(n) asm volatile("s_waitcnt lgkmcnt(" #n ")" ::: "memory")
#define PG8_BAR __builtin_amdgcn_s_barrier()
#define PG8_SCHED __builtin_amdgcn_sched_barrier(0)
    Unit cur, nxt; int ui = 0;
    if (!S.next(0, cur)) return;
    f32x4 acc[2][2][4][2];
#pragma unroll
    for (int a = 0; a < 2; ++a)
#pragma unroll
        for (int b = 0; b < 2; ++b)
#pragma unroll
            for (int m = 0; m < 4; ++m)
#pragma unroll
                for (int n = 0; n < 2; ++n) acc[a][b][m][n] = (f32x4){0.f, 0.f, 0.f, 0.f};
    bf16x8 At[4][2], B0[2][2], B1[2][2];
    const char* cA = (const char*)g.A + (size_t)cur.pm * tstep; const char* cB = (const char*)g.Bt + (size_t)cur.pn * tstep;
    S.a_ready(cur);
    if constexpr (SP2) {
        PG8_STAGE(PG8_SB(0, 0), cB, voffB); PG8_STAGE(PG8_SB(0, 1), cB + hstep, voffB); PG8_STAGE(PG8_SA(0, 0), cA, voffA); PG8_STAGE(PG8_SA(0, 1), cA + hstep, voffA);
        if (wr == 1) PG8_BAR;
        PG8_WAIT_V(2); PG8_BAR;
        PG8_STAGE(PG8_SB(1, 0), cB + kstep, voffB); PG8_STAGE(PG8_SA(1, 0), cA + kstep, voffA); PG8_STAGE(PG8_SB(1, 1), cB + hstep + kstep, voffB);
        PG8_WAIT_V(6); PG8_BAR;
    } else {
        PG8_STAGE(PG8_SB(0, 0), cB, voffB); PG8_STAGE(PG8_SA(0, 0), cA, voffA); PG8_STAGE(PG8_SB(0, 1), cB + hstep, voffB); PG8_STAGE(PG8_SA(0, 1), cA + hstep, voffA);
        if (wr == 1) PG8_BAR;
        PG8_WAIT_V(4); PG8_BAR;
        PG8_STAGE(PG8_SB(1, 0), cB + kstep, voffB); PG8_STAGE(PG8_SA(1, 0), cA + kstep, voffA); PG8_STAGE(PG8_SB(1, 1), cB + hstep + kstep, voffB);
        PG8_WAIT_V(6); PG8_BAR;
    }
    for (;;) {
        const bool has_next = S.next(ui + 1, nxt);
        const char* nA = has_next ? (const char*)g.A + (size_t)nxt.pm * tstep : cA; const char* nB = has_next ? (const char*)g.Bt + (size_t)nxt.pn * tstep : cB;
        for (int t = 0; t < nt; t += 2) {
            const bool last = (t == nt - 2);
            const char* a1 = cA + (size_t)(t + 1) * kstep;
            const char* a2 = last ? nA : cA + (size_t)(t + 2) * kstep; const char* b2 = last ? nB : cB + (size_t)(t + 2) * kstep;
            const char* a3 = a2 + kstep; const char* b3 = b2 + kstep;
            if (last && has_next) S.a_ready(nxt);
            if constexpr (SP2) {
            PG8_LDB(B0, 0, 0); PG8_LDB(B1, 0, 1); PG8_SCHED; PG8_LDA(At, 0, 0); PG8_STAGE(PG8_SA(1, 1), a1 + hstep, voffA);
            PG8_WAIT_V(8); PG8_WAIT_L(0); PG8_BAR; PG8_MMA(0, 0, At, B0); PG8_MMA(0, 1, At, B1); PG8_BAR; PG8_SCHED;
            PG8_LDA(At, 0, 1); PG8_STAGE(PG8_SB(0, 0), b2, voffB); PG8_STAGE(PG8_SB(0, 1), b2 + hstep, voffB); PG8_STAGE(PG8_SA(0, 0), a2, voffA);
            PG8_WAIT_V(8); PG8_WAIT_L(0); PG8_BAR; PG8_MMA(1, 0, At, B0); PG8_MMA(1, 1, At, B1); PG8_BAR; PG8_SCHED;
            PG8_LDB(B0, 1, 0); PG8_LDB(B1, 1, 1); PG8_SCHED; PG8_LDA(At, 1, 0); PG8_STAGE(PG8_SA(0, 1), a2 + hstep, voffA);
            PG8_WAIT_V(8); PG8_WAIT_L(0); PG8_BAR; PG8_MMA(0, 0, At, B0); PG8_MMA(0, 1, At, B1); PG8_BAR; PG8_SCHED;
            PG8_LDA(At, 1, 1); PG8_STAGE(PG8_SB(1, 0), b3, voffB); PG8_STAGE(PG8_SB(1, 1), b3 + hstep, voffB); PG8_STAGE(PG8_SA(1, 0), a3, voffA);
            PG8_WAIT_V(8); PG8_WAIT_L(0); PG8_BAR; PG8_MMA(1, 0, At, B0); PG8_MMA(1, 1, At, B1); PG8_BAR; PG8_SCHED;
            } else {
            PG8_LDB(B0, 0, 0); PG8_SCHED; PG8_LDA(At, 0, 0); PG8_STAGE(PG8_SA(1, 1), a1 + hstep, voffA);
            PG8_WAIT_L(8); PG8_BAR; PG8_WAIT_L(0); PG8_MMA(0, 0, At, B0); PG8_BAR; PG8_SCHED;
            PG8_LDB(B1, 0, 1); PG8_STAGE(PG8_SB(0, 0), b2, voffB);
            PG8_BAR; PG8_WAIT_L(0); PG8_MMA(0, 1, At, B1); PG8_BAR;
            PG8_LDA(At, 0, 1); PG8_STAGE(PG8_SA(0, 0), a2, voffA);
            PG8_BAR; PG8_WAIT_L(0); PG8_MMA(1, 0, At, B0); PG8_BAR; PG8_SCHED;
            PG8_STAGE(PG8_SB(0, 1), b2 + hstep, voffB);
            PG8_WAIT_V(6); PG8_BAR; PG8_MMA(1, 1, At, B1); PG8_BAR;
            PG8_LDB(B0, 1, 0); PG8_SCHED; PG8_LDA(At, 1, 0); PG8_STAGE(PG8_SA(0, 1), a2 + hstep, voffA);
            PG8_WAIT_L(8); PG8_BAR; PG8_WAIT_L(0); PG8_MMA(0, 0, At, B0); PG8_BAR; PG8_SCHED;
            PG8_LDB(B1, 1, 1); PG8_STAGE(PG8_SB(1, 0), b3, voffB);
            PG8_BAR; PG8_WAIT_L(0); PG8_MMA(0, 1, At, B1); PG8_BAR;
            PG8_LDA(At, 1, 1); PG8_STAGE(PG8_SA(1, 0), a3, voffA);
            PG8_BAR; PG8_WAIT_L(0); PG8_MMA(1, 0, At, B0); PG8_BAR; PG8_SCHED;
            PG8_STAGE(PG8_SB(1, 1), b3 + hstep, voffB);
            PG8_WAIT_V(6); PG8_BAR; PG8_MMA(1, 1, At, B1); PG8_BAR;
            }
        }
        if constexpr (ALIGN_EPI) { if (wr == 0) PG8_BAR; }
        if constexpr (!Epi::AFTER_DRAIN) { E(acc, cur, wr, wc, fr, fq); S.done(cur); }
        if (!has_next) break;
#pragma unroll
        for (int a = 0; a < 2; ++a)
#pragma unroll
            for (int b = 0; b < 2; ++b)
#pragma unroll
                for (int m = 0; m < 4; ++m)
#pragma unroll
                    for (int n = 0; n < 2; ++n) acc[a][b][m][n] = (f32x4){0.f, 0.f, 0.f, 0.f};
        cur = nxt; cA = nA; cB = nB; ++ui;
        if constexpr (ALIGN_EPI) { if (wr == 1) PG8_BAR; }
    }
    PG8_WAIT_V(0);
    if constexpr (!ALIGN_EPI) { if (wr == 0) PG8_BAR; }
    PG8_BAR;
    if constexpr (Epi::AFTER_DRAIN) { E.fused(acc, cur, wr, wc, fr, fq, lds, wid, lane); S.done(cur); }
#undef PG8_SA
#undef PG8_SB
#undef PG8_STAGE
#undef PG8_LDA
#undef PG8_LDB
#undef PG8_MMA
#undef PG8_WAIT_V
#undef PG8_WAIT_L
#undef PG8_BAR
#undef PG8_SCHED
}
}

namespace att {
typedef short bf16x8 __attribute__((ext_vector_type(8)));
typedef short s16x4 __attribute__((ext_vector_type(4)));
typedef float f32x16 __attribute__((ext_vector_type(16)));
constexpr int KCH = 1040, KBUF = 8 * KCH, VBUF = 8192;
constexpr int NSL = 5;
constexpr int OFF_K = 0, OFF_V = NSL * KBUF, OFF_G = OFF_V + NSL * VBUF, OFF_FLAG = OFF_G + NSL * 272, OFF_WS = OFF_FLAG + 96, OFF_OST = OFF_WS + 8 * 256 + 128;
static_assert(OFF_V % 16 == 0 && OFF_G % 16 == 0 && OFF_WS % 16 == 0 && OFF_OST % 16 == 0 && OFF_OST + 8 * 4096 <= 131072, "att LDS map");
__device__ __forceinline__ int crow(int r, int hi) { return (r & 3) + 8 * (r >> 2) + 4 * hi; }
__device__ __forceinline__ s16x4 vtr(const LAS unsigned char* p) { typedef short v4i16_t __attribute__((ext_vector_type(4))); return __builtin_bit_cast(s16x4, __builtin_amdgcn_ds_read_tr16_b64_v4i16((LAS v4i16_t*)p)); }
__device__ __forceinline__ unsigned cvtpk(float lo, float hi) { typedef float f2 __attribute__((ext_vector_type(2))); typedef __bf16 b2 __attribute__((ext_vector_type(2))); f2 v = {lo, hi}; b2 b = __builtin_convertvector(v, b2); return __builtin_bit_cast(unsigned, b); }
__device__ __forceinline__ float ex2(float x) { return __builtin_amdgcn_exp2f(x); }
__device__ __forceinline__ float lg2(float x) { return __builtin_amdgcn_logf(x); }

__device__ __forceinline__ void gtile(LAS unsigned char* L, float fl, float cp, float fprev, int buf, int lane, float Fq) {
    LAS float* g = (LAS float*)(L + OFF_G + buf * 272);
    g[lane] = Fq - (fl + cp);
    if (lane == 0) g[64] = Fq - fprev;
}

template <int MODE>
__device__ __forceinline__ void attn_unit(LAS unsigned char* L, unsigned char* ws, const float* fbias, const float* kmaxc, int b, int h, int qb, int tid) {
    asm volatile("" : "+v"(tid));
    const int lane = tid & 63, r32 = lane & 31, hi = lane >> 5, w = __builtin_amdgcn_readfirstlane(tid >> 6);
    const int bh = b * NH + h, q0 = qb * 256;
    const bf16* Qp = (const bf16*)(ws + WS_Q) + ((size_t)bh * T + q0 + w * 32 + r32) * HD;
    const bf16* Kp = (const bf16*)(ws + WS_K) + (size_t)bh * T * HD;
    const bf16* Vp = (const bf16*)(ws + WS_V) + (size_t)bh * T * HD;
    bf16x8 qr[4];
#pragma unroll
    for (int d0 = 0; d0 < 4; ++d0) qr[d0] = *(const bf16x8*)(Qp + d0 * 16 + hi * 8);
    const int lkv = tid >> 3, lch = tid & 7;
    const unsigned kdst = OFF_K + lch * KCH + lkv * 16;
    const unsigned vdst = OFF_V + ((lch >> 2) * 4 + (lkv >> 4)) * 1024 + (lkv & 15) * 64 + (lch & 3) * 16;
    const bf16* kg = Kp + (size_t)lkv * HD + lch * 8; const bf16* vg = Vp + (size_t)lkv * HD + lch * 8;
    int j = 4 * qb;
    { v4u kb_[3], vb_[3];
#pragma unroll
      for (int i = 0; i < 3; ++i) { kb_[i] = *(const v4u*)(kg + (size_t)(j + 3 - i) * 4096); vb_[i] = *(const v4u*)(vg + (size_t)(j + 3 - i) * 4096); }
#pragma unroll
      for (int i = 0; i < 3; ++i) { *(LAS v4u*)(L + i * KBUF + kdst) = kb_[i]; *(LAS v4u*)(L + i * VBUF + vdst) = vb_[i]; } }
    v4u kreg = *(const v4u*)(kg + (size_t)j * 4096), vreg = *(const v4u*)(vg + (size_t)j * 4096), kreg2 = kreg, vreg2 = vreg;
    if (j > 0) { kreg2 = *(const v4u*)(kg + (size_t)(j - 1) * 4096); vreg2 = *(const v4u*)(vg + (size_t)(j - 1) * 4096); }
    const unsigned kfb = OFF_K + hi * KCH + r32 * 16;
    const unsigned vfb = OFF_V + ((lane >> 4) & 1) * 32 + (lane & 3) * 8 + (4 * hi + ((lane & 15) >> 2)) * 64;
    LAS float* wsf = (LAS float*)(L + OFF_WS) + w * 64;
    LAS unsigned* flags = (LAS unsigned*)(L + OFF_FLAG);
    float sbound = 0.f;
    if (MODE == 0) {
#pragma unroll
        for (int d0 = 0; d0 < 4; ++d0) { float s = 0.f;
#pragma unroll
            for (int e = 0; e < 8; ++e) { const float v = bf2f((unsigned short)qr[d0][e]); s += v * v; }
            sbound += sqrtf(s) * kmaxc[bh * 8 + 2 * d0 + hi]; }
        sbound = swap32_sum(sbound) * 1.02f;
    }
    const float sshift = fmaxf(sbound - 60.f, 0.f);
    const float sbound37 = sbound + 37.f;
    const float* flp = (const float*)(ws + WS_FLOC) + (size_t)bh * T;
    float cpre = 0.f, Fq = 0.f, fx1 = 0.f, fx2 = 0.f;
    if (MODE == 0 && w == 0) {
        const float t = ((const float*)(ws + WS_FTOT))[bh * 64 + lane]; float v = t; int ln = lane; asm volatile("" : "+v"(ln));
#pragma unroll
        for (int o = 1; o < 64; o <<= 1) { const float u = bperm(ln - o, v); if (ln >= o) v += u; }
        cpre = v - t;
        const int ql = q0 + 255;
        Fq = flp[ql] + __builtin_bit_cast(float, __builtin_amdgcn_readlane(__builtin_bit_cast(int, cpre), ql >> 7));
        float ft[5];
#pragma unroll
        for (int i = 0; i < 5; ++i) { const int t = j + 3 - i; ft[i] = t >= 0 ? flp[t * 64 + lane] : 0.f; }
#pragma unroll
        for (int i = 0; i < 4; ++i) { const int t = j + 3 - i;
            const float cp = __builtin_bit_cast(float, __builtin_amdgcn_readlane(__builtin_bit_cast(int, cpre), t >> 1));
            const float fpv = t > 0 ? __builtin_bit_cast(float, __builtin_amdgcn_readlane(__builtin_bit_cast(int, ft[i + 1]), 63)) + __builtin_bit_cast(float, __builtin_amdgcn_readlane(__builtin_bit_cast(int, cpre), (t - 1) >> 1)) : 0.f;
            gtile(L, ft[i], cp, fpv, i, lane, Fq); }
        fx1 = ft[4]; if (j > 1) fx2 = flp[(j - 2) * 64 + lane];
        if (lane == 0) { LAS float* fref = (LAS float*)(L + OFF_FLAG + 64); fref[0] = Fq;
            fref[1] = __builtin_bit_cast(float, __builtin_amdgcn_readlane(__builtin_bit_cast(int, cpre), q0 >> 7)); fref[2] = __builtin_bit_cast(float, __builtin_amdgcn_readlane(__builtin_bit_cast(int, cpre), (q0 >> 7) + 1)); }
    }
    const float flq = (MODE == 0) ? flp[q0 + 32 * w + r32] : 0.f;
    float cq = 0.f;
    if (lane == 0) { flags[w] = 0u; flags[8 + w] = 0u; }
    float m = -1e30f, l = 0.f, R = 0.f;
    f32x16 o0 = {}, o1 = {};
    bool wdone = false, it_first = true;
    int sw = 3, it = 0;
    const int pw_ = w >> 1, qloc = 32 * (w & 1) + r32;
    bool stop = false;
    const bool late = (w >= 4); bool pend = false;
    unsigned pws[16]; s16x4 vas[4][2], vcs[4][2];
#define ATT_PV(PW, VA, VC) { _Pragma("unroll") for (int s_ = 0; s_ < 4; ++s_) { \
        const v4u pa_ = {PW[4 * s_], PW[4 * s_ + 1], PW[4 * s_ + 2], PW[4 * s_ + 3]}; const bf16x8 pa = __builtin_bit_cast(bf16x8, pa_); \
        const bf16x8 v0_ = {VA[s_][0][0], VA[s_][0][1], VA[s_][0][2], VA[s_][0][3], VA[s_][1][0], VA[s_][1][1], VA[s_][1][2], VA[s_][1][3]}, v1_ = {VC[s_][0][0], VC[s_][0][1], VC[s_][0][2], VC[s_][0][3], VC[s_][1][0], VC[s_][1][1], VC[s_][1][2], VC[s_][1][3]}; \
        o0 = __builtin_amdgcn_mfma_f32_32x32x16_bf16(pa, v0_, o0, 0, 0, 0); o1 = __builtin_amdgcn_mfma_f32_32x32x16_bf16(pa, v1_, o1, 0, 0, 0); } }
#if DIAG && defined(DIAG_ATT)
    long long t0_ = 0, t1_ = 0, t2_ = 0, tm_ = 0;
#define DSTAMP(x) x = clock64()
#define DACC() do { if (MODE == DIAG_MODE && blockIdx.x == 0 && w == DIAG_WAVE && lane == 0) { atomicAdd((unsigned long long*)(ws + WS_TS) + 60, (unsigned long long)(t1_ - t0_)); atomicAdd((unsigned long long*)(ws + WS_TS) + 61, (unsigned long long)(t2_ - t1_)); atomicAdd((unsigned long long*)(ws + WS_TS) + 62, 1ull); atomicAdd((unsigned long long*)(ws + WS_TS) + 63, (unsigned long long)(tm_ - t0_)); } } while (0)
#else
#define DSTAMP(x) do {} while (0)
#define DACC() do {} while (0)
#endif
#define ATT_STEP(KR, VR) { \
        DSTAMP(t0_); if (j >= 0) { *(LAS v4u*)(L + sw * KBUF + kdst) = KR; *(LAS v4u*)(L + sw * VBUF + vdst) = VR; } asm volatile("s_waitcnt lgkmcnt(0)" ::: "memory"); DSTAMP(tm_); \
        asm volatile("s_waitcnt lgkmcnt(0)" ::: "memory"); __builtin_amdgcn_s_barrier(); asm volatile("" ::: "memory"); DSTAMP(t1_);     \
        if (it > 0) { const LAS unsigned* f = flags + ((it - 1) & 1) * 8; unsigned a = f[0] & f[1] & f[2] & f[3] & f[4] & f[5] & f[6] & f[7]; if (a) { stop = true; } } \
        if (!stop) { \
        if (j > 1) { KR = *(const v4u*)(kg + (size_t)(j - 2) * 4096); VR = *(const v4u*)(vg + (size_t)(j - 2) * 4096); }       \
        if (MODE == 0 && w == 0 && j > 0) { const float fxc = fx1; fx1 = fx2; if (j > 2) fx2 = flp[(j - 3) * 64 + lane]; const float cpc = __builtin_bit_cast(float, __builtin_amdgcn_readlane(__builtin_bit_cast(int, cpre), (j - 1) >> 1)); const float cpn = __builtin_bit_cast(float, __builtin_amdgcn_readlane(__builtin_bit_cast(int, cpre), (j > 1 ? j - 2 : 0) >> 1)); const float fpv = j > 1 ? __builtin_bit_cast(float, __builtin_amdgcn_readlane(__builtin_bit_cast(int, fx1), 63)) + cpn : 0.f; gtile(L, fxc, cpc, fpv, (sw == NSL - 1 ? 0 : sw + 1), lane, Fq); } \
        const int tw = j + pw_; int sr = sw - pw_; if (sr < 0) sr += NSL;       \
        if (tw < 0) wdone = true; \
        if (pend) { ATT_PV(pws, vas, vcs) pend = false; } \
        if (!wdone) { \
            const LAS unsigned char* Kb = L + sr * KBUF + kfb; const LAS unsigned char* Vb = L + sr * VBUF + vfb; \
            f32x16 p0, p1; \
            bf16x8 kf[8]; \
        _Pragma("unroll") \
            for (int d0 = 0; d0 < 4; ++d0) { kf[2 * d0] = *(const LAS bf16x8*)(Kb + d0 * 2 * KCH); kf[2 * d0 + 1] = *(const LAS bf16x8*)(Kb + d0 * 2 * KCH + 512); } \
            if (MODE == 0) { const LAS float* g = (const LAS float*)(L + OFF_G + sr * 272); \
        _Pragma("unroll") \
                for (int gq = 0; gq < 4; ++gq) { const f32x4 a = *(const LAS f32x4*)(g + 8 * gq + 4 * hi), c = *(const LAS f32x4*)(g + 32 + 8 * gq + 4 * hi); \
        _Pragma("unroll") \
                    for (int e = 0; e < 4; ++e) { p0[4 * gq + e] = a[e]; p1[4 * gq + e] = c[e]; } } \
            } else { p0 = f32x16{}; p1 = f32x16{}; } \
            __builtin_amdgcn_sched_barrier(0); \
        _Pragma("unroll") \
            for (int d0 = 0; d0 < 4; ++d0) { \
                p0 = __builtin_amdgcn_mfma_f32_32x32x16_bf16(kf[2 * d0], qr[d0], p0, 0, 0, 0); \
                p1 = __builtin_amdgcn_mfma_f32_32x32x16_bf16(kf[2 * d0 + 1], qr[d0], p1, 0, 0, 0); \
            } \
             \
        _Pragma("unroll") \
            for (int s = 0; s < 4; ++s) { vas[s][0] = vtr(Vb + s * 1024); vas[s][1] = vtr(Vb + s * 1024 + 512); vcs[s][0] = vtr(Vb + 4096 + s * 1024); vcs[s][1] = vtr(Vb + 4096 + s * 1024 + 512); } \
            __builtin_amdgcn_sched_barrier(0); \
            const bool diag = (it == 0); \
            if (MODE == 0) { \
                if (diag) { const int kb = 4 * hi; \
        _Pragma("unroll") \
                    for (int r = 0; r < 16; ++r) { const int kv = kb + (r & 3) + 8 * (r >> 2); if (kv > qloc) p0[r] = -INFINITY; if (kv + 32 > qloc) p1[r] = -INFINITY; } } \
                if (it_first) { const LAS float* fref = (const LAS float*)(L + OFF_FLAG + 64); cq = fref[0] - (flq + fref[1 + ((32 * w + r32) >> 7)]) + sshift; it_first = false; } \
                float ls = 0.f; \
        _Pragma("unroll") \
                for (int r = 0; r < 16; ++r) { p0[r] = ex2(p0[r] - cq); p1[r] = ex2(p1[r] - cq); ls += p0[r] + p1[r]; } \
                l += ls; \
                const float gnext = ((const LAS float*)(L + OFF_G + sr * 272))[64]; \
                wdone = __all(gnext <= cq - sbound37 + lg2(swap32_sum(l))); \
            } else { \
                const int kb = 4 * hi; \
                float sp0[16], sp1[16]; \
        _Pragma("unroll") \
                for (int r = 0; r < 16; ++r) { \
                    const float x0 = p0[r], x1 = p1[r]; \
                    sp0[r] = fmaxf(x0, 0.f) + lg2(1.f + ex2(-fabsf(x0))); sp1[r] = fmaxf(x1, 0.f) + lg2(1.f + ex2(-fabsf(x1))); \
                } \
                if (diag) { \
        _Pragma("unroll") \
                    for (int r = 0; r < 16; ++r) { const int kv = kb + (r & 3) + 8 * (r >> 2); if (kv >= qloc) { sp0[r] = 0.f; p0[r] = -INFINITY; } if (kv + 32 >= qloc) { sp1[r] = 0.f; p1[r] = -INFINITY; } } } \
                float To[8], Tp[8], PT[8]; \
        _Pragma("unroll") \
                for (int i = 0; i < 4; ++i) { To[i] = -((sp0[4 * i] + sp0[4 * i + 1]) + (sp0[4 * i + 2] + sp0[4 * i + 3])); To[4 + i] = -((sp1[4 * i] + sp1[4 * i + 1]) + (sp1[4 * i + 2] + sp1[4 * i + 3])); } \
        _Pragma("unroll") \
                for (int i = 0; i < 8; ++i) { Tp[i] = swap32_other(To[i], hi); PT[i] = To[i] + Tp[i]; } \
                float above[8]; float run = 0.f; \
        _Pragma("unroll") \
                for (int i = 7; i >= 0; --i) { above[i] = R + run + (hi == 0 ? Tp[i] : 0.f); run += PT[i]; } \
        _Pragma("unroll") \
                for (int i = 0; i < 4; ++i) { \
                    float s = above[i]; \
        _Pragma("unroll") \
                    for (int e = 3; e >= 0; --e) { const int r = 4 * i + e; p0[r] = ex2(p0[r] - sp0[r] + s); s -= sp0[r]; } \
                    s = above[4 + i]; \
        _Pragma("unroll") \
                    for (int e = 3; e >= 0; --e) { const int r = 4 * i + e; p1[r] = ex2(p1[r] - sp1[r] + s); s -= sp1[r]; } \
                } \
                R += run; \
                wdone = __all(R <= -40.f); \
            } \
        _Pragma("unroll") \
            for (int i = 0; i < 8; ++i) { pws[i] = cvtpk(p0[2 * i], p0[2 * i + 1]); pws[8 + i] = cvtpk(p1[2 * i], p1[2 * i + 1]); } \
            __builtin_amdgcn_sched_barrier(0); \
            if (late) { pend = true; } else ATT_PV(pws, vas, vcs) \
        } \
        if (lane == 0) flags[(it & 1) * 8 + w] = wdone ? 1u : 0u; \
        sw = (sw == NSL - 1) ? 0 : sw + 1; \
        --j; ++it; if (j + 3 < 0) stop = true; } \
        DSTAMP(t2_); DACC(); \
    }
    while (!stop) { ATT_STEP(kreg, vreg); if (stop) break; ATT_STEP(kreg2, vreg2); }
#undef ATT_STEP
    if (pend) { ATT_PV(pws, vas, vcs) pend = false; }
#undef ATT_PV
#if DIAG && defined(DIAG_ATT)
    if (MODE == 0 && blockIdx.x == 0 && tid == 0) atomicAdd((unsigned*)(ws + WS_TS) + 100, (unsigned)it);
#endif
    if (MODE == 0) {
        l = swap32_sum(l);
        if (hi == 0) wsf[r32] = 1.0f / l;
#pragma unroll
        for (int gq = 0; gq < 4; ++gq) { const f32x4 a = *(const LAS f32x4*)(wsf + 8 * gq + 4 * hi);
#pragma unroll
            for (int e = 0; e < 4; ++e) { o0[4 * gq + e] *= a[e]; o1[4 * gq + e] *= a[e]; } }
    }
    LAS bf16* stg = (LAS bf16*)(L + OFF_OST) + w * 2048;
#pragma unroll
    for (int r = 0; r < 16; ++r) { const int orow = crow(r, hi); stg[orow * 64 + r32] = (bf16)f2bf(o0[r]); stg[orow * 64 + 32 + r32] = (bf16)f2bf(o1[r]); }
    bf16* Ow = (bf16*)(ws + WS_CAT) + (size_t)(b * T + q0 + w * 32) * D + h * HD;
#pragma unroll
    for (int i = 0; i < 4; ++i) { const int row = i * 8 + (lane >> 3), ch = lane & 7; const v4u v = *(const LAS v4u*)(stg + row * 64 + ch * 8); __builtin_nontemporal_store(v, (v4u*)(Ow + (size_t)row * D + ch * 8)); }
    __syncthreads();
}
}

#if DIAG && defined(DIAG_STG)
#define STG_INIT() long long stg_t_ = clock64()
#define STG(k) do { const long long n_ = clock64(); if (blockIdx.x == 0 && (tid & 63) == 0 && (tid >> 6) == 0) atomicAdd((unsigned long long*)(ws + WS_TS) + 64 + (k), (unsigned long long)(n_ - stg_t_)); stg_t_ = n_; } while (0)
#else
#define STG_INIT() do {} while (0)
#define STG(k) do {} while (0)
#endif
namespace ssd {
using att::bf16x8; using att::s16x4; using att::f32x16; using att::vtr; using att::crow; using att::ex2; using att::cvtpk;
constexpr int TAB_DT = 0, TAB_A = 2048, TAB_X = 4096;
constexpr int A_XD = 8192, A_B = A_XD + 65536;
constexpr int BKCH = 2064, C_BK = 8192, C_XDT = 24832, C_ST = C_XDT + 65536;
static_assert(C_BK + 8 * BKCH <= C_XDT && C_ST + 8 * 4096 <= 131072 && A_B + 16384 <= 131072, "ssd LDS map");
__device__ __forceinline__ int vimg_off(int s, int col) { return (((col >> 5) << 2) + (s >> 4)) * 1024 + (s & 15) * 64 + (col & 31) * 2; }
__device__ __forceinline__ bf16x8 trpair(const LAS unsigned char* p) { const s16x4 a = vtr(p), c = vtr(p + 512); return (bf16x8){a[0], a[1], a[2], a[3], c[0], c[1], c[2], c[3]}; }
__device__ __forceinline__ void unpack8(v4u w, float (&f)[8]) {
#pragma unroll
    for (int e = 0; e < 4; ++e) { f[2 * e] = __builtin_bit_cast(float, w[e] << 16); f[2 * e + 1] = __builtin_bit_cast(float, w[e] & 0xffff0000u); } }
__device__ __forceinline__ v4u pack8f(const float (&f)[8]) { v4u w; w.x = cvtpk(f[0], f[1]); w.y = cvtpk(f[2], f[3]); w.z = cvtpk(f[4], f[5]); w.w = cvtpk(f[6], f[7]); return w; }

__device__ __forceinline__ void fl_unit(LAS unsigned char* L, unsigned char* ws, const float* fbias, int b, int g, int c, int tid) {
    asm volatile("" : "+v"(tid));
    const int lane = tid & 63, w = __builtin_amdgcn_readfirstlane(tid >> 6); LAS float* wtot = (LAS float*)(L + TAB_X);
    const int hh = tid >> 7, s = tid & 127, hd = 4 * g + hh, row0 = b * T + c * 128;
    const float fx = ((const float*)(ws + WS_FD))[(size_t)(row0 + s) * 16 + hd] + fbias[hd];
    float f = fminf(fx, 0.f) * LOG2E - att::lg2(1.f + ex2(-fabsf(fx) * LOG2E));
#pragma unroll
    for (int o = 1; o < 64; o <<= 1) { const float t2 = bperm(lane - o, f); if (lane >= o) f += t2; }
    if (lane == 63) wtot[w] = f;
    __syncthreads();
    if (w & 1) f += wtot[w - 1];
    __hip_atomic_store((float*)(ws + WS_FLOC) + (size_t)(b * 8 + hd) * T + c * 128 + s, f, __ATOMIC_RELAXED, __HIP_MEMORY_SCOPE_AGENT);
    if (s == 127) __hip_atomic_store((float*)(ws + WS_FTOT) + (b * 8 + hd) * 64 + c, f, __ATOMIC_RELAXED, __HIP_MEMORY_SCOPE_AGENT);
    __syncthreads();
}
__device__ __forceinline__ void pass_a_unit(LAS unsigned char* L, unsigned char* ws, const float* convw, const float* convb, const float* dtb, const float* alog, int b, int g, int c, int tid) {
    asm volatile("" : "+v"(tid));
    int lane = tid & 63; const int w = __builtin_amdgcn_readfirstlane(tid >> 6), r32 = lane & 31, hi = lane >> 5;
    const int row0 = b * T + c * 128;
    LAS float* dtab = (LAS float*)(L + TAB_DT); LAS float* atab = (LAS float*)(L + TAB_A); LAS float* wtot = (LAS float*)(L + TAB_X);
    float* DTA = (float*)(ws + WS_DTA); const float* FD = (const float*)(ws + WS_FD);
    {
        const int hh = tid >> 7, s = tid & 127, hd = 4 * g + hh;
        const float dt = softplus_f(FD[(size_t)(row0 + s) * 16 + 8 + hd] + dtb[hd]);
        float v = dt * (-__expf(alog[hd])) * LOG2E;
        int ln = lane; asm volatile("" : "+v"(ln));
#pragma unroll
        for (int o = 1; o < 64; o <<= 1) { const float t = bperm(ln - o, v); if (ln >= o) v += t; }
        if (ln == 63) wtot[w] = v;
        __syncthreads();
        if (w & 1) v += wtot[w - 1];
        dtab[hh * 128 + s] = dt; atab[hh * 128 + s] = v;
        DTA[(size_t)(row0 + s) * 16 + hd] = dt; DTA[(size_t)(row0 + s) * 16 + 8 + hd] = v;
        if (s == 127) __hip_atomic_store((float*)(ws + WS_CHD) + (b * 8 + hd) * 64 + c, v, __ATOMIC_RELAXED, __HIP_MEMORY_SCOPE_AGENT);
        __syncthreads();
    }
    if (lane < 48) {
        const int col = lane < 32 ? 256 * g + 8 * lane : (lane < 40 ? 512 + 64 * g + 8 * (lane - 32) : 640 + 64 * g + 8 * (lane - 40));
        float wk[4][8], bs[8];
#pragma unroll
        for (int e = 0; e < 8; ++e) { bs[e] = convb[col + e];
#pragma unroll
            for (int k = 0; k < 4; ++k) wk[k][e] = convw[k * 768 + col + e]; }
        const bf16* xb = (const bf16*)(ws + WS_XBC) + col; bf16* xc = (bf16*)(ws + WS_XC) + col;
        const int s0 = 16 * w, t0 = c * 128 + s0;
        v4u rw[19]; const v4u zz = {0u, 0u, 0u, 0u};
#pragma unroll
        for (int i = 0; i < 19; ++i) rw[i] = (t0 + i >= 3) ? *(const v4u*)(xb + (size_t)(row0 + s0 + i - 3) * 768) : zz;
        const int hh = lane >> 3;
        const float alast = lane < 32 ? atab[hh * 128 + 127] : 0.f;
#pragma unroll
        for (int i = 0; i < 16; ++i) { const int s = s0 + i;
            float r0[8], r1[8], r2[8], cu[8], o[8];
            unpack8(rw[i], r0); unpack8(rw[i + 1], r1); unpack8(rw[i + 2], r2); unpack8(rw[i + 3], cu);
#pragma unroll
            for (int e = 0; e < 8; ++e) { const float v = bs[e] + wk[0][e] * r0[e] + wk[1][e] * r1[e] + wk[2][e] * r2[e] + wk[3][e] * cu[e]; o[e] = silu_f(v); }
            __builtin_nontemporal_store(pack8f(o), (v4u*)(xc + (size_t)(row0 + s) * 768));
            if (lane < 32) { const float sc = dtab[hh * 128 + s] * ex2(alast - atab[hh * 128 + s]);
#pragma unroll
                for (int e = 0; e < 8; ++e) o[e] *= sc;
                *(LAS v4u*)(L + A_XD + ((s >> 6) * 4 + hh) * 8192 + vimg_off(s & 63, (8 * lane) & 63)) = pack8f(o);
            } else if (lane < 40) { *(LAS v4u*)(L + A_B + (s >> 6) * 8192 + vimg_off(s & 63, 8 * (lane - 32))) = pack8f(o); }
        }
    }
    __syncthreads();
    {
        const int hh = w >> 1, ph = w & 1;
        const unsigned vfb = ((lane >> 4) & 1) * 32 + (lane & 3) * 8 + (4 * hi + ((lane & 15) >> 2)) * 64;
        f32x16 acc0 = {}, acc1 = {};
#pragma unroll
        for (int ks = 0; ks < 8; ++ks) { const int sh = ks >> 2, k16 = ks & 3;
            const bf16x8 A = trpair(L + A_XD + (sh * 4 + hh) * 8192 + vfb + ph * 4096 + k16 * 1024);
            const bf16x8 B0 = trpair(L + A_B + sh * 8192 + vfb + k16 * 1024), B1 = trpair(L + A_B + sh * 8192 + vfb + 4096 + k16 * 1024);
            acc0 = __builtin_amdgcn_mfma_f32_32x32x16_bf16(A, B0, acc0, 0, 0, 0); acc1 = __builtin_amdgcn_mfma_f32_32x32x16_bf16(A, B1, acc1, 0, 0, 0); }
        float* loc = (float*)(ws + WS_SLOC) + ((size_t)((b * 8 + 4 * g + hh) * 64 + c)) * 4096;
#pragma unroll
        for (int r = 0; r < 16; ++r) { const int p = 32 * ph + crow(r, hi); __hip_atomic_store(loc + p * 64 + r32, acc0[r], __ATOMIC_RELAXED, __HIP_MEMORY_SCOPE_AGENT); __hip_atomic_store(loc + p * 64 + 32 + r32, acc1[r], __ATOMIC_RELAXED, __HIP_MEMORY_SCOPE_AGENT); }
    }
    __syncthreads();
}
__device__ __forceinline__ void pass_b(unsigned char* ws, int bx, int G, int tid) {
    if (tid >= 128) return;
    typedef float f32x2v __attribute__((ext_vector_type(2)));
    const float* loc = (const float*)(ws + WS_SLOC); const float* chd = (const float*)(ws + WS_CHD); bf16* prev = (bf16*)(ws + WS_SPREV);
    for (int e = bx * 256 + 2 * tid; e < 65536; e += G * 256) { const int bh = e >> 12, pn = e & 4095; f32x2v S = {0.f, 0.f};
        for (int c0 = 0; c0 < 64; c0 += 32) { f32x2v lv[32]; float dd[32];
#pragma unroll
            for (int i = 0; i < 32; ++i) { const int u = bh * 64 + c0 + i; lv[i] = *(const f32x2v*)(loc + (size_t)u * 4096 + pn); dd[i] = chd[u]; }
#pragma unroll
            for (int i = 0; i < 32; ++i) { const int u = bh * 64 + c0 + i; *(unsigned*)(prev + (size_t)u * 4096 + pn) = cvtpk(S[0], S[1]); S = S * ex2(dd[i]) + lv[i]; } } }
}
__device__ __forceinline__ void pass_c_unit(LAS unsigned char* L, unsigned char* ws, const float* dskip, const float* normw, int b, int g, int c, int tid) {
    asm volatile("" : "+v"(tid));
    const int w = __builtin_amdgcn_readfirstlane(tid >> 6);
    const int row0 = b * T + c * 128;
    STG_INIT();
    LAS float* dtab = (LAS float*)(L + TAB_DT); LAS float* atab = (LAS float*)(L + TAB_A); LAS float* part = (LAS float*)(L + TAB_X);
    const float* DTA = (const float*)(ws + WS_DTA); const bf16* XC = (const bf16*)(ws + WS_XC);
    { const int hh = tid >> 7, s = tid & 127; dtab[hh * 128 + s] = DTA[(size_t)(row0 + s) * 16 + 4 * g + hh]; atab[hh * 128 + s] = DTA[(size_t)(row0 + s) * 16 + 8 + 4 * g + hh]; }
    {
        const int s = tid >> 3, ch = tid & 7;
#pragma unroll
        for (int i = 0; i < 2; ++i) { const int ss = s + 64 * i; *(LAS v4u*)(L + C_BK + ch * BKCH + ss * 16) = *(const v4u*)(XC + (size_t)(row0 + ss) * 768 + 512 + 64 * g + 8 * ch); }
    }
    __syncthreads(); STG(0);
    asm volatile("" : "+v"(tid));
    {
#pragma unroll
        for (int i = 0; i < 8; ++i) { const int idx = tid + 512 * i, s = idx >> 5, oc = idx & 31, hh = oc >> 3; float f[8];
            unpack8(*(const v4u*)(XC + (size_t)(row0 + s) * 768 + 256 * g + 8 * oc), f); const float dt = dtab[hh * 128 + s];
#pragma unroll
            for (int e = 0; e < 8; ++e) f[e] *= dt;
            *(LAS v4u*)(L + C_XDT + ((s >> 6) * 4 + hh) * 8192 + vimg_off(s & 63, (8 * oc) & 63)) = pack8f(f); }
    }
    __syncthreads(); STG(1);
    asm volatile("" : "+v"(tid));
    const int lane = tid & 63, r32 = lane & 31, hi = lane >> 5;
    const int hh = w >> 1, pair = w & 1, hd = 4 * g + hh;
    const unsigned vfb = ((lane >> 4) & 1) * 32 + (lane & 3) * 8 + (4 * hi + ((lane & 15) >> 2)) * 64;
    const bf16* prevp = (const bf16*)(ws + WS_SPREV) + ((size_t)((b * 8 + hd) * 64 + c)) * 4096;
    const float Dk = dskip[hd];
    float yv[2][2][16];
#pragma unroll
    for (int i = 0; i < 2; ++i) { const int lb = i == 0 ? pair : 3 - pair;
        v4u zreg[4];
#pragma unroll
        for (int i4 = 0; i4 < 4; ++i4) { const int idx = lane + 64 * i4; zreg[i4] = *(const v4u*)((const bf16*)(ws + WS_Z) + (size_t)(row0 + 32 * lb + (idx >> 3)) * 512 + 256 * g + 64 * hh + 8 * (idx & 7)); }
        bf16x8 cf[4];
#pragma unroll
        for (int st = 0; st < 4; ++st) cf[st] = *(const bf16x8*)(XC + (size_t)(row0 + 32 * lb + r32) * 768 + 640 + 64 * g + 16 * st + 8 * hi);
        const float al = atab[hh * 128 + 32 * lb + r32];
        f32x16 Y0 = {}, Y1 = {};
        for (int sb = 0; sb <= lb; ++sb) {
            f32x16 X = {};
#pragma unroll
            for (int st = 0; st < 4; ++st) { const bf16x8 kf = *(const LAS bf16x8*)(L + C_BK + (2 * st + hi) * BKCH + (32 * sb + r32) * 16); X = __builtin_amdgcn_mfma_f32_32x32x16_bf16(kf, cf[st], X, 0, 0, 0); }
            unsigned pw[8];
#pragma unroll
            for (int gq = 0; gq < 4; ++gq) { const f32x4 as = *(const LAS f32x4*)(atab + hh * 128 + 32 * sb + 8 * gq + 4 * hi);
#pragma unroll
                for (int e = 0; e < 4; ++e) { const int r = 4 * gq + e; float p = X[r] * ex2(al - as[e]); if (sb == lb && crow(r, hi) > r32) p = 0.f; X[r] = p; } }
#pragma unroll
            for (int q = 0; q < 8; ++q) pw[q] = cvtpk(X[2 * q], X[2 * q + 1]);
            const LAS unsigned char* img = L + C_XDT + ((sb >> 1) * 4 + hh) * 8192 + vfb + (2 * (sb & 1)) * 1024;
#pragma unroll
            for (int k = 0; k < 2; ++k) { const v4u pa_ = {pw[4 * k], pw[4 * k + 1], pw[4 * k + 2], pw[4 * k + 3]}; const bf16x8 pa = __builtin_bit_cast(bf16x8, pa_);
                const bf16x8 v0 = trpair(img + k * 1024), v1 = trpair(img + 4096 + k * 1024);
                Y0 = __builtin_amdgcn_mfma_f32_32x32x16_bf16(pa, v0, Y0, 0, 0, 0); Y1 = __builtin_amdgcn_mfma_f32_32x32x16_bf16(pa, v1, Y1, 0, 0, 0); }
        }
        f32x16 Z0 = {}, Z1 = {};
        { bf16x8 pf0[4], pf1[4];
#pragma unroll
          for (int st = 0; st < 4; ++st) { pf0[st] = *(const bf16x8*)(prevp + (size_t)r32 * 64 + 16 * st + 8 * hi); pf1[st] = *(const bf16x8*)(prevp + (size_t)(32 + r32) * 64 + 16 * st + 8 * hi); }
          __builtin_amdgcn_sched_barrier(0);
#pragma unroll
          for (int st = 0; st < 4; ++st) { Z0 = __builtin_amdgcn_mfma_f32_32x32x16_bf16(cf[st], pf0[st], Z0, 0, 0, 0); Z1 = __builtin_amdgcn_mfma_f32_32x32x16_bf16(cf[st], pf1[st], Z1, 0, 0, 0); } }
        {   LAS unsigned char* zst = L + C_ST + w * 4096;
#pragma unroll
            for (int i4 = 0; i4 < 4; ++i4) { const int idx = lane + 64 * i4; *(LAS v4u*)(zst + (idx >> 3) * 128 + (idx & 7) * 16) = zreg[i4]; }
            unsigned short xr0[16], xr1[16], zr0[16], zr1[16]; float rdt[16];
#pragma unroll
            for (int gq = 0; gq < 4; ++gq) { const f32x4 d4 = *(const LAS f32x4*)(dtab + hh * 128 + 32 * lb + 8 * gq + 4 * hi);
#pragma unroll
                for (int e = 0; e < 4; ++e) { const int r = 4 * gq + e, ll = crow(r, hi), l = 32 * lb + ll;
                    const LAS unsigned char* xi = L + C_XDT + ((l >> 6) * 4 + hh) * 8192 + vimg_off(l & 63, r32);
                    xr0[r] = *(const LAS unsigned short*)xi; xr1[r] = *(const LAS unsigned short*)(xi + 4096);
                    zr0[r] = *(const LAS unsigned short*)(zst + ll * 128 + r32 * 2); zr1[r] = *(const LAS unsigned short*)(zst + ll * 128 + 64 + r32 * 2);
                    rdt[r] = 1.0f / d4[e]; } }
            float qs[16];
#pragma unroll
            for (int gq = 0; gq < 4; ++gq) { const f32x4 a4 = *(const LAS f32x4*)(atab + hh * 128 + 32 * lb + 8 * gq + 4 * hi);
#pragma unroll
                for (int e = 0; e < 4; ++e) { const int r = 4 * gq + e; const float el = ex2(a4[e]);
                    float y0 = Y0[r] + Z0[r] * el + Dk * rdt[r] * bf2f(xr0[r]), y1 = Y1[r] + Z1[r] * el + Dk * rdt[r] * bf2f(xr1[r]);
                    y0 *= silu_f(bf2f(zr0[r])); y1 *= silu_f(bf2f(zr1[r]));
                    yv[i][0][r] = y0; yv[i][1][r] = y1; qs[r] = y0 * y0 + y1 * y1; } }
            const int lx = lane;
#pragma unroll
            for (int o = 1; o < 32; o <<= 1) {
#pragma unroll
                for (int r = 0; r < 16; ++r) qs[r] += bperm(lx ^ o, qs[r]); }
#pragma unroll
            for (int r = 0; r < 16; ++r) if (r32 == 0) part[hh * 128 + 32 * lb + crow(r, hi)] = qs[r];
        }
    }
    __syncthreads(); STG(2);
    bf16* cat = (bf16*)(ws + WS_CAT);
    const int cc = 256 * g + 64 * hh + r32; const float nw0 = normw[cc], nw1 = normw[cc + 32];
    LAS unsigned char* ost = L + C_ST + w * 4096;
#pragma unroll
    for (int i = 0; i < 2; ++i) { const int lb = i == 0 ? pair : 3 - pair;
#pragma unroll
        for (int r = 0; r < 16; ++r) { const int ll = crow(r, hi), l = 32 * lb + ll; const float tot = (part[l] + part[128 + l]) + (part[256 + l] + part[384 + l]);
            const float rs = 1.0f / sqrtf(tot * (1.f / 256.f) + EPS);
            *(LAS bf16*)(ost + ll * 128 + r32 * 2) = (bf16)f2bf(yv[i][0][r] * rs * nw0); *(LAS bf16*)(ost + ll * 128 + 64 + r32 * 2) = (bf16)f2bf(yv[i][1][r] * rs * nw1); }
#pragma unroll
        for (int i4 = 0; i4 < 4; ++i4) { const int idx = lane + 64 * i4; const v4u v = *(const LAS v4u*)(ost + (idx >> 3) * 128 + (idx & 7) * 16);
            *(v4u*)(cat + (size_t)(row0 + 32 * lb + (idx >> 3)) * D + 512 + 256 * g + 64 * hh + 8 * (idx & 7)) = v; }
    }
    __syncthreads(); STG(3);
}
}

namespace gla {
using att::bf16x8; using att::s16x4; using att::f32x16; using att::vtr; using att::crow; using att::ex2; using att::cvtpk; using att::lg2;
using ssd::vimg_off; using ssd::trpair; using ssd::BKCH;
constexpr int A_GLOW = 0, A_WT = 8192, A_KI = 10240, A_VI = A_KI + 16384, A_GS = A_VI + 32768, A_PRE = A_GS + 32768;
constexpr int C_PART = 0, C_BK = 8192, C_VI = 24832;
static_assert(A_PRE + 2048 + 256 <= 131072 && C_BK + 8 * BKCH <= C_VI && C_VI + 32768 + 8 * 2048 <= 131072, "gla LDS map");
typedef float f32x4v __attribute__((ext_vector_type(4)));
__device__ __forceinline__ void pass_a_unit(LAS unsigned char* L, unsigned char* ws, const float* w2, const float* gb, int b, int h, int c, int tid) {
    asm volatile("" : "+v"(tid));
    const int lane = tid & 63, w = __builtin_amdgcn_readfirstlane(tid >> 6), r32 = lane & 31, hi = lane >> 5;
    const int row0 = b * T + c * 128, u = (b * 4 + h) * 64 + c;
    STG_INIT();
    LAS float* glow = (LAS float*)(L + A_GLOW); LAS float* wt = (LAS float*)(L + A_WT);
    {
        constexpr int WROW = 2064, AROW = 528, G_WG = 10240, G_AST = G_WG + 16 * WROW;
        static_assert(G_AST + 8 * 16 * AROW <= 131072, "gla g_low LDS map");
        const bf16* wgp = (const bf16*)(ws + WS_WCD) + (size_t)3072 * D;
#pragma unroll
        for (int i = 0; i < 4; ++i) { const int idx = tid + 512 * i, r = idx >> 7, pc = idx & 127; *(LAS v4u*)(L + G_WG + r * WROW + pc * 16) = *(const v4u*)(wgp + (size_t)r * D + pc * 8); }
        v4u areg[4][8];
        const bf16* hbw = (const bf16*)(ws + WS_HB) + (size_t)(row0 + 16 * w) * D;
#pragma unroll
        for (int q = 0; q < 4; ++q)
#pragma unroll
            for (int i = 0; i < 8; ++i) { const int idx = lane + 64 * i, r = idx >> 5, pc = idx & 31; areg[q][i] = *(const v4u*)(hbw + (size_t)r * D + q * 256 + pc * 8); }
        __syncthreads();
        LAS unsigned char* al = L + G_AST + w * (16 * AROW);
        const int fr = lane & 15, kq = lane >> 4;
        f32x4v acc = {0.f, 0.f, 0.f, 0.f};
#pragma unroll
        for (int q = 0; q < 4; ++q) {
#pragma unroll
            for (int i = 0; i < 8; ++i) { const int idx = lane + 64 * i, r = idx >> 5, pc = idx & 31; *(LAS v4u*)(al + r * AROW + pc * 16) = areg[q][i]; }
#pragma unroll
            for (int st = 0; st < 8; ++st) { const bf16x8 a = *(const LAS bf16x8*)(al + fr * AROW + (32 * st + 8 * kq) * 2), bb = *(const LAS bf16x8*)(L + G_WG + fr * WROW + (q * 256 + 32 * st + 8 * kq) * 2);
                acc = __builtin_amdgcn_mfma_f32_16x16x32_bf16(a, bb, acc, 0, 0, 0); }
        }
#pragma unroll
        for (int e = 0; e < 4; ++e) { const int s = 16 * w + 4 * (lane >> 4) + e; glow[s * 16 + (lane & 15)] = acc[e] * row_rstd((const float*)(ws + WS_SSQ), row0 + s); }
    }
    __syncthreads(); STG(4);
    {
        const bf16* gv = (const bf16*)(ws + WS_Z);
#pragma unroll
        for (int i = 0; i < 4; ++i) { const int idx = tid + 512 * i, s = idx >> 4, oc = idx & 15;
            *(LAS v4u*)(L + A_VI + ((s >> 6) * 2 + (oc >> 3)) * 8192 + vimg_off(s & 63, (8 * oc) & 63)) = *(const v4u*)(gv + (size_t)(row0 + s) * 512 + 128 * h + 8 * oc); }
    }
    const int k = lane;
    LAS float* gtab = (LAS float*)(L + A_GS); LAS float* pretab = (LAS float*)(L + A_PRE); LAS float* tottab = pretab + 512;
    {   float wc[16];
#pragma unroll
        for (int r = 0; r < 16; ++r) wc[r] = w2[r * 256 + 64 * h + k];
        const float bk = gb[64 * h + k]; float run = 0.f;
#pragma unroll
        for (int i = 0; i < 16; ++i) { const int s = 16 * w + i; float x = bk;
#pragma unroll
            for (int q = 0; q < 4; ++q) { const f32x4v gl4 = *(const LAS f32x4v*)(glow + s * 16 + 4 * q);
#pragma unroll
                for (int e = 0; e < 4; ++e) x += gl4[e] * wc[4 * q + e]; }
            const float la = (fminf(x, 0.f) * LOG2E - lg2(1.f + ex2(-fabsf(x) * LOG2E))) * (1.f / 16.f);
            run += la; gtab[s * 64 + k] = run; }
        wt[w * 64 + k] = run;
    }
    __syncthreads(); STG(5);
    {   float pre = 0.f;
#pragma unroll
        for (int q = 0; q < 8; ++q) { const float t = wt[q * 64 + k]; if (q < w) pre += t; }
        pretab[w * 64 + k] = pre; if (w == 7) tottab[k] = pre + wt[7 * 64 + k];
    }
    __syncthreads();
    {
        bf16* gq = (bf16*)(ws + WS_XBC) + 64 * h; bf16* gk = (bf16*)(ws + WS_XBC + 8 * MiB) + 64 * h;
        v4u qv[2], kv[2];
#pragma unroll
        for (int i = 0; i < 2; ++i) { const int idx = tid + 512 * i, s = idx >> 3, oc = idx & 7; const size_t o = (size_t)(row0 + s) * 256 + 8 * oc; qv[i] = *(const v4u*)(gq + o); kv[i] = *(const v4u*)(gk + o); }
#pragma unroll
        for (int i = 0; i < 2; ++i) { const int idx = tid + 512 * i, s = idx >> 3, oc = idx & 7; const size_t o = (size_t)(row0 + s) * 256 + 8 * oc;
            float qf_[8], kf_[8], gs[8], tt[8], oq[8], ok[8], okk[8];
            ssd::unpack8(qv[i], qf_); ssd::unpack8(kv[i], kf_);
#pragma unroll
            for (int hq = 0; hq < 2; ++hq) { const f32x4v g4 = *(const LAS f32x4v*)(gtab + s * 64 + 8 * oc + 4 * hq), p4 = *(const LAS f32x4v*)(pretab + (s >> 4) * 64 + 8 * oc + 4 * hq), t4 = *(const LAS f32x4v*)(tottab + 8 * oc + 4 * hq);
#pragma unroll
                for (int e = 0; e < 4; ++e) { gs[4 * hq + e] = g4[e] + p4[e]; tt[4 * hq + e] = t4[e]; } }
#pragma unroll
            for (int e = 0; e < 8; ++e) { oq[e] = qf_[e] * ex2(gs[e]); ok[e] = kf_[e] * ex2(-gs[e]); okk[e] = kf_[e] * ex2(tt[e] - gs[e]); }
            *(v4u*)(gq + o) = ssd::pack8f(oq); *(v4u*)(gk + o) = ssd::pack8f(ok);
            *(LAS v4u*)(L + A_KI + (s >> 6) * 8192 + vimg_off(s & 63, 8 * oc)) = ssd::pack8f(okk); }
        if (tid < 64) __hip_atomic_store((float*)(ws + WS_GDEC) + u * 64 + tid, tottab[tid], __ATOMIC_RELAXED, __HIP_MEMORY_SCOPE_AGENT);
    }
    __syncthreads(); STG(6);
    {
        const int vt = w >> 1, kh = w & 1;
        const unsigned vfb = ((lane >> 4) & 1) * 32 + (lane & 3) * 8 + (4 * hi + ((lane & 15) >> 2)) * 64;
        f32x16 acc = {};
#pragma unroll
        for (int ks = 0; ks < 8; ++ks) { const int sh = ks >> 2, k16 = ks & 3;
            const bf16x8 A = trpair(L + A_VI + (sh * 2 + (vt >> 1)) * 8192 + vfb + (vt & 1) * 4096 + k16 * 1024);
            const bf16x8 Bf = trpair(L + A_KI + sh * 8192 + vfb + kh * 4096 + k16 * 1024);
            acc = __builtin_amdgcn_mfma_f32_32x32x16_bf16(A, Bf, acc, 0, 0, 0); }
        float* loc = (float*)(ws + WS_GLOC) + (size_t)u * 8192;
#pragma unroll
        for (int r = 0; r < 16; ++r) __hip_atomic_store(loc + (32 * vt + crow(r, hi)) * 64 + 32 * kh + r32, acc[r], __ATOMIC_RELAXED, __HIP_MEMORY_SCOPE_AGENT);
    }
    __syncthreads(); STG(7);
}
__device__ __forceinline__ void pass_b(unsigned char* ws, int bx, int G, int tid) {
    if (tid >= 128) return;
    typedef float f32x2v __attribute__((ext_vector_type(2)));
    const float* loc = (const float*)(ws + WS_GLOC); const float* gdec = (const float*)(ws + WS_GDEC); bf16* prev = (bf16*)(ws + WS_GPREV);
    for (int e = bx * 256 + 2 * tid; e < 65536; e += G * 256) { const int bh = e >> 13, vk = e & 8191, k = e & 63; f32x2v S = {0.f, 0.f};
        for (int c0 = 0; c0 < 64; c0 += 16) { f32x2v lv[16], dd[16];
#pragma unroll
            for (int i = 0; i < 16; ++i) { const int u = bh * 64 + c0 + i; lv[i] = *(const f32x2v*)(loc + (size_t)u * 8192 + vk); dd[i] = *(const f32x2v*)(gdec + u * 64 + k); }
#pragma unroll
            for (int i = 0; i < 16; ++i) { const int u = bh * 64 + c0 + i; *(unsigned*)(prev + (size_t)u * 8192 + vk) = cvtpk(S[0], S[1]); S[0] = S[0] * ex2(dd[i][0]) + lv[i][0]; S[1] = S[1] * ex2(dd[i][1]) + lv[i][1]; } } }
}
__device__ __forceinline__ void pass_c_unit(LAS unsigned char* L, unsigned char* ws, const float* normw, int b, int h, int c, int tid) {
    asm volatile("" : "+v"(tid));
    const int w = __builtin_amdgcn_readfirstlane(tid >> 6);
    const int row0 = b * T + c * 128, u = (b * 4 + h) * 64 + c;
    LAS float* part = (LAS float*)(L + C_PART);
    const bf16* GQ = (const bf16*)(ws + WS_XBC); const bf16* GK = (const bf16*)(ws + WS_XBC + 8 * MiB); const bf16* GV = (const bf16*)(ws + WS_Z);
    {   const int s = tid >> 3, ch = tid & 7;
#pragma unroll
        for (int i = 0; i < 2; ++i) { const int ss = s + 64 * i; *(LAS v4u*)(L + C_BK + ch * BKCH + ss * 16) = *(const v4u*)(GK + (size_t)(row0 + ss) * 256 + 64 * h + 8 * ch); }
#pragma unroll
        for (int i = 0; i < 4; ++i) { const int idx = tid + 512 * i, s2 = idx >> 4, oc = idx & 15;
            *(LAS v4u*)(L + C_VI + ((s2 >> 6) * 2 + (oc >> 3)) * 8192 + vimg_off(s2 & 63, (8 * oc) & 63)) = *(const v4u*)(GV + (size_t)(row0 + s2) * 512 + 128 * h + 8 * oc); }
    }
    __syncthreads();
    asm volatile("" : "+v"(tid));
    const int lane = tid & 63, r32 = lane & 31, hi = lane >> 5;
    const int pair = w & 1, vt = w >> 1;
    const unsigned vfb = ((lane >> 4) & 1) * 32 + (lane & 3) * 8 + (4 * hi + ((lane & 15) >> 2)) * 64;
    const bf16* prevp = (const bf16*)(ws + WS_GPREV) + (size_t)u * 8192 + (size_t)(32 * vt + r32) * 64 + 8 * hi;
    f32x16 O[2];
#pragma unroll
    for (int i = 0; i < 2; ++i) { const int tb = i == 0 ? pair : 3 - pair;
        bf16x8 qf[4];
#pragma unroll
        for (int st = 0; st < 4; ++st) qf[st] = *(const bf16x8*)(GQ + (size_t)(row0 + 32 * tb + r32) * 256 + 64 * h + 16 * st + 8 * hi);
        f32x16 Oa = {};
        for (int sb = 0; sb <= tb; ++sb) {
            f32x16 X = {};
#pragma unroll
            for (int st = 0; st < 4; ++st) { const bf16x8 kf = *(const LAS bf16x8*)(L + C_BK + (2 * st + hi) * BKCH + (32 * sb + r32) * 16); X = __builtin_amdgcn_mfma_f32_32x32x16_bf16(kf, qf[st], X, 0, 0, 0); }
            unsigned pw[8];
            if (sb == tb) {
#pragma unroll
                for (int r = 0; r < 16; ++r) if (crow(r, hi) > r32) X[r] = 0.f; }
#pragma unroll
            for (int q = 0; q < 8; ++q) pw[q] = cvtpk(X[2 * q], X[2 * q + 1]);
            const LAS unsigned char* img = L + C_VI + ((sb >> 1) * 2 + (vt >> 1)) * 8192 + vfb + (vt & 1) * 4096 + (2 * (sb & 1)) * 1024;
#pragma unroll
            for (int kk = 0; kk < 2; ++kk) { const v4u pa_ = {pw[4 * kk], pw[4 * kk + 1], pw[4 * kk + 2], pw[4 * kk + 3]}; const bf16x8 pa = __builtin_bit_cast(bf16x8, pa_);
                Oa = __builtin_amdgcn_mfma_f32_32x32x16_bf16(pa, trpair(img + kk * 1024), Oa, 0, 0, 0); }
        }
        { bf16x8 pf[4];
#pragma unroll
          for (int st = 0; st < 4; ++st) pf[st] = *(const bf16x8*)(prevp + 16 * st);
          __builtin_amdgcn_sched_barrier(0);
#pragma unroll
          for (int st = 0; st < 4; ++st) Oa = __builtin_amdgcn_mfma_f32_32x32x16_bf16(qf[st], pf[st], Oa, 0, 0, 0); }
        O[i] = Oa;
        { float qs[16]; const int lx = lane;
#pragma unroll
          for (int r = 0; r < 16; ++r) qs[r] = Oa[r] * Oa[r];
#pragma unroll
          for (int o = 1; o < 32; o <<= 1) {
#pragma unroll
              for (int r = 0; r < 16; ++r) qs[r] += bperm(lx ^ o, qs[r]); }
#pragma unroll
          for (int r = 0; r < 16; ++r) if (r32 == 0) part[vt * 128 + 32 * tb + crow(r, hi)] = qs[r]; }
    }
    __syncthreads();
    const bf16* GR = (const bf16*)(ws + WS_GR); bf16* cat = (bf16*)(ws + WS_CAT);
    const int v = 32 * vt + r32; const float nw = normw[v];
    LAS unsigned char* st_ = L + C_VI + 32768 + w * 2048;
    v4u grv4[2][2];
#pragma unroll
    for (int i = 0; i < 2; ++i) { const int tb = i == 0 ? pair : 3 - pair;
#pragma unroll
        for (int q = 0; q < 2; ++q) { const int idx = lane + 64 * q; grv4[i][q] = *(const v4u*)(GR + (size_t)(row0 + 32 * tb + (idx >> 2)) * 512 + 128 * h + 32 * vt + 8 * (idx & 3)); } }
#pragma unroll
    for (int i = 0; i < 2; ++i) { const int tb = i == 0 ? pair : 3 - pair;
#pragma unroll
        for (int q = 0; q < 2; ++q) { const int idx = lane + 64 * q; *(LAS v4u*)(st_ + (idx >> 2) * 64 + (idx & 3) * 16) = grv4[i][q]; }
        float ov[16];
#pragma unroll
        for (int r = 0; r < 16; ++r) { const int tl = crow(r, hi), t = 32 * tb + tl; const float tot = (part[t] + part[128 + t]) + (part[256 + t] + part[384 + t]);
            const float rs = 1.0f / sqrtf(tot * (1.f / 128.f) + EPS);
            ov[r] = O[i][r] * rs * nw * silu_f(bf2f(*(const LAS unsigned short*)(st_ + tl * 64 + r32 * 2))); }
#pragma unroll
        for (int r = 0; r < 16; ++r) *(LAS bf16*)(st_ + crow(r, hi) * 64 + r32 * 2) = (bf16)f2bf(ov[r]);
#pragma unroll
        for (int q = 0; q < 2; ++q) { const int idx = lane + 64 * q; const v4u o4 = *(const LAS v4u*)(st_ + (idx >> 2) * 64 + (idx & 3) * 16);
            *(v4u*)(cat + (size_t)(row0 + 32 * tb + (idx >> 2)) * D + 512 + 128 * h + 32 * vt + 8 * (idx & 3)) = o4; }
    }
    __syncthreads();
}
}
constexpr int NWAVES = 8;
constexpr int RING_OFF = 0, RING_BYTES = 131072;
constexpr int LDSCTL_OFF = RING_BYTES, MISC_OFF = LDSCTL_OFF + 320;
constexpr int LDS_BYTES = 147456;
constexpr int EPI_RED_OFF = LDSCTL_OFF + 1024;
static_assert(EPI_RED_OFF + 4096 + 1024 <= LDS_BYTES, "LDS map");
constexpr int CW_TMO = 0, CW_BAR = 4096;
constexpr size_t CTL_ZERO_BYTES = 1 * MiB;
constexpr int PH_PRO = 0, PH_FINAL = 15, N_PHASES = 16;

#ifndef DIAG
#define DIAG 0
#endif
#ifndef DIAG_WAVE
#define DIAG_WAVE 1
#endif
#ifndef DIAG_MODE
#define DIAG_MODE 0
#endif
#ifndef DIAG_MASK_A
#define DIAG_MASK_A 0
#define DIAG_MASK_B 0
#endif
#if DIAG
#define PROBE(k) do { if (__builtin_amdgcn_mbcnt_hi(~0u, __builtin_amdgcn_mbcnt_lo(~0u, 0u)) == 0 && wave == 0) { const unsigned long long t_ = rt(); if (blockIdx.x == 0) __hip_atomic_store((unsigned long long*)(ws + WS_TS) + 17 + (k), t_, RLX_AGENT); atomicMax((unsigned long long*)(ws + WS_TS) + 40 + (k), t_); } } while (0)
#else
#define PROBE(k) do {} while (0)
#endif
struct Args { Bufs B; int ph_lo, ph_hi, li, pad; };

__device__ __forceinline__ void p0_transpose_item(const float* W, const float* gain, int K, int Nsrc, int Ndst, int mode, bf16* WT, LAS float* scr, int item, int lane) {
    const int nblk = Ndst / 32, kb = item / nblk, nb = item % nblk, k0 = 64 * kb, n0 = 32 * nb;
    const int n4 = 4 * (lane & 7), ksub = lane >> 3, nn = n0 + n4; const int s = mode == 0 ? nn : (mode == 1 ? src_col_ab(nn) : src_col_cd(nn));
    const float* src = W + (size_t)(k0 + ksub) * Nsrc + (s >= 0 ? s : 0);
    f32x4 v[8];
#pragma unroll
    for (int i = 0; i < 8; ++i) v[i] = *(const f32x4*)(src + (size_t)(8 * i) * Nsrc);
    if (gain) {
#pragma unroll
        for (int i = 0; i < 8; ++i) v[i] = v[i] * gain[k0 + 8 * i + ksub]; }
#pragma unroll
    for (int i = 0; i < 8; ++i) { LAS float* d = scr + (8 * i + ksub) * 33 + n4; const f32x4 x = s >= 0 ? v[i] : (f32x4){0.f, 0.f, 0.f, 0.f}; d[0] = x[0]; d[1] = x[1]; d[2] = x[2]; d[3] = x[3]; }
    LDS_WAIT(); asm volatile("" ::: "memory");
    const int c = lane & 7;
#pragma unroll
    for (int j = 0; j < 4; ++j) { const int n = (lane >> 3) + 8 * j; const LAS float* sp = scr + (8 * c) * 33 + n;
        v4u o; o.x = pk2(sp[0 * 33], sp[1 * 33]); o.y = pk2(sp[2 * 33], sp[3 * 33]); o.z = pk2(sp[4 * 33], sp[5 * 33]); o.w = pk2(sp[6 * 33], sp[7 * 33]);
        __builtin_nontemporal_store(o, (GAS v4u*)(WT + (size_t)(n0 + n) * K + k0 + 8 * c)); }
    LDS_WAIT(); asm volatile("" ::: "memory");
}
__device__ __forceinline__ float wave_sum(float v) { return red64_sum(v); }
constexpr int WI0 = 16 * 96, WI1 = 16 * 32, WI2 = 16 * 128, WI3 = 64 * 32, WI4 = 16 * 104, W_NITEMS = WI0 + WI1 + WI2 + WI3 + WI4 + WI1 + WI2 + WI3;
template <class AP> __device__ __forceinline__ void wconv_item(AP ap, const float* nmix, const float* nmlp, unsigned char* ws, LAS float* scr, int it, int lane) {
    int r = it;
    if (r < WI0) { p0_transpose_item(ap->B.in[I_WAB], nmix, D, AB_IN, NAB, 1, (bf16*)(ws + WS_WAB), scr, r, lane); return; } r -= WI0;
    if (r < WI1) { p0_transpose_item(ap->B.in[I_WOA], nullptr, D, D, D, 0, (bf16*)(ws + WS_WOA), scr, r, lane); return; } r -= WI1;
    if (r < WI2) { p0_transpose_item(ap->B.in[I_WUP], nmlp, D, FF, FF, 0, (bf16*)(ws + WS_WU0), scr, r, lane); return; } r -= WI2;
    if (r < WI3) { p0_transpose_item(ap->B.in[I_WDN], nullptr, FF, D, D, 0, (bf16*)(ws + WS_WD0), scr, r, lane); return; } r -= WI3;
    if (r < WI4) { p0_transpose_item(ap->B.in[I_WCD], nmix + D, D, CD_IN, NCDW, 2, (bf16*)(ws + WS_WCD), scr, r, lane); return; } r -= WI4;
    if (r < WI1) { p0_transpose_item(ap->B.in[I_WOC], nullptr, D, D, D, 0, (bf16*)(ws + WS_WOC), scr, r, lane); return; } r -= WI1;
    if (r < WI2) { p0_transpose_item(ap->B.in[I_WUP] + (size_t)D * FF, nmlp + D, D, FF, FF, 0, (bf16*)(ws + WS_WU1), scr, r, lane); return; } r -= WI2;
    p0_transpose_item(ap->B.in[I_WDN] + (size_t)FF * D, nullptr, FF, D, D, 0, (bf16*)(ws + WS_WD1), scr, r, lane);
}
__device__ __forceinline__ void unit_done_signal(gu32* cnt, int tid) {
    asm volatile("s_waitcnt vmcnt(0)" ::: "memory"); __syncthreads();
    if (tid == 0) __hip_atomic_fetch_add(cnt, 1u, RLX_AGENT);
}
__device__ __forceinline__ void units_wait(gu32* cnt, unsigned want, int tid) {
    if (tid == 0) { unsigned sp = 0u; while (__hip_atomic_load(cnt, RLX_AGENT) < want) { __builtin_amdgcn_s_sleep(4); if (++sp > (1u << 22)) break; }
        __builtin_amdgcn_fence(__ATOMIC_ACQUIRE, "agent"); asm volatile("s_waitcnt vmcnt(0)" ::: "memory"); }
    __syncthreads();
}

__global__ void __launch_bounds__(NWAVES * 64, 2) mk_fwd(Args a) {
    extern __shared__ __attribute__((aligned(16))) unsigned char lds[];
    LAS unsigned char* L = (LAS unsigned char*)lds;
    const int tid = threadIdx.x, wave0 = __builtin_amdgcn_readfirstlane(tid >> 6);
    unsigned char* ws0 = a.B.ws;
    for (int u = tid; u < (LDS_BYTES - LDSCTL_OFF) / 4; u += NWAVES * 64) ((LAS unsigned*)(L + LDSCTL_OFF))[u] = 0u;
    __syncthreads();
    XcdBarrier bar = xcd_barrier_post((unsigned*)(ws0 + WS_CTL) + CW_BAR + a.li * XCD_BAR_WORDS, (volatile LAS unsigned*)(L + MISC_OFF) + 8);

#if DIAG
    if (blockIdx.x == 0 && tid == 0) __hip_atomic_store((unsigned long long*)(ws0 + WS_TS), rt(), RLX_AGENT);
#endif
    for (int ph = a.ph_lo; ph < a.ph_hi; ++ph) {
        int lane_p = __builtin_amdgcn_mbcnt_hi(~0u, __builtin_amdgcn_mbcnt_lo(~0u, 0u)); asm volatile("" : "+v"(lane_p));
        typedef const __attribute__((address_space(4))) Args* KArgPtr;
        KArgPtr ap = (KArgPtr)__builtin_amdgcn_kernarg_segment_ptr(); asm volatile("" : "+s"(ap));
        unsigned char* ws = ap->B.ws;
        int bx_p = blockIdx.x, G = gridDim.x, wave = wave0; asm volatile("" : "+s"(bx_p), "+s"(G), "+s"(wave));
        const int gw = bx_p * NWAVES + wave, NGW = G * NWAVES;
        if (ph == PH_PRO) {
            LAS float* scr = (LAS float*)(L + RING_OFF + wave * 16384);
            constexpr int I0 = WI0;
            const float* nmix = ap->B.in[I_NMIX]; const float* nmlp = ap->B.in[I_NMLP];
            for (int it = gw; it < I0; it += NGW) wconv_item(ap, nmix, nmlp, ws, scr, it, lane_p);
            for (int m = gw; m < M; m += 2 * NGW) {
                const int m1 = m + NGW < M ? m + NGW : m;
                const GAS f32x4* xr0 = (const GAS f32x4*)(ap->B.in[I_X] + (size_t)m * D) + lane_p; const GAS f32x4* xr1 = (const GAS f32x4*)(ap->B.in[I_X] + (size_t)m1 * D) + lane_p;
                f32x4 v0[4], v1[4];
#pragma unroll
                for (int j = 0; j < 4; ++j) { v0[j] = xr0[64 * j]; v1[j] = xr1[64 * j]; }
#pragma unroll
                for (int q = 0; q < 2; ++q) { const int mm = q ? m1 : m; if (q && m1 == m) break;
                    GAS unsigned long long* o8 = (GAS unsigned long long*)((bf16*)(ws + WS_HB) + (size_t)mm * D) + lane_p; float sq = 0.f;
#pragma unroll
                    for (int j = 0; j < 4; ++j) { const f32x4 v = q ? v1[j] : v0[j]; sq += (v.x * v.x + v.y * v.y) + (v.z * v.z + v.w * v.w);
                        o8[64 * j] = (unsigned long long)pk2(v.x, v.y) | ((unsigned long long)pk2(v.z, v.w) << 32); }
                    sq = wave_sum(sq);
                    if (lane_p < 4) ((float*)(ws + WS_SSQ))[(size_t)mm * 4 + lane_p] = lane_p == 0 ? sq : 0.f; }
            }
        } else if (ph == PH_FINAL) {
            const float* w = ap->B.in[I_NFIN];
            for (int m = gw; m < M; m += NGW) {
                GAS f32x4* hr = (GAS f32x4*)(ap->B.h + (size_t)m * D) + lane_p; f32x4 v[4]; float s = 0.f;
#pragma unroll
                for (int j = 0; j < 4; ++j) { v[j] = hr[64 * j]; s += (v[j].x * v[j].x + v[j].y * v[j].y) + (v[j].z * v[j].z + v[j].w * v[j].w); }
                const float r = 1.0f / sqrtf(wave_sum(s) * (1.f / D) + EPS);
#pragma unroll
                for (int j = 0; j < 4; ++j) { const f32x4 g = *((const f32x4*)w + lane_p + 64 * j); hr[64 * j] = v[j] * r * g; }
            }
        } else {
            const int layer = (ph - 1) / 7, kind = (ph - 1) % 7;
            if (kind == 2) {
#if DIAG
                if (blockIdx.x == 0 && __builtin_amdgcn_mbcnt_hi(~0u, __builtin_amdgcn_mbcnt_lo(~0u, 0u)) == 0 && wave == 0) __hip_atomic_store((unsigned long long*)(ws0 + WS_TS) + ph + 1, rt(), RLX_AGENT);
#endif
                continue; }
            if (kind == 0) {
                pg8::StaticOrder S;
                if (layer == 0) { pg8::Gemm g{(const bf16*)(ws + WS_HB), (const bf16*)(ws + WS_WAB), M, NAB, D}; S.init(M, NAB, G, bx_p);
                    pg8::EpiProj<0> E{ws, (const float*)(ws + WS_SSQ)}; pg8::gemm_phase<pg8::EpiProj<0>, pg8::StaticOrder, true, true>(L + RING_OFF, g, S, E, (wave << 6) | lane_p); }
                else { pg8::Gemm g{(const bf16*)(ws + WS_HB), (const bf16*)(ws + WS_WCD), M, NCD, D}; S.init(M, NCD, G, bx_p);
                    pg8::EpiProj<1> E{ws, (const float*)(ws + WS_SSQ)}; pg8::gemm_phase<pg8::EpiProj<1>, pg8::StaticOrder, true, true>(L + RING_OFF, g, S, E, (wave << 6) | lane_p); }
            } else if (kind == 1) {
                if (layer == 0) PROBE(0);
                int tid_p = (wave << 6) | lane_p; asm volatile("" : "+v"(tid_p));
                if (layer == 1) for (int u = bx_p; u < 512; u += G) { gla::pass_a_unit(L, ws, ap->B.in[I_GW2], ap->B.in[I_GB], u >> 8, (u >> 6) & 3, u & 63, tid_p); unit_done_signal((gu32*)(ws + WS_CNTA) + 64, tid_p); }
                if (layer == 1) PROBE(6);
                if (layer == 0) {
                    for (int u = bx_p; u < 256; u += G) { ssd::fl_unit(L, ws, ap->B.in[I_FBIAS], u >> 7, (u >> 6) & 1, u & 63, tid_p); unit_done_signal((gu32*)(ws + WS_CNTA) + 128, tid_p); }
                    PROBE(1);
                    units_wait((gu32*)(ws + WS_CNTA) + 128, 256u, tid_p);
                    PROBE(2);
                }
                unsigned order = 0x76543210u;
                if (layer == 0) { order = 0u; const float* fbp = ap->B.in[I_FBIAS];
                    for (int hh = 0; hh < 8; ++hh) { const float bv = fbp[hh]; int rk = 0;
                        for (int h2 = 0; h2 < 8; ++h2) { const float b2 = fbp[h2]; rk += (b2 > bv || (b2 == bv && h2 < hh)) ? 1 : 0; }
                        order |= (unsigned)hh << (4 * rk); } }
                gu32* qc = (gu32*)(ws + WS_QCTR) + 64 * ph;
                volatile LAS unsigned* qslot = (volatile LAS unsigned*)(L + MISC_OFF) + 24;
                unsigned nxt = 0u; if (tid_p == 0) nxt = __hip_atomic_fetch_add(qc, 1u, RLX_AGENT);
                for (;;) {
                    if (tid_p == 0) *qslot = nxt;
                    __syncthreads();
                    unsigned u = __builtin_amdgcn_readfirstlane(*qslot);
                    if (u >= (layer == 0 ? 768u : 512u)) break;
                    if (tid_p == 0) nxt = __hip_atomic_fetch_add(qc, 1u, RLX_AGENT);
                    if (layer == 0 && u >= 256u && u < 512u) {
                        const int v_ = (int)u - 256; ssd::pass_a_unit(L, ws, ap->B.in[I_CONVW], ap->B.in[I_CONVB], ap->B.in[I_DTB], ap->B.in[I_ALOG], v_ >> 7, (v_ >> 6) & 1, v_ & 63, tid_p);
                        unit_done_signal((gu32*)(ws + WS_CNTA), tid_p); continue; }
                    if (layer == 0 && u >= 512u) u -= 256u;
                    const int rk = u >> 6, rem = u & 63, qb = 31 - (rem >> 1), bb = rem & 1, hh = (order >> (4 * rk)) & 7;
                    if (layer == 0) att::attn_unit<0>(L, ws, ap->B.in[I_FBIAS], (const float*)(ws + WS_KMAX), bb, hh, qb, tid_p);
                    else att::attn_unit<1>(L, ws, nullptr, nullptr, bb, hh, qb, tid_p);
                }
                if (layer == 0) PROBE(3); else PROBE(7);
                units_wait((gu32*)(ws + WS_CNTA) + 64 * layer, layer ? 512u : 256u, tid_p);
                if (layer == 0) ssd::pass_b(ws, bx_p, G, tid_p); else gla::pass_b(ws, bx_p, G, tid_p);
                if (layer == 0) PROBE(4); else PROBE(8);
                if (layer == 0) {
                    LAS float* scr = (LAS float*)(L + RING_OFF + wave * 16384); gu32* wq = (gu32*)(ws + WS_QCTR) + 64 * 15;
                    const float* nmix = ap->B.in[I_NMIX]; const float* nmlp = ap->B.in[I_NMLP];
                    for (;;) { unsigned i0 = 0u; if (lane_p == 0) i0 = __hip_atomic_fetch_add(wq, 4u, RLX_AGENT); i0 = __builtin_amdgcn_readfirstlane(i0) + WI0;
                        if (i0 >= (unsigned)W_NITEMS) break;
                        for (unsigned q = 0; q < 4u && i0 + q < (unsigned)W_NITEMS; ++q) wconv_item(ap, nmix, nmlp, ws, scr, (int)(i0 + q), lane_p); }
                }
                if (layer == 0) PROBE(5);
            } else if (kind == 3 && layer == 1) {
                int tid_p = (wave << 6) | lane_p; asm volatile("" : "+v"(tid_p));
                for (int u = bx_p; u < 512; u += G) gla::pass_c_unit(L, ws, ap->B.in[I_GLAN], u >> 8, (u >> 6) & 3, u & 63, tid_p);
            } else if (kind == 3 && layer == 0) {
                int tid_p = (wave << 6) | lane_p; asm volatile("" : "+v"(tid_p));
                for (int u = bx_p; u < 256; u += G) ssd::pass_c_unit(L, ws, ap->B.in[I_SSD_D], ap->B.in[I_SSDN], u >> 7, (u >> 6) & 1, u & 63, tid_p);
            } else if (kind == 4 || kind == 6) {
                const bf16* A = kind == 4 ? (const bf16*)(ws + WS_CAT) : (const bf16*)(ws + WS_U);
                const bf16* Bt = (const bf16*)(ws + (kind == 4 ? (layer ? WS_WOC : WS_WOA) : (layer ? WS_WD1 : WS_WD0)));
                pg8::Gemm g{A, Bt, M, D, kind == 4 ? D : FF}; pg8::StaticOrder S; S.init(M, D, G, bx_p);
                if (ph == 14) {
                    pg8::EpiFinal E{(const bf16*)(ws + WS_HB), ap->B.h, ap->B.in[I_NFIN], (float*)(ws + WS_XBUF), (unsigned*)(ws + WS_FCNT), (LAS float*)(L + EPI_RED_OFF)};
                    pg8::gemm_phase<pg8::EpiFinal, pg8::StaticOrder, true, true>(L + RING_OFF, g, S, E, (wave << 6) | lane_p);
                } else {
                pg8::EpiRes E{(bf16*)(ws + WS_HB), (float*)(ws + WS_SSQ), (LAS float*)(L + EPI_RED_OFF)};
                pg8::gemm_phase<pg8::EpiRes, pg8::StaticOrder, true, true>(L + RING_OFF, g, S, E, (wave << 6) | lane_p);
                }
            } else if (kind == 5) {
                pg8::Gemm g{(const bf16*)(ws + WS_HB), (const bf16*)(ws + (layer ? WS_WU1 : WS_WU0)), M, FF, D}; pg8::StaticOrder S; S.init(M, FF, G, bx_p);
                pg8::EpiUp E{(bf16*)(ws + WS_U), (const float*)(ws + WS_SSQ)};
                pg8::gemm_phase<pg8::EpiUp, pg8::StaticOrder, true, true>(L + RING_OFF, g, S, E, (wave << 6) | lane_p);
            }
        }
        if (DIAG || ph + 1 < a.ph_hi) { XcdBarrier bl = bar; asm volatile("" : "+s"(bl.bar), "+s"(bl.x)); xcd_barrier(bl); }
#if DIAG
        if (blockIdx.x == 0 && __builtin_amdgcn_mbcnt_hi(~0u, __builtin_amdgcn_mbcnt_lo(~0u, 0u)) == 0 && wave == 0) __hip_atomic_store((unsigned long long*)(ws0 + WS_TS) + ph + 1, rt(), RLX_AGENT);
#endif
    }
#if DIAG
    {
        XcdBarrier bl = bar; xcd_barrier(bl);
        float ta = 0.f, tb = 0.f;
        for (int ph = 0; ph < 30; ++ph) { if (ph == 16) continue; const unsigned long long t0 = __hip_atomic_load((unsigned long long*)(ws0 + WS_TS) + ph, RLX_AGENT), t1 = __hip_atomic_load((unsigned long long*)(ws0 + WS_TS) + ph + 1, RLX_AGENT);
            const float d = (float)(t1 - t0); if ((DIAG_MASK_A >> ph) & 1) ta += d; if ((DIAG_MASK_B >> ph) & 1) tb += d; }
        if (DIAG_MASK_B == 0x40000000u) tb = 200.f * (float)__hip_atomic_load((unsigned*)(ws0 + WS_TS) + 100, RLX_AGENT);
        if ((DIAG_MASK_B & 0xFFFFFFF0u) == 0x60000000u) { const float n_ = (float)__hip_atomic_load((unsigned long long*)(ws0 + WS_TS) + 62, RLX_AGENT), a_ = (float)__hip_atomic_load((unsigned long long*)(ws0 + WS_TS) + 60, RLX_AGENT), b_ = (float)__hip_atomic_load((unsigned long long*)(ws0 + WS_TS) + 61, RLX_AGENT);
            const float c_ = (float)__hip_atomic_load((unsigned long long*)(ws0 + WS_TS) + 63, RLX_AGENT); tb = ((DIAG_MASK_B & 3) == 0 ? a_ : (DIAG_MASK_B & 3) == 1 ? b_ : (DIAG_MASK_B & 3) == 2 ? a_ + b_ : c_) / fmaxf(n_, 1.f) * 2.f; }
        if ((DIAG_MASK_B & 0xFFFFFFF0u) == 0x80000000u) tb = (float)(__hip_atomic_load((unsigned long long*)(ws0 + WS_TS) + 40 + (DIAG_MASK_B & 15), RLX_AGENT) - __hip_atomic_load((unsigned long long*)(ws0 + WS_TS) + ((DIAG_MASK_B & 15) >= 6 ? 9 : 2), RLX_AGENT));
        if ((DIAG_MASK_B & 0xFFFFFFF0u) == 0x70000000u) tb = 0.1f * (float)__hip_atomic_load((unsigned long long*)(ws0 + WS_TS) + 64 + (DIAG_MASK_B & 15), RLX_AGENT);
        if ((DIAG_MASK_B & 0xFFFFFFF0u) == 0x50000000u) tb = 0.1f * (float)__hip_atomic_load((unsigned long long*)(ws0 + WS_TS) + 60 + (DIAG_MASK_B & 3), RLX_AGENT);
        const float sc = 1.f + ta * 1e-6f; const int lane = __builtin_amdgcn_mbcnt_hi(~0u, __builtin_amdgcn_mbcnt_lo(~0u, 0u));
        LAS unsigned* tk = (LAS unsigned*)(L + MISC_OFF) + 16; int wv = 0; if (lane == 0) wv = (int)atomicAdd((unsigned*)tk, 1u); wv = __builtin_amdgcn_readfirstlane(wv);
        const int gw = blockIdx.x * NWAVES + wv, NGW = gridDim.x * NWAVES;
        for (int m = gw; m < M; m += NGW) { GAS f32x4* hr = (GAS f32x4*)(a.B.h + (size_t)m * D) + lane;
#pragma unroll
            for (int j = 0; j < 4; ++j) { f32x4 v = hr[64 * j] * sc; if (m == 0 && lane == 0 && j == 0) v.x += tb * 5e-4f; hr[64 * j] = v; } }
    }
#endif
}
static int g_grid = 0;
static void launch_mk(const Bufs& B, int lo, int hi, int li, hipStream_t stream) {
    Args a{}; a.B = B; a.ph_lo = lo; a.ph_hi = hi; a.li = li; a.pad = 0;
    hipLaunchKernelGGL(mk_fwd, dim3(g_grid), dim3(NWAVES * 64), LDS_BYTES, stream, a);
}
extern "C" void kernel_launch(void* const* d_in, const int* in_sizes, int n_in, void* d_out, int out_size, void* d_ws, size_t ws_size, hipStream_t stream) {
    if (n_in != 20 || out_size != M * D || ws_size < WS_END) { fprintf(stderr, "kernel_launch: unexpected shapes n_in %d out %d ws %zu\n", n_in, out_size, ws_size); return; }
    if (g_grid == 0) {
        int dev = 0, cus = 0, per_cu = 0;
        if (hipGetDevice(&dev) != hipSuccess || hipDeviceGetAttribute(&cus, hipDeviceAttributeMultiprocessorCount, dev) != hipSuccess) { g_grid = -1; return; }
        if (hipFuncSetAttribute((const void*)mk_fwd, hipFuncAttributeMaxDynamicSharedMemorySize, LDS_BYTES) != hipSuccess) { fprintf(stderr, "hipFuncSetAttribute failed\n"); g_grid = -1; return; }
        if (hipOccupancyMaxActiveBlocksPerMultiprocessor(&per_cu, (const void*)mk_fwd, NWAVES * 64, LDS_BYTES) != hipSuccess || per_cu < 1) fprintf(stderr, "occupancy query says %d\n", per_cu);
        (void)hipGetLastError();
        g_grid = cus;
    }
    if (g_grid < 0) return;
    Bufs B{};
    for (int i = 0; i < 20; ++i) B.in[i] = (const float*)d_in[i];
    B.h = (float*)d_out; B.ws = (unsigned char*)d_ws;
    hipMemsetAsync((char*)d_ws + WS_CTL, 0, CTL_ZERO_BYTES, stream);
    launch_mk(B, 0, 15, 0, stream);
}
```

```cpp
#include <hip/hip_runtime.h>
#include <cstdio>
#include <cstdint>
#define GAS __attribute__((address_space(1)))
#define LAS __attribute__((address_space(3)))
typedef unsigned short bf16;
typedef unsigned v4u __attribute__((ext_vector_type(4)));
typedef float f32x4 __attribute__((ext_vector_type(4)));
typedef short bf16x8 __attribute__((ext_vector_type(8)));
typedef GAS unsigned gu32;
typedef GAS unsigned long long gu64;
#define RLX_AGENT __ATOMIC_RELAXED, __HIP_MEMORY_SCOPE_AGENT
#define LDS_WAIT() asm volatile("s_waitcnt lgkmcnt(0)" ::: "memory")
#define VM_WAIT() asm volatile("s_waitcnt vmcnt(0)" ::: "memory")
__device__ __forceinline__ unsigned long long rt() { return __builtin_amdgcn_s_memrealtime(); }
__device__ __forceinline__ unsigned f2bf(float f) { unsigned u = __builtin_bit_cast(unsigned, f); return (u + 0x7fffu + ((u >> 16) & 1u)) >> 16; }
__device__ __forceinline__ unsigned pk2(float lo, float hi) { return f2bf(lo) | (f2bf(hi) << 16); }

#define XB_TMO      128
#define XB_XCNT(j)  (256  + 64 * (j))
#define XB_XSUB(j)  (1280 + 64 * (j))
#define XB_XGEN(j)  (2304 + 64 * (j))
#define XB_TOP      3328
#define XB_TOPGEN   3392
#define XCD_BAR_WORDS 3456
#define XB_SPIN_CAP (1u << 18)

__device__ __forceinline__ unsigned xb_ld(unsigned* p)              { return __hip_atomic_load(p, __ATOMIC_RELAXED, __HIP_MEMORY_SCOPE_AGENT); }
__device__ __forceinline__ unsigned xb_add(unsigned* p, unsigned v) { return __hip_atomic_fetch_add(p, v, __ATOMIC_RELAXED, __HIP_MEMORY_SCOPE_AGENT); }
__device__ __forceinline__ unsigned xb_xcc_id() { return (unsigned)__builtin_amdgcn_s_getreg((3 << 11) | 20) & 0xFu; }
#define XB_SPIN(cond, bar) do { unsigned _sp = 0; while (cond) { __builtin_amdgcn_s_sleep(1); \
    if ((++_sp & 255u) == 0u) { if (xb_ld(&(bar)[XB_TMO])) break; if (_sp > XB_SPIN_CAP) { atomicAdd(&(bar)[XB_TMO], 1u); break; } } } } while (0)

struct XcdBarrier {
    unsigned* bar; unsigned x;
    volatile LAS unsigned* st;
};

__device__ __forceinline__ XcdBarrier xcd_barrier_post(unsigned* bar, volatile LAS unsigned* st) {
    XcdBarrier b; b.bar = bar; b.x = xb_xcc_id(); b.st = st;
    if (threadIdx.x == 0) (void)xb_add(&bar[XB_XCNT(b.x)], 1u);
    return b;
}
__device__ __forceinline__ void xcd_barrier_complete(unsigned* bar, unsigned x, unsigned& nloc, unsigned& nx) {
    const unsigned G = gridDim.x * gridDim.y * gridDim.z;
    unsigned sum, cnt, mine, sp = 0u;
    for (;;) {
        sum = 0u; cnt = 0u; mine = 0u;
#pragma unroll
        for (unsigned j = 0; j < 16; ++j) { const unsigned c = xb_ld(&bar[XB_XCNT(j)]); sum += c; cnt += (c > 0u) ? 1u : 0u; mine = (j == x) ? c : mine; }
        if (sum == G) break;
        __builtin_amdgcn_s_sleep(1);
        if ((++sp & 255u) == 0u) { if (xb_ld(&bar[XB_TMO])) break; if (sp > XB_SPIN_CAP) { atomicAdd(&bar[XB_TMO], 1u); break; } }
    }
    nloc = mine > 0u ? mine : 1u; nx = cnt > 0u ? cnt : 1u;
}

__device__ __forceinline__ void xcd_barrier(const XcdBarrier& b) {
    asm volatile("s_waitcnt vmcnt(0)" ::: "memory");
    __syncthreads();
    if (threadIdx.x == 0) {
        unsigned* bar = b.bar;
        __builtin_amdgcn_s_waitcnt(0);
        unsigned nloc = b.st[0], nx = b.st[1];
        if (nloc == 0u) { xcd_barrier_complete(bar, b.x, nloc, nx); b.st[0] = nloc; b.st[1] = nx; }
        const unsigned old = xb_add(&bar[XB_XSUB(b.x)], 1u);
        const unsigned gen = old / nloc;
        if (old + 1u == (gen + 1u) * nloc) {
            __builtin_amdgcn_fence(__ATOMIC_RELEASE, "agent");
            asm volatile("s_waitcnt vmcnt(0)" ::: "memory");
            const unsigned og = xb_add(&bar[XB_TOP], 1u);
            const unsigned tg = og / nx;
            if (og + 1u == (tg + 1u) * nx) xb_add(&bar[XB_TOPGEN], 1u);
            else XB_SPIN(xb_ld(&bar[XB_TOPGEN]) == tg, bar);
            __builtin_amdgcn_fence(__ATOMIC_ACQUIRE, "agent");
            asm volatile("s_waitcnt vmcnt(0)" ::: "memory");
        } else {
            XB_SPIN(xb_ld(&bar[XB_TOPGEN]) == gen, bar);
            __builtin_amdgcn_fence(__ATOMIC_ACQUIRE, "agent");
            asm volatile("s_waitcnt vmcnt(0)" ::: "memory");
        }
    }
    __syncthreads();
}

__device__ __forceinline__ int xl_lane() { int l = __builtin_amdgcn_mbcnt_hi(~0u, __builtin_amdgcn_mbcnt_lo(~0u, 0u)); asm volatile("" : "+v"(l)); return l; }
__device__ __forceinline__ float bperm(int srclane, float v) { return __builtin_bit_cast(float, __builtin_amdgcn_ds_bpermute(srclane << 2, __builtin_bit_cast(int, v))); }
__device__ __forceinline__ float red16_sum(float v) { const int l = xl_lane(); v += bperm(l ^ 1, v); v += bperm(l ^ 2, v); v += bperm(l ^ 4, v); v += bperm(l ^ 8, v); return v; }
__device__ __forceinline__ float red16_max(float v) { const int l = xl_lane(); v = fmaxf(v, bperm(l ^ 1, v)); v = fmaxf(v, bperm(l ^ 2, v)); v = fmaxf(v, bperm(l ^ 4, v)); v = fmaxf(v, bperm(l ^ 8, v)); return v; }
__device__ __forceinline__ float swap16_sum(float v) { const int l = xl_lane(); return v + bperm(l ^ 16, v); }
__device__ __forceinline__ float swap32_sum(float v) { const int l = xl_lane(); return v + bperm(l ^ 32, v); }
__device__ __forceinline__ float swap32_max(float v) { const int l = xl_lane(); return fmaxf(v, bperm(l ^ 32, v)); }
__device__ __forceinline__ float swap32_other(float v, int hi) { const int l = xl_lane(); return bperm(l ^ 32, v); }
__device__ __forceinline__ float red32_sum(float v) { return swap16_sum(red16_sum(v)); }
__device__ __forceinline__ float red64_sum(float v) { return swap32_sum(swap16_sum(red16_sum(v))); }
constexpr int BATCH = 2, T = 8192, D = 1024, M = BATCH * T, FF = 4096;
constexpr int NH = 8, HD = 64;
constexpr int AB_IN = 2832, CD_IN = 3088;
constexpr int NAB = 3072, NCD = 3072, NCDW = 3328;
constexpr float EPS = 1e-5f;
constexpr float LOG2E = 1.4426950408889634f;
constexpr float C2 = 0.125f * LOG2E;

constexpr size_t MiB = 1u << 20;
constexpr size_t WS_CTL = 0;
constexpr size_t WS_KMAX = 36 * 1024;
constexpr size_t WS_SSQ = 1 * MiB;
constexpr size_t WS_WAB = 2 * MiB;
constexpr size_t WS_WOA = 8 * MiB;
constexpr size_t WS_WU0 = 10 * MiB;
constexpr size_t WS_WD0 = 18 * MiB;
constexpr size_t WS_WCD = 26 * MiB;
constexpr size_t WS_WOC = 33 * MiB;
constexpr size_t WS_WU1 = 35 * MiB;
constexpr size_t WS_WD1 = 43 * MiB;
constexpr size_t WS_HB = 52 * MiB;
constexpr size_t WS_TMP = 52 * MiB;
constexpr size_t WS_Q = 84 * MiB, WS_K = 100 * MiB, WS_V = 116 * MiB;
constexpr size_t WS_Z = 132 * MiB;
constexpr size_t WS_XBC = 148 * MiB;
constexpr size_t WS_XC = 172 * MiB;
constexpr size_t WS_GR = 164 * MiB;
constexpr size_t WS_GLOW = 180 * MiB;
constexpr size_t WS_CAT = 212 * MiB;
constexpr size_t WS_LA = 228 * MiB;
constexpr size_t WS_FD = 244 * MiB;
constexpr size_t WS_FL = 246 * MiB;
constexpr size_t WS_DTA = 246 * MiB;
constexpr size_t WS_CHD = 520 * 1024;
constexpr size_t WS_SLOC = 196 * MiB;
constexpr size_t WS_SPREV = 248 * MiB;
constexpr size_t WS_GDEC = 640 * 1024;
constexpr size_t WS_GLOC = 196 * MiB;
constexpr size_t WS_GPREV = 244 * MiB;
constexpr size_t WS_QCTR = 40 * 1024;
constexpr size_t WS_CNTA = 44 * 1024;
constexpr size_t WS_TS = 800 * 1024;
constexpr size_t WS_FLOC = 247 * MiB;
constexpr size_t WS_FTOT = 920 * 1024;
constexpr size_t WS_XBUF = 248 * MiB;
constexpr size_t WS_FCNT = 46 * 1024;
constexpr size_t WS_U = 84 * MiB;
constexpr size_t WS_END = 256 * MiB;

struct Bufs {
    const float* in[20];
    float* h;
    unsigned char* ws;
};
__device__ __forceinline__ float* ws_f(const Bufs& b, size_t off) { return (float*)(b.ws + off); }
__device__ __forceinline__ bf16* ws_b(const Bufs& b, size_t off) { return (bf16*)(b.ws + off); }

enum { I_X = 0, I_NMIX, I_NMLP, I_NFIN, I_WAB, I_FBIAS, I_CONVW, I_CONVB, I_DTB, I_ALOG, I_SSD_D, I_SSDN, I_WOA, I_WCD, I_GW2, I_GB, I_GLAN, I_WOC, I_WUP, I_WDN };

__device__ __forceinline__ float bf2f(unsigned short b) { return __builtin_bit_cast(float, (unsigned)b << 16); }
__device__ __forceinline__ float softplus_f(float x) { return fmaxf(x, 0.f) + log1pf(__expf(-fabsf(x))); }
__device__ __forceinline__ float logsig_f(float x) { return fminf(x, 0.f) - log1pf(__expf(-fabsf(x))); }
__device__ __forceinline__ float silu_f(float x) { return x * __builtin_amdgcn_rcpf(1.f + __builtin_amdgcn_exp2f(-x * LOG2E)); }
__device__ __forceinline__ float row_rstd(const float* ssq, int row) {
    const f32x4 a = *(const f32x4*)(ssq + (size_t)row * 4);
    return 1.0f / sqrtf(((a.x + a.y) + (a.z + a.w)) * (1.0f / D) + EPS);
}
__device__ __forceinline__ size_t qkv_off(int row, int head, int d) { const int b = row / T, t = row % T; return ((size_t)(b * NH + head) * T + t) * HD + d; }

__device__ __forceinline__ int src_col_ab(int n) { if (n < 1536) return n; if (n < 2816) return n + 8; if (n < 2824) return n - 1280; if (n < 2832) return n; return -1; }
__device__ __forceinline__ int src_col_cd(int n) { if (n < 2560) return n; if (n < 3072) return n + 16; if (n < 3088) return n - 512; return -1; }

namespace pg8 {
#define PG8_LAS __attribute__((address_space(3)))
typedef unsigned short bf16_t;
typedef short bf16x8 __attribute__((ext_vector_type(8)));
typedef float f32x4 __attribute__((ext_vector_type(4)));
typedef unsigned u32x4 __attribute__((ext_vector_type(4)));
constexpr int BM = 256, BK = 64, HALF = 128, HTB = HALF * BK * 2  , STAGE_BYTES = 8 * HTB, NXCD = 8, WGM = 8;

__host__ __device__ __forceinline__ int lds_byte(int r, int c) { const int st = (r >> 4) * 2 + (c >> 5), rr = r & 15, cc = c & 31, ob = rr * 64 + cc * 2; return st * 1024 + (ob ^ (((ob >> 9) & 1) << 5)); }
__host__ __device__ __forceinline__ void stage_rc(int b, int& R, int& C) { const int st = b / 1024, sb = b % 1024, swz = sb ^ (((sb >> 9) & 1) << 5); R = (st >> 1) * 16 + swz / 64; C = (st & 1) * 32 + (swz % 64) / 2; }
__host__ __device__ __forceinline__ int perm32(int rho) { const int n = rho >> 4, i = rho & 15; return 8 * (i >> 2) + 4 * n + (i & 3); }

struct Unit { int pm, pn; };
struct Gemm { const bf16_t* A; const bf16_t* Bt; int M, N, K; };

struct StaticOrder {
    int nM, nN, nwg, G, c;
    __host__ __device__ void init(int M, int N, int G_, int c_) { nM = M / BM; nN = N / BM; nwg = nM * nN; G = G_; c = c_; }
    __host__ __device__ bool next(int i, Unit& u) const {
        const long L = (long)i * G + c; if (L >= nwg) return false;
        int wgid = (int)L; { const int q = nwg / NXCD, r = nwg % NXCD, xcd = wgid % NXCD, off = wgid / NXCD; wgid = (xcd < r ? xcd * (q + 1) : r * (q + 1) + (xcd - r) * q) + off; }
        const int nig = WGM * nN, gid = wgid / nig, fm = gid * WGM, gsz = (nM - fm) < WGM ? (nM - fm) : WGM;
        u.pm = fm + ((wgid % nig) % gsz); u.pn = (wgid % nig) / gsz; return true;
    }
    __device__ __forceinline__ void a_ready(const Unit&) const {}
    __device__ __forceinline__ void done(const Unit&) const {}
};
__device__ __forceinline__ unsigned cvt_pk_bf16(float lo, float hi) { unsigned r; asm volatile("v_cvt_pk_bf16_f32 %0, %1, %2" : "=v"(r) : "v"(lo), "v"(hi)); return r; }
typedef float f32x2 __attribute__((ext_vector_type(2)));
__device__ __forceinline__ void st16_wt(void* p, u32x4 v) { asm volatile("global_store_dwordx4 %0, %1, off sc1\n\ts_nop 1" :: "v"(p), "v"(v) : "memory"); }
__device__ __forceinline__ u32x4 pack8(f32x4 v0, f32x4 v1) { u32x4 w; w.x = cvt_pk_bf16(v0[0], v0[1]); w.y = cvt_pk_bf16(v0[2], v0[3]); w.z = cvt_pk_bf16(v1[0], v1[1]); w.w = cvt_pk_bf16(v1[2], v1[3]); return w; }
template <int LAYER> __device__ __forceinline__ void proj_store8(unsigned char* ws, int row, int c, f32x4 v0, f32x4 v1) {
    if (c < 1536) {
        const int which = c >> 9, cc = c & 511, head = cc >> 6, d = cc & 63; const float sc = which == 0 ? C2 : 1.f;
        bf16_t* dst = (bf16_t*)(ws + WS_Q + (size_t)which * (16 * MiB)) + qkv_off(row, head, d);
        st16_wt(dst, pack8(v0 * sc, v1 * sc)); return;
    }
    if (LAYER == 0) {
        if (c < 2048) { st16_wt((bf16_t*)(ws + WS_Z) + (size_t)row * 512 + (c - 1536), pack8(v0, v1)); }
        else if (c < 2816) { st16_wt((bf16_t*)(ws + WS_XBC) + (size_t)row * 768 + (c - 2048), pack8(v0, v1)); }
        else if (c < 2832) { float* p = (float*)(ws + WS_FD) + (size_t)row * 16 + (c - 2816); *(f32x4*)p = v0; *(f32x4*)(p + 4) = v1; }
    } else {
        if (c < 1792) { st16_wt((bf16_t*)(ws + WS_XBC) + (size_t)row * 256 + (c - 1536), pack8(v0 * 0.125f, v1 * 0.125f)); }
        else if (c < 2048) { st16_wt((bf16_t*)(ws + WS_XBC + 8 * MiB) + (size_t)row * 256 + (c - 1792), pack8(v0, v1)); }
        else if (c < 2560) { st16_wt((bf16_t*)(ws + WS_Z) + (size_t)row * 512 + (c - 2048), pack8(v0, v1)); }
        else if (c < 3072) { st16_wt((bf16_t*)(ws + WS_GR) + (size_t)row * 512 + (c - 2560), pack8(v0, v1)); }
        else if (c < 3088) { float* p = (float*)(ws + WS_GLOW) + (size_t)row * 16 + (c - 3072); *(f32x4*)p = v0; *(f32x4*)(p + 4) = v1; }
    }
}
__device__ __forceinline__ void load_rsv(float (&rsv)[2][4], const float* ssq, PG8_LAS float* rs_lds, int row0, int wr, int wc, int fr, int fq, bool first) {
    if (first) {
#pragma unroll
        for (int ai = 0; ai < 2; ++ai)
#pragma unroll
            for (int m = 0; m < 4; ++m) rsv[ai][m] = row_rstd(ssq, row0 + ai * HALF + m * 16);
        if (wc == 0 && fq == 0) {
#pragma unroll
            for (int ai = 0; ai < 2; ++ai)
#pragma unroll
                for (int m = 0; m < 4; ++m) rs_lds[ai * HALF + wr * 64 + m * 16 + fr] = rsv[ai][m]; }
    } else {
#pragma unroll
        for (int ai = 0; ai < 2; ++ai)
#pragma unroll
            for (int m = 0; m < 4; ++m) rsv[ai][m] = rs_lds[ai * HALF + wr * 64 + m * 16 + fr];
    }
}
__device__ __forceinline__ f32x4 rs_pre_issue(const float* ssq, const Unit& u, int tid) { return *(const f32x4*)(ssq + (size_t)(u.pm * BM + (tid & 255)) * 4); }
__device__ __forceinline__ void rs_pre_commit(PG8_LAS float* rs_lds, f32x4 a, int tid) { if (tid < 256) rs_lds[tid] = 1.0f / sqrtf(((a.x + a.y) + (a.z + a.w)) * (1.0f / D) + EPS); }
template <int LAYER> struct EpiProj {
    static constexpr bool PERM = true, AFTER_DRAIN = false, HAS_PRE = true;
    __device__ __forceinline__ f32x4 pre_issue(const Unit& u, int tid) const { return rs_pre_issue(ssq, u, tid); }
    __device__ __forceinline__ void pre_commit(f32x4 v, int tid) const { rs_pre_commit(rs_lds, v, tid); }
    unsigned char* ws; const float* ssq; PG8_LAS float* rs_lds;
    __device__ __forceinline__ void operator()(const f32x4 (&acc)[2][2][4][2], const Unit& u, int wr, int wc, int fr, int fq, bool first) const {
        const int row0 = u.pm * BM + wr * 64 + fr, col0 = u.pn * BM + wc * 32 + 8 * fq;
        float kmx[2] = {0.f, 0.f};
        float rsv[2][4];
        load_rsv(rsv, ssq, rs_lds, row0, wr, wc, fr, fq, first);
#pragma unroll
        for (int ai = 0; ai < 2; ++ai)
#pragma unroll
            for (int m = 0; m < 4; ++m) { const int row = row0 + ai * HALF + m * 16; const float rs = rsv[ai][m];
#pragma unroll
                for (int bj = 0; bj < 2; ++bj) { const f32x4 v0 = acc[ai][bj][m][0] * rs, v1 = acc[ai][bj][m][1] * rs;
                    proj_store8<LAYER>(ws, row, col0 + bj * HALF, v0, v1);
                    if (LAYER == 0) kmx[bj] = fmaxf(kmx[bj], ((v0[0] * v0[0] + v0[1] * v0[1]) + (v0[2] * v0[2] + v0[3] * v0[3])) + ((v1[0] * v1[0] + v1[1] * v1[1]) + (v1[2] * v1[2] + v1[3] * v1[3]))); } }
        if (LAYER == 0 && (u.pn == 2 || u.pn == 3)) {
#pragma unroll
            for (int bj = 0; bj < 2; ++bj) { float v = kmx[bj];
                v = red16_max(v);
                if (fr == 0) { const int c = col0 + bj * HALF - 512, head = c >> 6, chunk = (c & 63) >> 3, b = (u.pm * BM) / T;
                    atomicMax((unsigned*)(ws + WS_KMAX) + (b * NH + head) * 8 + chunk, __builtin_bit_cast(unsigned, sqrtf(v))); } }
        }
    }
};
__device__ __forceinline__ void unpack_bf16x8(u32x4 w, f32x4& lo, f32x4& hi) {
    lo = (f32x4){__builtin_bit_cast(float, w.x << 16), __builtin_bit_cast(float, w.x & 0xffff0000u), __builtin_bit_cast(float, w.y << 16), __builtin_bit_cast(float, w.y & 0xffff0000u)};
    hi = (f32x4){__builtin_bit_cast(float, w.z << 16), __builtin_bit_cast(float, w.z & 0xffff0000u), __builtin_bit_cast(float, w.w << 16), __builtin_bit_cast(float, w.w & 0xffff0000u)};
}
struct EpiRes {
    static constexpr bool PERM = true, AFTER_DRAIN = false, HAS_PRE = false;
    bf16_t* hb; float* ssq; PG8_LAS float* red;
    __device__ __forceinline__ void operator()(f32x4 (&acc)[2][2][4][2], const Unit& u, int wr, int wc, int fr, int fq, bool) const {
        const int row0 = u.pm * BM + wr * 64 + fr, col0 = u.pn * BM + wc * 32 + 8 * fq;
        u32x4 rv[2][4][2];
#pragma unroll
        for (int ai = 0; ai < 2; ++ai)
#pragma unroll
            for (int m = 0; m < 4; ++m)
#pragma unroll
                for (int bj = 0; bj < 2; ++bj) rv[ai][m][bj] = *(const u32x4*)(hb + (size_t)(row0 + ai * HALF + m * 16) * D + col0 + bj * HALF);
#pragma unroll
        for (int ai = 0; ai < 2; ++ai)
#pragma unroll
            for (int m = 0; m < 4; ++m) { const int row = row0 + ai * HALF + m * 16; float s = 0.f;
#pragma unroll
                for (int bj = 0; bj < 2; ++bj) { f32x4 lo, hi; unpack_bf16x8(rv[ai][m][bj], lo, hi);
                    const f32x4 v0 = lo + acc[ai][bj][m][0], v1 = hi + acc[ai][bj][m][1];
                    s += ((v0[0] * v0[0] + v0[1] * v0[1]) + (v0[2] * v0[2] + v0[3] * v0[3])) + ((v1[0] * v1[0] + v1[1] * v1[1]) + (v1[2] * v1[2] + v1[3] * v1[3]));
                    st16_wt(hb + (size_t)row * D + col0 + bj * HALF, pack8(v0, v1)); }
                s = swap32_sum(swap16_sum(s));
                if (fq == 0) red[(ai * HALF + wr * 64 + m * 16 + fr) * 4 + wc] = s; }
        asm volatile("s_waitcnt lgkmcnt(0)" ::: "memory"); __builtin_amdgcn_s_barrier(); asm volatile("" ::: "memory");
        { const int t = (wr * 4 + wc) * 64 + fq * 16 + fr;
          if (t < 256) { const f32x4 p = *(const PG8_LAS f32x4*)(red + t * 4); ssq[(size_t)(u.pm * BM + t) * 4 + u.pn] = (p[0] + p[1]) + (p[2] + p[3]); } }
        asm volatile("s_waitcnt lgkmcnt(0)" ::: "memory"); __builtin_amdgcn_s_barrier(); asm volatile("" ::: "memory");
    }
};
struct EpiFinal {
    static constexpr bool PERM = true, AFTER_DRAIN = false, HAS_PRE = false;
    const bf16_t* base; float* out; const float* wn; float* xbuf; unsigned* cnt; PG8_LAS float* red;
    __device__ __forceinline__ void operator()(f32x4 (&acc)[2][2][4][2], const Unit& u, int wr, int wc, int fr, int fq, bool) const {
        const int row0 = u.pm * BM + wr * 64 + fr, col0 = u.pn * BM + wc * 32 + 8 * fq;
        { u32x4 rv[2][4][2];
#pragma unroll
          for (int ai = 0; ai < 2; ++ai)
#pragma unroll
              for (int m = 0; m < 4; ++m)
#pragma unroll
                  for (int bj = 0; bj < 2; ++bj) rv[ai][m][bj] = *(const u32x4*)(base + (size_t)(row0 + ai * HALF + m * 16) * D + col0 + bj * HALF);
#pragma unroll
          for (int ai = 0; ai < 2; ++ai)
#pragma unroll
              for (int m = 0; m < 4; ++m)
#pragma unroll
                  for (int bj = 0; bj < 2; ++bj) { f32x4 lo, hi; unpack_bf16x8(rv[ai][m][bj], lo, hi); acc[ai][bj][m][0] += lo; acc[ai][bj][m][1] += hi; } }
#pragma unroll
        for (int ai = 0; ai < 2; ++ai)
#pragma unroll
            for (int m = 0; m < 4; ++m) { float s = 0.f;
#pragma unroll
                for (int bj = 0; bj < 2; ++bj)
#pragma unroll
                    for (int n = 0; n < 2; ++n) { const f32x4 v = acc[ai][bj][m][n]; s += (v[0] * v[0] + v[1] * v[1]) + (v[2] * v[2] + v[3] * v[3]); }
                s = swap32_sum(swap16_sum(s));
                if (fq == 0) red[(ai * HALF + wr * 64 + m * 16 + fr) * 4 + wc] = s; }
        asm volatile("s_waitcnt lgkmcnt(0)" ::: "memory"); __builtin_amdgcn_s_barrier(); asm volatile("" ::: "memory");
        const int wid = wr * 4 + wc, t = wid * 64 + fq * 16 + fr;
        if (t < 256) { const f32x4 p = *(const PG8_LAS f32x4*)(red + t * 4);
            __hip_atomic_store(xbuf + (size_t)(u.pm * BM + t) * 4 + u.pn, (p[0] + p[1]) + (p[2] + p[3]), __ATOMIC_RELAXED, __HIP_MEMORY_SCOPE_AGENT); }
        asm volatile("s_waitcnt vmcnt(0)" ::: "memory");
        if (wid < 4 && fq * 16 + fr == 0) __hip_atomic_fetch_add(cnt + 64 * u.pm, 1u, __ATOMIC_RELAXED, __HIP_MEMORY_SCOPE_AGENT);
        if (wid == 0) { unsigned sp = 0u;
            while ((unsigned)__builtin_amdgcn_readfirstlane(__hip_atomic_load(cnt + 64 * u.pm, __ATOMIC_RELAXED, __HIP_MEMORY_SCOPE_AGENT)) < 16u) { __builtin_amdgcn_s_sleep(2); if (++sp > (1u << 22)) break; }
            __builtin_amdgcn_fence(__ATOMIC_ACQUIRE, "agent"); }
        asm volatile("s_waitcnt vmcnt(0) lgkmcnt(0)" ::: "memory"); __builtin_amdgcn_s_barrier(); asm volatile("" ::: "memory");
        if (t < 256) { const float* sl = xbuf + (size_t)(u.pm * BM + t) * 4; float q = 0.f;
#pragma unroll
            for (int i = 0; i < 4; ++i) q += __hip_atomic_load(sl + i, __ATOMIC_RELAXED, __HIP_MEMORY_SCOPE_AGENT);
            red[1024 + t] = 1.0f / sqrtf(q * (1.0f / D) + EPS); }
        asm volatile("s_waitcnt vmcnt(0) lgkmcnt(0)" ::: "memory"); __builtin_amdgcn_s_barrier(); asm volatile("" ::: "memory");
        f32x4 wv[2][2];
#pragma unroll
        for (int bj = 0; bj < 2; ++bj)
#pragma unroll
            for (int n = 0; n < 2; ++n) wv[bj][n] = *(const f32x4*)(wn + col0 + bj * HALF + n * 4);
#pragma unroll
        for (int ai = 0; ai < 2; ++ai)
#pragma unroll
            for (int m = 0; m < 4; ++m) { const int rl = ai * HALF + wr * 64 + m * 16 + fr; const float rs = red[1024 + rl];
#pragma unroll
                for (int bj = 0; bj < 2; ++bj)
#pragma unroll
                    for (int n = 0; n < 2; ++n) *(f32x4*)(out + (size_t)(u.pm * BM + rl) * D + col0 + bj * HALF + n * 4) = acc[ai][bj][m][n] * rs * wv[bj][n]; }
        asm volatile("s_waitcnt lgkmcnt(0)" ::: "memory"); __builtin_amdgcn_s_barrier(); asm volatile("" ::: "memory");
    }
};
struct EpiUp {
    static constexpr bool PERM = true, AFTER_DRAIN = false, HAS_PRE = true;
    __device__ __forceinline__ f32x4 pre_issue(const Unit& u, int tid) const { return rs_pre_issue(ssq, u, tid); }
    __device__ __forceinline__ void pre_commit(f32x4 v, int tid) const { rs_pre_commit(rs_lds, v, tid); }
    bf16_t* U; const float* ssq; PG8_LAS float* rs_lds;
    __device__ __forceinline__ void operator()(const f32x4 (&acc)[2][2][4][2], const Unit& u, int wr, int wc, int fr, int fq, bool first) const {
        const int row0 = u.pm * BM + wr * 64 + fr, col0 = u.pn * BM + wc * 32 + 8 * fq;
        float rsv[2][4];
        load_rsv(rsv, ssq, rs_lds, row0, wr, wc, fr, fq, first);
#pragma unroll
        for (int ai = 0; ai < 2; ++ai)
#pragma unroll
            for (int m = 0; m < 4; ++m) { const int row = row0 + ai * HALF + m * 16; const float rs = rsv[ai][m];
#pragma unroll
                for (int bj = 0; bj < 2; ++bj) { f32x4 a = acc[ai][bj][m][0], b = acc[ai][bj][m][1];
#pragma unroll
                    for (int e = 0; e < 4; ++e) { const float x = fmaxf(a[e], 0.f) * rs, y = fmaxf(b[e], 0.f) * rs; a[e] = x * x; b[e] = y * y; }
                    st16_wt(U + (size_t)row * FF + col0 + bj * HALF, pack8(a, b)); } }
    }
};
template <class Epi, class Sched, bool ALIGN_EPI = false, bool SP2 = false>
__device__ __forceinline__ void gemm_phase(PG8_LAS unsigned char* lds, const Gemm g, const Sched& S, const Epi& E, int tid_in) {
    int tid_l = tid_in; asm volatile("" : "+v"(tid_l));
    const int tid = tid_l, wid = __builtin_amdgcn_readfirstlane(tid >> 6), lane = tid & 63, wr = wid >> 2, wc = wid & 3, fr = lane & 15, fq = lane >> 4;
    const int K = g.K, nt = K / BK;
    unsigned voffA[2], voffB[2];
#pragma unroll
    for (int i = 0; i < 2; ++i) { int R, C; stage_rc(tid * 16 + i * 8192, R, C); const int Rb = Epi::PERM ? ((R & ~31) + perm32(R & 31)) : R;
        voffA[i] = (unsigned)(R * K + C) * 2u; voffB[i] = (unsigned)(Rb * K + C) * 2u; }
    const size_t kstep = (size_t)(BK * 2);
    const size_t hstep = (size_t)HALF * K * 2;
    const size_t tstep = 2 * hstep;
    const unsigned ldsw = (unsigned)wid * 1024u;
    const int aoff = lds_byte(wr * 64 + fr, fq * 8), boff = lds_byte(wc * 32 + fr, fq * 8);
#define PG8_SA(b, h) (((b) * 2 + (h)) * HTB)
#define PG8_SB(b, h) ((4 + (b) * 2 + (h)) * HTB)
#define PG8_STAGE(bufoff, gbase, voff) do { _Pragma("unroll") for (int _i = 0; _i < 2; ++_i) \
        __builtin_amdgcn_global_load_lds((const unsigned*)((const char*)(gbase) + (voff)[_i]), (PG8_LAS unsigned*)(lds + (bufoff) + ldsw + _i * 8192), 16, 0, 0); } while (0)
#define PG8_LDA(dst, b, h) do { _Pragma("unroll") for (int m = 0; m < 4; ++m) _Pragma("unroll") for (int k = 0; k < 2; ++k) dst[m][k] = *(const PG8_LAS bf16x8*)(lds + PG8_SA(b, h) + aoff + m * 2048 + k * 1024); } while (0)
#define PG8_LDB(dst, b, h) do { _Pragma("unroll") for (int n = 0; n < 2; ++n) _Pragma("unroll") for (int k = 0; k < 2; ++k) dst[n][k] = *(const PG8_LAS bf16x8*)(lds + PG8_SB(b, h) + boff + n * 2048 + k * 1024); } while (0)
#define PG8_MMA(ai, bj, At, Bt) do { __builtin_amdgcn_s_setprio(1); _Pragma("unroll") for (int m = 0; m < 4; ++m) _Pragma("unroll") for (int n = 0; n < 2; ++n) _Pragma("unroll") for (int k = 0; k < 2; ++k) \
        acc[ai][bj][m][n] = __builtin_amdgcn_mfma_f32_16x16x32_bf16(Bt[n][k], At[m][k], acc[ai][bj][m][n], 0, 0, 0); __builtin_amdgcn_s_setprio(0); } while (0)
#define PG8_WAIT_V(n) asm volatile("s_waitcnt vmcnt(" #n ")" ::: "memory")
#define PG8_WAIT_L(n) asm volatile("s_waitcnt lgkmcnt(" #n ")" ::: "memory")
#define PG8_BAR __builtin_amdgcn_s_barrier()
#define PG8_SCHED __builtin_amdgcn_sched_barrier(0)
    Unit cur, nxt; int ui = 0;
    if (!S.next(0, cur)) return;
    int pm0 = cur.pm;
    f32x4 acc[2][2][4][2];
#pragma unroll
    for (int a = 0; a < 2; ++a)
#pragma unroll
        for (int b = 0; b < 2; ++b)
#pragma unroll
            for (int m = 0; m < 4; ++m)
#pragma unroll
                for (int n = 0; n < 2; ++n) acc[a][b][m][n] = (f32x4){0.f, 0.f, 0.f, 0.f};
    bf16x8 At[4][2], B0[2][2], B1[2][2];
    const char* cA = (const char*)g.A + (size_t)cur.pm * tstep; const char* cB = (const char*)g.Bt + (size_t)cur.pn * tstep;
    S.a_ready(cur);
    f32x4 pre_v = (f32x4){0.f, 0.f, 0.f, 0.f};
    if constexpr (Epi::HAS_PRE) pre_v = E.pre_issue(cur, tid);
    if constexpr (SP2) {
        PG8_STAGE(PG8_SB(0, 0), cB, voffB); PG8_STAGE(PG8_SB(0, 1), cB + hstep, voffB); PG8_STAGE(PG8_SA(0, 0), cA, voffA); PG8_STAGE(PG8_SA(0, 1), cA + hstep, voffA);
        if (wr == 1) PG8_BAR;
        PG8_WAIT_V(2); PG8_BAR;
        if constexpr (Epi::HAS_PRE) E.pre_commit(pre_v, tid);
        PG8_STAGE(PG8_SB(1, 0), cB + kstep, voffB); PG8_STAGE(PG8_SA(1, 0), cA + kstep, voffA); PG8_STAGE(PG8_SB(1, 1), cB + hstep + kstep, voffB);
        PG8_WAIT_V(6); PG8_BAR;
    } else {
        PG8_STAGE(PG8_SB(0, 0), cB, voffB); PG8_STAGE(PG8_SA(0, 0), cA, voffA); PG8_STAGE(PG8_SB(0, 1), cB + hstep, voffB); PG8_STAGE(PG8_SA(0, 1), cA + hstep, voffA);
        if (wr == 1) PG8_BAR;
        PG8_WAIT_V(4); PG8_BAR;
        PG8_STAGE(PG8_SB(1, 0), cB + kstep, voffB); PG8_STAGE(PG8_SA(1, 0), cA + kstep, voffA); PG8_STAGE(PG8_SB(1, 1), cB + hstep + kstep, voffB);
        PG8_WAIT_V(6); PG8_BAR;
    }
    for (;;) {
        const bool has_next = S.next(ui + 1, nxt);
        const char* nA = has_next ? (const char*)g.A + (size_t)nxt.pm * tstep : cA; const char* nB = has_next ? (const char*)g.Bt + (size_t)nxt.pn * tstep : cB;
        for (int t = 0; t < nt; t += 2) {
            const bool last = (t == nt - 2);
            const char* a1 = cA + (size_t)(t + 1) * kstep;
            const char* a2 = last ? nA : cA + (size_t)(t + 2) * kstep; const char* b2 = last ? nB : cB + (size_t)(t + 2) * kstep;
            const char* a3 = a2 + kstep; const char* b3 = b2 + kstep;
            if (last && has_next) S.a_ready(nxt);
            if constexpr (SP2) {
            PG8_LDB(B0, 0, 0); PG8_LDB(B1, 0, 1); PG8_SCHED; PG8_LDA(At, 0, 0); PG8_STAGE(PG8_SA(1, 1), a1 + hstep, voffA);
            PG8_WAIT_V(8); PG8_WAIT_L(0); PG8_BAR; PG8_MMA(0, 0, At, B0); PG8_MMA(0, 1, At, B1); PG8_BAR; PG8_SCHED;
            PG8_LDA(At, 0, 1); PG8_STAGE(PG8_SB(0, 0), b2, voffB); PG8_STAGE(PG8_SB(0, 1), b2 + hstep, voffB); PG8_STAGE(PG8_SA(0, 0), a2, voffA);
            PG8_WAIT_V(8); PG8_WAIT_L(0); PG8_BAR; PG8_MMA(1, 0, At, B0); PG8_MMA(1, 1, At, B1); PG8_BAR; PG8_SCHED;
            PG8_LDB(B0, 1, 0); PG8_LDB(B1, 1, 1); PG8_SCHED; PG8_LDA(At, 1, 0); PG8_STAGE(PG8_SA(0, 1), a2 + hstep, voffA);
            PG8_WAIT_V(8); PG8_WAIT_L(0); PG8_BAR; PG8_MMA(0, 0, At, B0); PG8_MMA(0, 1, At, B1); PG8_BAR; PG8_SCHED;
            PG8_LDA(At, 1, 1); PG8_STAGE(PG8_SB(1, 0), b3, voffB); PG8_STAGE(PG8_SB(1, 1), b3 + hstep, voffB); PG8_STAGE(PG8_SA(1, 0), a3, voffA);
            PG8_WAIT_V(8); PG8_WAIT_L(0); PG8_BAR; PG8_MMA(1, 0, At, B0); PG8_MMA(1, 1, At, B1); PG8_BAR; PG8_SCHED;
            } else {
            PG8_LDB(B0, 0, 0); PG8_SCHED; PG8_LDA(At, 0, 0); PG8_STAGE(PG8_SA(1, 1), a1 + hstep, voffA);
            PG8_WAIT_L(8); PG8_BAR; PG8_WAIT_L(0); PG8_MMA(0, 0, At, B0); PG8_BAR; PG8_SCHED;
            PG8_LDB(B1, 0, 1); PG8_STAGE(PG8_SB(0, 0), b2, voffB);
            PG8_BAR; PG8_WAIT_L(0); PG8_MMA(0, 1, At, B1); PG8_BAR;
            PG8_LDA(At, 0, 1); PG8_STAGE(PG8_SA(0, 0), a2, voffA);
            PG8_BAR; PG8_WAIT_L(0); PG8_MMA(1, 0, At, B0); PG8_BAR; PG8_SCHED;
            PG8_STAGE(PG8_SB(0, 1), b2 + hstep, voffB);
            PG8_WAIT_V(6); PG8_BAR; PG8_MMA(1, 1, At, B1); PG8_BAR;
            PG8_LDB(B0, 1, 0); PG8_SCHED; PG8_LDA(At, 1, 0); PG8_STAGE(PG8_SA(0, 1), a2 + hstep, voffA);
            PG8_WAIT_L(8); PG8_BAR; PG8_WAIT_L(0); PG8_MMA(0, 0, At, B0); PG8_BAR; PG8_SCHED;
            PG8_LDB(B1, 1, 1); PG8_STAGE(PG8_SB(1, 0), b3, voffB);
            PG8_BAR; PG8_WAIT_L(0); PG8_MMA(0, 1, At, B1); PG8_BAR;
            PG8_LDA(At, 1, 1); PG8_STAGE(PG8_SA(1, 0), a3, voffA);
            PG8_BAR; PG8_WAIT_L(0); PG8_MMA(1, 0, At, B0); PG8_BAR; PG8_SCHED;
            PG8_STAGE(PG8_SB(1, 1), b3 + hstep, voffB);
            PG8_WAIT_V(6); PG8_BAR; PG8_MMA(1, 1, At, B1); PG8_BAR;
            }
        }
        if constexpr (ALIGN_EPI) { if (wr == 0) PG8_BAR; }
        if constexpr (!Epi::AFTER_DRAIN) { E(acc, cur, wr, wc, fr, fq, (ui == 0 && !(Epi::HAS_PRE && SP2)) || cur.pm != pm0); pm0 = cur.pm; S.done(cur); }
        if (!has_next) break;
#pragma unroll
        for (int a = 0; a < 2; ++a)
#pragma unroll
            for (int b = 0; b < 2; ++b)
#pragma unroll
                for (int m = 0; m < 4; ++m)
#pragma unroll
                    for (int n = 0; n < 2; ++n) acc[a][b][m][n] = (f32x4){0.f, 0.f, 0.f, 0.f};
        cur = nxt; cA = nA; cB = nB; ++ui;
        if constexpr (ALIGN_EPI) { if (wr == 1) PG8_BAR; }
    }
    PG8_WAIT_V(0);
    if constexpr (!ALIGN_EPI) { if (wr == 0) PG8_BAR; }
    PG8_BAR;
    if constexpr (Epi::AFTER_DRAIN) { E.fused(acc, cur, wr, wc, fr, fq, lds, wid, lane); S.done(cur); }
#undef PG8_SA
#undef PG8_SB
#undef PG8_STAGE
#undef PG8_LDA
#undef PG8_LDB
#undef PG8_MMA
#undef PG8_WAIT_V
#undef PG8_WAIT_L
#undef PG8_BAR
#undef PG8_SCHED
}
}

__device__ __forceinline__ void store16_wt(void* p, v4u v) {
    __hip_atomic_store((unsigned long long*)p, ((unsigned long long)v.y << 32) | v.x, __ATOMIC_RELAXED, __HIP_MEMORY_SCOPE_AGENT);
    __hip_atomic_store((unsigned long long*)p + 1, ((unsigned long long)v.w << 32) | v.z, __ATOMIC_RELAXED, __HIP_MEMORY_SCOPE_AGENT);
}
__device__ __forceinline__ void st16_wtg(void* p, v4u v) { asm volatile("global_store_dwordx4 %0, %1, off sc1\n\ts_nop 1" :: "v"(p), "v"(v) : "memory"); }
#define NTL(p) __builtin_nontemporal_load(p)
namespace att {
typedef short bf16x8 __attribute__((ext_vector_type(8)));
typedef short s16x4 __attribute__((ext_vector_type(4)));
typedef float f32x16 __attribute__((ext_vector_type(16)));
constexpr int KCH = 1040, KBUF = 8 * KCH, VBUF = 8192;
constexpr int NSL = 5;
constexpr int OFF_K = 0, OFF_V = NSL * KBUF, OFF_G = OFF_V + NSL * VBUF, GSL = 4 * 68 * 4 + 16, OFF_FLAG = OFF_G + NSL * GSL, OFF_WS = OFF_FLAG + 96, OFF_OST = OFF_WS + 8 * 256 + 128;
static_assert(OFF_V % 16 == 0 && OFF_G % 16 == 0 && OFF_WS % 16 == 0 && OFF_OST % 16 == 0 && OFF_OST + 8 * 4096 <= 131072, "att LDS map");
__device__ __forceinline__ int crow(int r, int hi) { return (r & 3) + 8 * (r >> 2) + 4 * hi; }
__device__ __forceinline__ s16x4 vtr(const LAS unsigned char* p) { typedef short v4i16_t __attribute__((ext_vector_type(4))); return __builtin_bit_cast(s16x4, __builtin_amdgcn_ds_read_tr16_b64_v4i16((LAS v4i16_t*)p)); }
__device__ __forceinline__ unsigned cvtpk(float lo, float hi) { typedef float f2 __attribute__((ext_vector_type(2))); typedef __bf16 b2 __attribute__((ext_vector_type(2))); f2 v = {lo, hi}; b2 b = __builtin_convertvector(v, b2); return __builtin_bit_cast(unsigned, b); }
__device__ __forceinline__ float ex2(float x) { return __builtin_amdgcn_exp2f(x); }
__device__ __forceinline__ float lg2(float x) { return __builtin_amdgcn_logf(x); }

__device__ __forceinline__ void gtile(LAS unsigned char* L, float fl, float cp, float fprev, int slot, int lane, float Fq, const float (&cw)[4]) {
    LAS float* g = (LAS float*)(L + OFF_G + slot * GSL);
    const float gv = Fq - (fl + cp);
#pragma unroll
    for (int p = 0; p < 4; ++p) g[p * 68 + lane] = gv - cw[p];
    if (lane == 0) g[272] = Fq - fprev;
}

template <int MODE>
__device__ __forceinline__ void attn_unit(LAS unsigned char* L, unsigned char* ws, const float* fbias, const float* kmaxc, int b, int h, int qb, int tid) {
    asm volatile("" : "+v"(tid));
    const int lane = tid & 63, r32 = lane & 31, hi = lane >> 5, w = __builtin_amdgcn_readfirstlane(tid >> 6);
    const int bh = b * NH + h, q0 = qb * 256;
    const bf16* Qp = (const bf16*)(ws + WS_Q) + ((size_t)bh * T + q0 + w * 32 + r32) * HD;
    const bf16* Kp = (const bf16*)(ws + WS_K) + (size_t)bh * T * HD;
    const bf16* Vp = (const bf16*)(ws + WS_V) + (size_t)bh * T * HD;
    bf16x8 qr[4];
#pragma unroll
    for (int d0 = 0; d0 < 4; ++d0) qr[d0] = *(const bf16x8*)(Qp + d0 * 16 + hi * 8);
    const int lkv = tid >> 3, lch = tid & 7;
    const unsigned kdst = OFF_K + lch * KCH + lkv * 16;
    const unsigned vdst = OFF_V + ((lch >> 2) * 4 + (lkv >> 4)) * 1024 + (lkv & 15) * 64 + (lch & 3) * 16;
    const bf16* kg = Kp + (size_t)lkv * HD + lch * 8; const bf16* vg = Vp + (size_t)lkv * HD + lch * 8;
    int j = 4 * qb;
    { v4u kb_[3], vb_[3];
#pragma unroll
      for (int i = 0; i < 3; ++i) { kb_[i] = *(const v4u*)(kg + (size_t)(j + 3 - i) * 4096); vb_[i] = *(const v4u*)(vg + (size_t)(j + 3 - i) * 4096); }
#pragma unroll
      for (int i = 0; i < 3; ++i) { *(LAS v4u*)(L + i * KBUF + kdst) = kb_[i]; *(LAS v4u*)(L + i * VBUF + vdst) = vb_[i]; } }
    v4u kreg = *(const v4u*)(kg + (size_t)j * 4096), vreg = *(const v4u*)(vg + (size_t)j * 4096), kreg2 = kreg, vreg2 = vreg;
    if (j > 0) { kreg2 = *(const v4u*)(kg + (size_t)(j - 1) * 4096); vreg2 = *(const v4u*)(vg + (size_t)(j - 1) * 4096); }
    const unsigned kfb = OFF_K + hi * KCH + r32 * 16;
    const unsigned vfb = OFF_V + ((lane >> 4) & 1) * 32 + (lane & 3) * 8 + (4 * hi + ((lane & 15) >> 2)) * 64;
    LAS float* wsf = (LAS float*)(L + OFF_WS) + w * 64;
    LAS unsigned* flags = (LAS unsigned*)(L + OFF_FLAG);
    float sbound = 0.f;
    if (MODE == 0) {
#pragma unroll
        for (int d0 = 0; d0 < 4; ++d0) { float s = 0.f;
#pragma unroll
            for (int e = 0; e < 8; ++e) { const float v = bf2f((unsigned short)qr[d0][e]); s += v * v; }
            sbound += sqrtf(s) * kmaxc[bh * 8 + 2 * d0 + hi]; }
        sbound = swap32_sum(sbound) * 1.02f;
    }
    const float sshift = fmaxf(sbound - 60.f, 0.f);
    const float sbound37 = sbound + 37.f;
    const float* flp = (const float*)(ws + WS_FLOC) + (size_t)bh * T;
    float cpre = 0.f, Fq = 0.f, fx1 = 0.f, fx2 = 0.f; float cwv[4] = {0.f, 0.f, 0.f, 0.f};
    if (MODE == 0 && w == 0) {
        const float t = ((const float*)(ws + WS_FTOT))[bh * 64 + lane]; float v = t; int ln = lane; asm volatile("" : "+v"(ln));
#pragma unroll
        for (int o = 1; o < 64; o <<= 1) { const float u = bperm(ln - o, v); if (ln >= o) v += u; }
        cpre = v - t;
        const int ql = q0 + 255;
        Fq = flp[ql] + __builtin_bit_cast(float, __builtin_amdgcn_readlane(__builtin_bit_cast(int, cpre), ql >> 7));
        { const float fe = flp[q0 + 64 * (lane & 3) + 63];
#pragma unroll
          for (int p = 0; p < 4; ++p) cwv[p] = Fq - (__builtin_bit_cast(float, __builtin_amdgcn_readlane(__builtin_bit_cast(int, fe), p)) + __builtin_bit_cast(float, __builtin_amdgcn_readlane(__builtin_bit_cast(int, cpre), (q0 + 64 * p) >> 7))); }
        float ft[5];
#pragma unroll
        for (int i = 0; i < 5; ++i) { const int t = j + 3 - i; ft[i] = t >= 0 ? flp[t * 64 + lane] : 0.f; }
#pragma unroll
        for (int i = 0; i < 4; ++i) { const int t = j + 3 - i;
            const float cp = __builtin_bit_cast(float, __builtin_amdgcn_readlane(__builtin_bit_cast(int, cpre), t >> 1));
            const float fpv = t > 0 ? __builtin_bit_cast(float, __builtin_amdgcn_readlane(__builtin_bit_cast(int, ft[i + 1]), 63)) + __builtin_bit_cast(float, __builtin_amdgcn_readlane(__builtin_bit_cast(int, cpre), (t - 1) >> 1)) : 0.f;
            gtile(L, ft[i], cp, fpv, i, lane, Fq, cwv); }
        fx1 = ft[4]; if (j > 1) fx2 = flp[(j - 2) * 64 + lane];
        if (lane == 0) { LAS float* fref = (LAS float*)(L + OFF_FLAG + 64); fref[0] = cwv[0]; fref[1] = cwv[1]; fref[2] = cwv[2]; fref[3] = cwv[3]; }
    }
    float cq = 0.f;
    if (lane == 0) { flags[w] = 0u; flags[8 + w] = 0u; }
    float m = -1e30f, l = 0.f, R = 0.f;
    f32x16 o0 = {}, o1 = {};
    bool wdone = false, it_first = true;
    int sw = 3, it = 0;
    const int pw_ = w >> 1, qloc = 32 * (w & 1) + r32;
    bool stop = false;
    const bool late = (w >= 4); bool pend = false;
    unsigned pws[16]; s16x4 vas[4][2], vcs[4][2];
#define ATT_PV(PW, VA, VC) { _Pragma("unroll") for (int s_ = 0; s_ < 4; ++s_) { \
        const v4u pa_ = {PW[4 * s_], PW[4 * s_ + 1], PW[4 * s_ + 2], PW[4 * s_ + 3]}; const bf16x8 pa = __builtin_bit_cast(bf16x8, pa_); \
        const bf16x8 v0_ = {VA[s_][0][0], VA[s_][0][1], VA[s_][0][2], VA[s_][0][3], VA[s_][1][0], VA[s_][1][1], VA[s_][1][2], VA[s_][1][3]}, v1_ = {VC[s_][0][0], VC[s_][0][1], VC[s_][0][2], VC[s_][0][3], VC[s_][1][0], VC[s_][1][1], VC[s_][1][2], VC[s_][1][3]}; \
        o0 = __builtin_amdgcn_mfma_f32_32x32x16_bf16(pa, v0_, o0, 0, 0, 0); o1 = __builtin_amdgcn_mfma_f32_32x32x16_bf16(pa, v1_, o1, 0, 0, 0); } }
#if DIAG && defined(DIAG_ATT)
    long long t0_ = 0, t1_ = 0, t2_ = 0, tm_ = 0;
#define DSTAMP(x) x = clock64()
#define DACC() do { if (MODE == DIAG_MODE && blockIdx.x == 0 && w == DIAG_WAVE && lane == 0) { atomicAdd((unsigned long long*)(ws + WS_TS) + 60, (unsigned long long)(t1_ - t0_)); atomicAdd((unsigned long long*)(ws + WS_TS) + 61, (unsigned long long)(t2_ - t1_)); atomicAdd((unsigned long long*)(ws + WS_TS) + 62, 1ull); atomicAdd((unsigned long long*)(ws + WS_TS) + 63, (unsigned long long)(tm_ - t0_)); } } while (0)
#else
#define DSTAMP(x) do {} while (0)
#define DACC() do {} while (0)
#endif
#define ATT_STEP(KR, VR) { \
        DSTAMP(t0_); if (j >= 0) { *(LAS v4u*)(L + sw * KBUF + kdst) = KR; *(LAS v4u*)(L + sw * VBUF + vdst) = VR; } asm volatile("s_waitcnt lgkmcnt(0)" ::: "memory"); DSTAMP(tm_); \
        asm volatile("s_waitcnt lgkmcnt(0)" ::: "memory"); __builtin_amdgcn_s_barrier(); asm volatile("" ::: "memory"); DSTAMP(t1_);     \
        if (it > 0) { const LAS unsigned* f = flags + ((it - 1) & 1) * 8; unsigned a = f[0] & f[1] & f[2] & f[3] & f[4] & f[5] & f[6] & f[7]; if (a) { stop = true; } } \
        if (!stop) { \
        if (j > 1) { KR = *(const v4u*)(kg + (size_t)(j - 2) * 4096); VR = *(const v4u*)(vg + (size_t)(j - 2) * 4096); }       \
        if (MODE == 0 && w == 0 && j > 0) { const float fxc = fx1; fx1 = fx2; if (j > 2) fx2 = flp[(j - 3) * 64 + lane]; const float cpc = __builtin_bit_cast(float, __builtin_amdgcn_readlane(__builtin_bit_cast(int, cpre), (j - 1) >> 1)); const float cpn = __builtin_bit_cast(float, __builtin_amdgcn_readlane(__builtin_bit_cast(int, cpre), (j > 1 ? j - 2 : 0) >> 1)); const float fpv = j > 1 ? __builtin_bit_cast(float, __builtin_amdgcn_readlane(__builtin_bit_cast(int, fx1), 63)) + cpn : 0.f; gtile(L, fxc, cpc, fpv, (sw == NSL - 1 ? 0 : sw + 1), lane, Fq, cwv); } \
        const int tw = j + pw_; int sr = sw - pw_; if (sr < 0) sr += NSL;       \
        if (tw < 0) wdone = true; \
        if (pend) { ATT_PV(pws, vas, vcs) pend = false; } \
        if (!wdone) { \
            const LAS unsigned char* Kb = L + sr * KBUF + kfb; const LAS unsigned char* Vb = L + sr * VBUF + vfb; \
            f32x16 p0, p1; \
            bf16x8 kf[8]; \
        _Pragma("unroll") \
            for (int d0 = 0; d0 < 4; ++d0) { kf[2 * d0] = *(const LAS bf16x8*)(Kb + d0 * 2 * KCH); kf[2 * d0 + 1] = *(const LAS bf16x8*)(Kb + d0 * 2 * KCH + 512); } \
            if (MODE == 0) { const LAS float* g = (const LAS float*)(L + OFF_G + sr * GSL) + pw_ * 68; \
        _Pragma("unroll") \
                for (int gq = 0; gq < 4; ++gq) { const f32x4 a = *(const LAS f32x4*)(g + 8 * gq + 4 * hi), c = *(const LAS f32x4*)(g + 32 + 8 * gq + 4 * hi); \
        _Pragma("unroll") \
                    for (int e = 0; e < 4; ++e) { p0[4 * gq + e] = a[e]; p1[4 * gq + e] = c[e]; } } \
            } else { p0 = f32x16{}; p1 = f32x16{}; } \
            __builtin_amdgcn_sched_barrier(0); \
        _Pragma("unroll") \
            for (int d0 = 0; d0 < 4; ++d0) { \
                p0 = __builtin_amdgcn_mfma_f32_32x32x16_bf16(kf[2 * d0], qr[d0], p0, 0, 0, 0); \
                p1 = __builtin_amdgcn_mfma_f32_32x32x16_bf16(kf[2 * d0 + 1], qr[d0], p1, 0, 0, 0); \
            } \
             \
        _Pragma("unroll") \
            for (int s = 0; s < 4; ++s) { vas[s][0] = vtr(Vb + s * 1024); vas[s][1] = vtr(Vb + s * 1024 + 512); vcs[s][0] = vtr(Vb + 4096 + s * 1024); vcs[s][1] = vtr(Vb + 4096 + s * 1024 + 512); } \
            __builtin_amdgcn_sched_barrier(0); \
            const bool diag = (it == 0); \
            if (MODE == 0) { \
                if (diag) { const int kb = 4 * hi; asm volatile("" ::: "memory"); \
        _Pragma("unroll") \
                    for (int r = 0; r < 16; ++r) { const int kv = kb + (r & 3) + 8 * (r >> 2); if (kv > qloc) p0[r] = -INFINITY; if (kv + 32 > qloc) p1[r] = -INFINITY; } } \
                if (it_first) { cq = ((const LAS float*)(L + OFF_FLAG + 64))[pw_]; it_first = false; } \
                if (__any(sshift > 0.f)) { _Pragma("unroll") for (int r = 0; r < 16; ++r) { p0[r] -= sshift; p1[r] -= sshift; } }        \
                float ls = 0.f; \
        _Pragma("unroll") \
                for (int r = 0; r < 16; ++r) { p0[r] = ex2(p0[r]); p1[r] = ex2(p1[r]); ls += p0[r] + p1[r]; } \
                l += ls; \
                const float gnext = ((const LAS float*)(L + OFF_G + sr * GSL))[272]; \
                wdone = __all(gnext <= cq + sshift - sbound37 + lg2(swap32_sum(l))); \
            } else { \
                const int kb = 4 * hi; \
                float sp0[16], sp1[16]; \
        _Pragma("unroll") \
                for (int r = 0; r < 16; ++r) { \
                    const float x0 = p0[r], x1 = p1[r]; \
                    sp0[r] = fmaxf(x0, 0.f) + lg2(1.f + ex2(-fabsf(x0))); sp1[r] = fmaxf(x1, 0.f) + lg2(1.f + ex2(-fabsf(x1))); \
                } \
                if (diag) { \
        _Pragma("unroll") \
                    for (int r = 0; r < 16; ++r) { const int kv = kb + (r & 3) + 8 * (r >> 2); if (kv >= qloc) { sp0[r] = 0.f; p0[r] = -INFINITY; } if (kv + 32 >= qloc) { sp1[r] = 0.f; p1[r] = -INFINITY; } } } \
                float To[8], Tp[8], PT[8]; \
        _Pragma("unroll") \
                for (int i = 0; i < 4; ++i) { To[i] = -((sp0[4 * i] + sp0[4 * i + 1]) + (sp0[4 * i + 2] + sp0[4 * i + 3])); To[4 + i] = -((sp1[4 * i] + sp1[4 * i + 1]) + (sp1[4 * i + 2] + sp1[4 * i + 3])); } \
        _Pragma("unroll") \
                for (int i = 0; i < 8; ++i) { Tp[i] = swap32_other(To[i], hi); PT[i] = To[i] + Tp[i]; } \
                float above[8]; float run = 0.f; \
        _Pragma("unroll") \
                for (int i = 7; i >= 0; --i) { above[i] = R + run + (hi == 0 ? Tp[i] : 0.f); run += PT[i]; } \
        _Pragma("unroll") \
                for (int i = 0; i < 4; ++i) { \
                    float s = above[i]; \
        _Pragma("unroll") \
                    for (int e = 3; e >= 0; --e) { const int r = 4 * i + e; p0[r] = ex2(p0[r] - sp0[r] + s); s -= sp0[r]; } \
                    s = above[4 + i]; \
        _Pragma("unroll") \
                    for (int e = 3; e >= 0; --e) { const int r = 4 * i + e; p1[r] = ex2(p1[r] - sp1[r] + s); s -= sp1[r]; } \
                } \
                R += run; \
                wdone = __all(R <= -40.f); \
            } \
        _Pragma("unroll") \
            for (int i = 0; i < 8; ++i) { pws[i] = cvtpk(p0[2 * i], p0[2 * i + 1]); pws[8 + i] = cvtpk(p1[2 * i], p1[2 * i + 1]); } \
            __builtin_amdgcn_sched_barrier(0); \
            if (late) { pend = true; } else ATT_PV(pws, vas, vcs) \
        } \
        if (lane == 0) flags[(it & 1) * 8 + w] = wdone ? 1u : 0u; \
        sw = (sw == NSL - 1) ? 0 : sw + 1; \
        --j; ++it; if (j + 3 < 0) stop = true; } \
        DSTAMP(t2_); DACC(); \
    }
    while (!stop) { ATT_STEP(kreg, vreg); if (stop) break; ATT_STEP(kreg2, vreg2); }
#undef ATT_STEP
    if (pend) { ATT_PV(pws, vas, vcs) pend = false; }
#undef ATT_PV
#if DIAG && defined(DIAG_ATT)
    if (MODE == 0 && blockIdx.x == 0 && tid == 0) atomicAdd((unsigned*)(ws + WS_TS) + 100, (unsigned)it);
#endif
    if (MODE == 0) {
        l = swap32_sum(l);
        if (hi == 0) wsf[r32] = 1.0f / l;
#pragma unroll
        for (int gq = 0; gq < 4; ++gq) { const f32x4 a = *(const LAS f32x4*)(wsf + 8 * gq + 4 * hi);
#pragma unroll
            for (int e = 0; e < 4; ++e) { o0[4 * gq + e] *= a[e]; o1[4 * gq + e] *= a[e]; } }
    }
    LAS bf16* stg = (LAS bf16*)(L + OFF_OST) + w * 2048;
#pragma unroll
    for (int r = 0; r < 16; ++r) { const int orow = crow(r, hi); stg[orow * 64 + r32] = (bf16)f2bf(o0[r]); stg[orow * 64 + 32 + r32] = (bf16)f2bf(o1[r]); }
    bf16* Ow = (bf16*)(ws + WS_CAT) + (size_t)(b * T + q0 + w * 32) * D + h * HD;
#pragma unroll
    for (int i = 0; i < 4; ++i) { const int row = i * 8 + (lane >> 3), ch = lane & 7; const v4u v = *(const LAS v4u*)(stg + row * 64 + ch * 8); st16_wtg(Ow + (size_t)row * D + ch * 8, v); }
    __syncthreads();
}
}

#if DIAG && defined(DIAG_STG)
#define STG_INIT() long long stg_t_ = clock64()
#define STG(k) do { const long long n_ = clock64(); if (blockIdx.x == 0 && (tid & 63) == 0 && (tid >> 6) == 0) atomicAdd((unsigned long long*)(ws + WS_TS) + 64 + (k), (unsigned long long)(n_ - stg_t_)); stg_t_ = n_; } while (0)
#else
#define STG_INIT() do {} while (0)
#define STG(k) do {} while (0)
#endif
namespace ssd {
using att::bf16x8; using att::s16x4; using att::f32x16; using att::vtr; using att::crow; using att::ex2; using att::cvtpk;
constexpr int TAB_DT = 0, TAB_A = 2048, TAB_X = 4096;
constexpr int A_XD = 8192, A_B = A_XD + 65536;
constexpr int BKCH = 2064, C_BK = 8192, C_XDT = 24832, C_ST = C_XDT + 65536;
static_assert(C_BK + 8 * BKCH <= C_XDT && C_ST + 8 * 4096 <= 131072 && A_B + 16384 <= 131072, "ssd LDS map");
__device__ __forceinline__ int vimg_off(int s, int col) { return (((col >> 5) << 2) + (s >> 4)) * 1024 + (s & 15) * 64 + (col & 31) * 2; }
__device__ __forceinline__ bf16x8 trpair(const LAS unsigned char* p) { const s16x4 a = vtr(p), c = vtr(p + 512); return (bf16x8){a[0], a[1], a[2], a[3], c[0], c[1], c[2], c[3]}; }
__device__ __forceinline__ void unpack8(v4u w, float (&f)[8]) {
#pragma unroll
    for (int e = 0; e < 4; ++e) { f[2 * e] = __builtin_bit_cast(float, w[e] << 16); f[2 * e + 1] = __builtin_bit_cast(float, w[e] & 0xffff0000u); } }
__device__ __forceinline__ v4u pack8f(const float (&f)[8]) { v4u w; w.x = cvtpk(f[0], f[1]); w.y = cvtpk(f[2], f[3]); w.z = cvtpk(f[4], f[5]); w.w = cvtpk(f[6], f[7]); return w; }

__device__ __forceinline__ void fl_unit(LAS unsigned char* L, unsigned char* ws, const float* fbias, int b, int g, int c, int tid) {
    asm volatile("" : "+v"(tid));
    const int lane = tid & 63, w = __builtin_amdgcn_readfirstlane(tid >> 6); LAS float* wtot = (LAS float*)(L + TAB_X);
    const int hh = tid >> 7, s = tid & 127, hd = 4 * g + hh, row0 = b * T + c * 128;
    const float fx = ((const float*)(ws + WS_FD))[(size_t)(row0 + s) * 16 + hd] + fbias[hd];
    float f = fminf(fx, 0.f) * LOG2E - att::lg2(1.f + ex2(-fabsf(fx) * LOG2E));
#pragma unroll
    for (int o = 1; o < 64; o <<= 1) { const float t2 = bperm(lane - o, f); if (lane >= o) f += t2; }
    if (lane == 63) wtot[w] = f;
    __syncthreads();
    if (w & 1) f += wtot[w - 1];
    __hip_atomic_store((float*)(ws + WS_FLOC) + (size_t)(b * 8 + hd) * T + c * 128 + s, f, __ATOMIC_RELAXED, __HIP_MEMORY_SCOPE_AGENT);
    if (s == 127) __hip_atomic_store((float*)(ws + WS_FTOT) + (b * 8 + hd) * 64 + c, f, __ATOMIC_RELAXED, __HIP_MEMORY_SCOPE_AGENT);
    __syncthreads();
}
__device__ __forceinline__ void pass_a_unit(LAS unsigned char* L, unsigned char* ws, const float* convw, const float* convb, const float* dtb, const float* alog, int b, int g, int c, int tid) {
    asm volatile("" : "+v"(tid));
    int lane = tid & 63; const int w = __builtin_amdgcn_readfirstlane(tid >> 6), r32 = lane & 31, hi = lane >> 5;
    const int row0 = b * T + c * 128;
    LAS float* dtab = (LAS float*)(L + TAB_DT); LAS float* atab = (LAS float*)(L + TAB_A); LAS float* wtot = (LAS float*)(L + TAB_X);
    float* DTA = (float*)(ws + WS_DTA); const float* FD = (const float*)(ws + WS_FD);
    {
        const int hh = tid >> 7, s = tid & 127, hd = 4 * g + hh;
        const float dt = softplus_f(FD[(size_t)(row0 + s) * 16 + 8 + hd] + dtb[hd]);
        float v = dt * (-__expf(alog[hd])) * LOG2E;
        int ln = lane; asm volatile("" : "+v"(ln));
#pragma unroll
        for (int o = 1; o < 64; o <<= 1) { const float t = bperm(ln - o, v); if (ln >= o) v += t; }
        if (ln == 63) wtot[w] = v;
        __syncthreads();
        if (w & 1) v += wtot[w - 1];
        dtab[hh * 128 + s] = dt; atab[hh * 128 + s] = v;
        DTA[(size_t)(row0 + s) * 16 + hd] = dt; DTA[(size_t)(row0 + s) * 16 + 8 + hd] = v;
        if (s == 127) __hip_atomic_store((float*)(ws + WS_CHD) + (b * 8 + hd) * 64 + c, v, __ATOMIC_RELAXED, __HIP_MEMORY_SCOPE_AGENT);
        __syncthreads();
    }
    if (lane < 48) {
        const int col = lane < 32 ? 256 * g + 8 * lane : (lane < 40 ? 512 + 64 * g + 8 * (lane - 32) : 640 + 64 * g + 8 * (lane - 40));
        float wk[4][8], bs[8];
#pragma unroll
        for (int e = 0; e < 8; ++e) { bs[e] = convb[col + e];
#pragma unroll
            for (int k = 0; k < 4; ++k) wk[k][e] = convw[k * 768 + col + e]; }
        const bf16* xb = (const bf16*)(ws + WS_XBC) + col; bf16* xc = (bf16*)(ws + WS_XC) + col;
        const int s0 = 16 * w, t0 = c * 128 + s0;
        v4u rw[19]; const v4u zz = {0u, 0u, 0u, 0u};
#pragma unroll
        for (int i = 0; i < 19; ++i) rw[i] = (t0 + i >= 3) ? NTL((const v4u*)(xb + (size_t)(row0 + s0 + i - 3) * 768)) : zz;
        const int hh = lane >> 3;
        const float alast = lane < 32 ? atab[hh * 128 + 127] : 0.f;
#pragma unroll
        for (int i = 0; i < 16; ++i) { const int s = s0 + i;
            float r0[8], r1[8], r2[8], cu[8], o[8];
            unpack8(rw[i], r0); unpack8(rw[i + 1], r1); unpack8(rw[i + 2], r2); unpack8(rw[i + 3], cu);
#pragma unroll
            for (int e = 0; e < 8; ++e) { const float v = bs[e] + wk[0][e] * r0[e] + wk[1][e] * r1[e] + wk[2][e] * r2[e] + wk[3][e] * cu[e]; o[e] = silu_f(v); }
            st16_wtg(xc + (size_t)(row0 + s) * 768, pack8f(o));
            if (lane < 32) { const float sc = dtab[hh * 128 + s] * ex2(alast - atab[hh * 128 + s]);
#pragma unroll
                for (int e = 0; e < 8; ++e) o[e] *= sc;
                *(LAS v4u*)(L + A_XD + ((s >> 6) * 4 + hh) * 8192 + vimg_off(s & 63, (8 * lane) & 63)) = pack8f(o);
            } else if (lane < 40) { *(LAS v4u*)(L + A_B + (s >> 6) * 8192 + vimg_off(s & 63, 8 * (lane - 32))) = pack8f(o); }
        }
    }
    __syncthreads();
    {
        const int hh = w >> 1, ph = w & 1;
        const unsigned vfb = ((lane >> 4) & 1) * 32 + (lane & 3) * 8 + (4 * hi + ((lane & 15) >> 2)) * 64;
        f32x16 acc0 = {}, acc1 = {};
#pragma unroll
        for (int ks = 0; ks < 8; ++ks) { const int sh = ks >> 2, k16 = ks & 3;
            const bf16x8 A = trpair(L + A_XD + (sh * 4 + hh) * 8192 + vfb + ph * 4096 + k16 * 1024);
            const bf16x8 B0 = trpair(L + A_B + sh * 8192 + vfb + k16 * 1024), B1 = trpair(L + A_B + sh * 8192 + vfb + 4096 + k16 * 1024);
            acc0 = __builtin_amdgcn_mfma_f32_32x32x16_bf16(A, B0, acc0, 0, 0, 0); acc1 = __builtin_amdgcn_mfma_f32_32x32x16_bf16(A, B1, acc1, 0, 0, 0); }
        float* loc = (float*)(ws + WS_SLOC) + ((size_t)((b * 8 + 4 * g + hh) * 64 + c)) * 4096;
#pragma unroll
        for (int r = 0; r < 16; ++r) { const int p = 32 * ph + crow(r, hi); __hip_atomic_store(loc + p * 64 + r32, acc0[r], __ATOMIC_RELAXED, __HIP_MEMORY_SCOPE_AGENT); __hip_atomic_store(loc + p * 64 + 32 + r32, acc1[r], __ATOMIC_RELAXED, __HIP_MEMORY_SCOPE_AGENT); }
    }
    __syncthreads();
}
__device__ __forceinline__ void pass_b(unsigned char* ws, int bx, int G, int tid) {
    asm volatile("" : "+v"(tid));
    if (tid >= 128) return;
    typedef float f32x2v __attribute__((ext_vector_type(2)));
    const float* loc = (const float*)(ws + WS_SLOC); const float* chd = (const float*)(ws + WS_CHD); bf16* prev = (bf16*)(ws + WS_SPREV);
    { const int e = bx * 256 + 2 * tid; const int bh = e >> 12, pn = e & 4095; f32x2v S = {0.f, 0.f};
        for (int c0 = 0; c0 < 64; c0 += 32) { f32x2v lv[32]; float dd[32];
#pragma unroll
            for (int i = 0; i < 32; ++i) { const int u = bh * 64 + c0 + i; lv[i] = NTL((const f32x2v*)(loc + (size_t)u * 4096 + pn)); dd[i] = chd[u]; }
#pragma unroll
            for (int i = 0; i < 32; ++i) { const int u = bh * 64 + c0 + i; __hip_atomic_store((unsigned*)(prev + (size_t)u * 4096 + pn), cvtpk(S[0], S[1]), __ATOMIC_RELAXED, __HIP_MEMORY_SCOPE_AGENT); S = S * ex2(dd[i]) + lv[i]; } } }
}
__device__ __forceinline__ void pass_c_unit(LAS unsigned char* L, unsigned char* ws, const float* dskip, const float* normw, int b, int g, int c, int tid) {
    asm volatile("" : "+v"(tid));
    const int w = __builtin_amdgcn_readfirstlane(tid >> 6);
    const int row0 = b * T + c * 128;
    STG_INIT();
    LAS float* dtab = (LAS float*)(L + TAB_DT); LAS float* atab = (LAS float*)(L + TAB_A); LAS float* part = (LAS float*)(L + TAB_X);
    const float* DTA = (const float*)(ws + WS_DTA); const bf16* XC = (const bf16*)(ws + WS_XC);
    { const int hh = tid >> 7, s = tid & 127; dtab[hh * 128 + s] = DTA[(size_t)(row0 + s) * 16 + 4 * g + hh]; atab[hh * 128 + s] = DTA[(size_t)(row0 + s) * 16 + 8 + 4 * g + hh]; }
    {
        const int s = tid >> 3, ch = tid & 7;
#pragma unroll
        for (int i = 0; i < 2; ++i) { const int ss = s + 64 * i; *(LAS v4u*)(L + C_BK + ch * BKCH + ss * 16) = NTL((const v4u*)(XC + (size_t)(row0 + ss) * 768 + 512 + 64 * g + 8 * ch)); }
    }
    __syncthreads(); STG(0);
    asm volatile("" : "+v"(tid));
    {
#pragma unroll
        for (int i = 0; i < 8; ++i) { const int idx = tid + 512 * i, s = idx >> 5, oc = idx & 31, hh = oc >> 3; float f[8];
            unpack8(NTL((const v4u*)(XC + (size_t)(row0 + s) * 768 + 256 * g + 8 * oc)), f); const float dt = dtab[hh * 128 + s];
#pragma unroll
            for (int e = 0; e < 8; ++e) f[e] *= dt;
            *(LAS v4u*)(L + C_XDT + ((s >> 6) * 4 + hh) * 8192 + vimg_off(s & 63, (8 * oc) & 63)) = pack8f(f); }
    }
    __syncthreads(); STG(1);
    asm volatile("" : "+v"(tid));
    const int lane = tid & 63, r32 = lane & 31, hi = lane >> 5;
    const int hh = w >> 1, pair = w & 1, hd = 4 * g + hh;
    const unsigned vfb = ((lane >> 4) & 1) * 32 + (lane & 3) * 8 + (4 * hi + ((lane & 15) >> 2)) * 64;
    const bf16* prevp = (const bf16*)(ws + WS_SPREV) + ((size_t)((b * 8 + hd) * 64 + c)) * 4096;
    const float Dk = dskip[hd];
    float yv[2][2][16];
#pragma unroll
    for (int i = 0; i < 2; ++i) { const int lb = i == 0 ? pair : 3 - pair;
        v4u zreg[4];
#pragma unroll
        for (int i4 = 0; i4 < 4; ++i4) { const int idx = lane + 64 * i4; zreg[i4] = NTL((const v4u*)((const bf16*)(ws + WS_Z) + (size_t)(row0 + 32 * lb + (idx >> 3)) * 512 + 256 * g + 64 * hh + 8 * (idx & 7))); }
        bf16x8 cf[4];
#pragma unroll
        for (int st = 0; st < 4; ++st) cf[st] = *(const bf16x8*)(XC + (size_t)(row0 + 32 * lb + r32) * 768 + 640 + 64 * g + 16 * st + 8 * hi);
        const float al = atab[hh * 128 + 32 * lb + r32];
        f32x16 Y0 = {}, Y1 = {};
        for (int sb = 0; sb <= lb; ++sb) {
            f32x16 X = {};
#pragma unroll
            for (int st = 0; st < 4; ++st) { const bf16x8 kf = *(const LAS bf16x8*)(L + C_BK + (2 * st + hi) * BKCH + (32 * sb + r32) * 16); X = __builtin_amdgcn_mfma_f32_32x32x16_bf16(kf, cf[st], X, 0, 0, 0); }
            unsigned pw[8];
#pragma unroll
            for (int gq = 0; gq < 4; ++gq) { const f32x4 as = *(const LAS f32x4*)(atab + hh * 128 + 32 * sb + 8 * gq + 4 * hi);
#pragma unroll
                for (int e = 0; e < 4; ++e) { const int r = 4 * gq + e; float p = X[r] * ex2(al - as[e]); if (sb == lb && crow(r, hi) > r32) p = 0.f; X[r] = p; } }
#pragma unroll
            for (int q = 0; q < 8; ++q) pw[q] = cvtpk(X[2 * q], X[2 * q + 1]);
            const LAS unsigned char* img = L + C_XDT + ((sb >> 1) * 4 + hh) * 8192 + vfb + (2 * (sb & 1)) * 1024;
#pragma unroll
            for (int k = 0; k < 2; ++k) { const v4u pa_ = {pw[4 * k], pw[4 * k + 1], pw[4 * k + 2], pw[4 * k + 3]}; const bf16x8 pa = __builtin_bit_cast(bf16x8, pa_);
                const bf16x8 v0 = trpair(img + k * 1024), v1 = trpair(img + 4096 + k * 1024);
                Y0 = __builtin_amdgcn_mfma_f32_32x32x16_bf16(pa, v0, Y0, 0, 0, 0); Y1 = __builtin_amdgcn_mfma_f32_32x32x16_bf16(pa, v1, Y1, 0, 0, 0); }
        }
        f32x16 Z0 = {}, Z1 = {};
        { bf16x8 pf0[4], pf1[4];
#pragma unroll
          for (int st = 0; st < 4; ++st) { pf0[st] = *(const bf16x8*)(prevp + (size_t)r32 * 64 + 16 * st + 8 * hi); pf1[st] = *(const bf16x8*)(prevp + (size_t)(32 + r32) * 64 + 16 * st + 8 * hi); }
          __builtin_amdgcn_sched_barrier(0);
#pragma unroll
          for (int st = 0; st < 4; ++st) { Z0 = __builtin_amdgcn_mfma_f32_32x32x16_bf16(cf[st], pf0[st], Z0, 0, 0, 0); Z1 = __builtin_amdgcn_mfma_f32_32x32x16_bf16(cf[st], pf1[st], Z1, 0, 0, 0); } }
        {   LAS unsigned char* zst = L + C_ST + w * 4096;
#pragma unroll
            for (int i4 = 0; i4 < 4; ++i4) { const int idx = lane + 64 * i4; *(LAS v4u*)(zst + (idx >> 3) * 128 + (idx & 7) * 16) = zreg[i4]; }
            unsigned short xr0[16], xr1[16], zr0[16], zr1[16]; float rdt[16];
#pragma unroll
            for (int gq = 0; gq < 4; ++gq) { const f32x4 d4 = *(const LAS f32x4*)(dtab + hh * 128 + 32 * lb + 8 * gq + 4 * hi);
#pragma unroll
                for (int e = 0; e < 4; ++e) { const int r = 4 * gq + e, ll = crow(r, hi), l = 32 * lb + ll;
                    const LAS unsigned char* xi = L + C_XDT + ((l >> 6) * 4 + hh) * 8192 + vimg_off(l & 63, r32);
                    xr0[r] = *(const LAS unsigned short*)xi; xr1[r] = *(const LAS unsigned short*)(xi + 4096);
                    zr0[r] = *(const LAS unsigned short*)(zst + ll * 128 + r32 * 2); zr1[r] = *(const LAS unsigned short*)(zst + ll * 128 + 64 + r32 * 2);
                    rdt[r] = 1.0f / d4[e]; } }
            float qs[16];
#pragma unroll
            for (int gq = 0; gq < 4; ++gq) { const f32x4 a4 = *(const LAS f32x4*)(atab + hh * 128 + 32 * lb + 8 * gq + 4 * hi);
#pragma unroll
                for (int e = 0; e < 4; ++e) { const int r = 4 * gq + e; const float el = ex2(a4[e]);
                    float y0 = Y0[r] + Z0[r] * el + Dk * rdt[r] * bf2f(xr0[r]), y1 = Y1[r] + Z1[r] * el + Dk * rdt[r] * bf2f(xr1[r]);
                    y0 *= silu_f(bf2f(zr0[r])); y1 *= silu_f(bf2f(zr1[r]));
                    yv[i][0][r] = y0; yv[i][1][r] = y1; qs[r] = y0 * y0 + y1 * y1; } }
            const int lx = lane;
#pragma unroll
            for (int o = 1; o < 32; o <<= 1) {
#pragma unroll
                for (int r = 0; r < 16; ++r) qs[r] += bperm(lx ^ o, qs[r]); }
#pragma unroll
            for (int r = 0; r < 16; ++r) if (r32 == 0) part[hh * 128 + 32 * lb + crow(r, hi)] = qs[r];
        }
    }
    __syncthreads(); STG(2);
    bf16* cat = (bf16*)(ws + WS_CAT);
    const int cc = 256 * g + 64 * hh + r32; const float nw0 = normw[cc], nw1 = normw[cc + 32];
    LAS unsigned char* ost = L + C_ST + w * 4096;
#pragma unroll
    for (int i = 0; i < 2; ++i) { const int lb = i == 0 ? pair : 3 - pair;
#pragma unroll
        for (int r = 0; r < 16; ++r) { const int ll = crow(r, hi), l = 32 * lb + ll; const float tot = (part[l] + part[128 + l]) + (part[256 + l] + part[384 + l]);
            const float rs = 1.0f / sqrtf(tot * (1.f / 256.f) + EPS);
            *(LAS bf16*)(ost + ll * 128 + r32 * 2) = (bf16)f2bf(yv[i][0][r] * rs * nw0); *(LAS bf16*)(ost + ll * 128 + 64 + r32 * 2) = (bf16)f2bf(yv[i][1][r] * rs * nw1); }
#pragma unroll
        for (int i4 = 0; i4 < 4; ++i4) { const int idx = lane + 64 * i4; const v4u v = *(const LAS v4u*)(ost + (idx >> 3) * 128 + (idx & 7) * 16);
            st16_wtg(cat + (size_t)(row0 + 32 * lb + (idx >> 3)) * D + 512 + 256 * g + 64 * hh + 8 * (idx & 7), v); }
    }
    __syncthreads(); STG(3);
}
}

namespace gla {
using att::bf16x8; using att::s16x4; using att::f32x16; using att::vtr; using att::crow; using att::ex2; using att::cvtpk; using att::lg2;
using ssd::vimg_off; using ssd::trpair; using ssd::BKCH;
constexpr int A_GLOW = 0, A_WT = 8192, A_KI = 10240, A_VI = A_KI + 16384, A_GS = A_VI + 32768, A_PRE = A_GS + 32768;
constexpr int C_PART = 0, C_BK = 8192, C_VI = 24832;
static_assert(A_PRE + 2048 + 256 <= 131072 && C_BK + 8 * BKCH <= C_VI && C_VI + 32768 + 8 * 2048 <= 131072, "gla LDS map");
typedef float f32x4v __attribute__((ext_vector_type(4)));
__device__ __forceinline__ void pass_a_unit(LAS unsigned char* L, unsigned char* ws, const float* w2, const float* gb, int b, int h, int c, int tid, bool reuse_glow = false) {
    asm volatile("" : "+v"(tid));
    const int lane = tid & 63, w = __builtin_amdgcn_readfirstlane(tid >> 6), r32 = lane & 31, hi = lane >> 5;
    const int row0 = b * T + c * 128, u = (b * 4 + h) * 64 + c;
    STG_INIT();
    LAS float* glow = (LAS float*)(L + A_GLOW); LAS float* wt = (LAS float*)(L + A_WT);
    if (!reuse_glow) {
        constexpr int WROW = 2064, AROW = 528, G_WG = 10240, G_AST = G_WG + 16 * WROW;
        static_assert(G_AST + 8 * 16 * AROW <= 131072, "gla g_low LDS map");
        const bf16* wgp = (const bf16*)(ws + WS_WCD) + (size_t)3072 * D;
#pragma unroll
        for (int i = 0; i < 4; ++i) { const int idx = tid + 512 * i, r = idx >> 7, pc = idx & 127; *(LAS v4u*)(L + G_WG + r * WROW + pc * 16) = *(const v4u*)(wgp + (size_t)r * D + pc * 8); }
        v4u areg[4][8];
        const bf16* hbw = (const bf16*)(ws + WS_HB) + (size_t)(row0 + 16 * w) * D;
#pragma unroll
        for (int q = 0; q < 4; ++q)
#pragma unroll
            for (int i = 0; i < 8; ++i) { const int idx = lane + 64 * i, r = idx >> 5, pc = idx & 31; areg[q][i] = *(const v4u*)(hbw + (size_t)r * D + q * 256 + pc * 8); }
        __syncthreads();
        LAS unsigned char* al = L + G_AST + w * (16 * AROW);
        const int fr = lane & 15, kq = lane >> 4;
        f32x4v acc = {0.f, 0.f, 0.f, 0.f};
#pragma unroll
        for (int q = 0; q < 4; ++q) {
#pragma unroll
            for (int i = 0; i < 8; ++i) { const int idx = lane + 64 * i, r = idx >> 5, pc = idx & 31; *(LAS v4u*)(al + r * AROW + pc * 16) = areg[q][i]; }
#pragma unroll
            for (int st = 0; st < 8; ++st) { const bf16x8 a = *(const LAS bf16x8*)(al + fr * AROW + (32 * st + 8 * kq) * 2), bb = *(const LAS bf16x8*)(L + G_WG + fr * WROW + (q * 256 + 32 * st + 8 * kq) * 2);
                acc = __builtin_amdgcn_mfma_f32_16x16x32_bf16(a, bb, acc, 0, 0, 0); }
        }
#pragma unroll
        for (int e = 0; e < 4; ++e) { const int s = 16 * w + 4 * (lane >> 4) + e; glow[s * 16 + (lane & 15)] = acc[e] * row_rstd((const float*)(ws + WS_SSQ), row0 + s); }
    }
    __syncthreads(); STG(4);
    {
        const bf16* gv = (const bf16*)(ws + WS_Z);
#pragma unroll
        for (int i = 0; i < 4; ++i) { const int idx = tid + 512 * i, s = idx >> 4, oc = idx & 15;
            *(LAS v4u*)(L + A_VI + ((s >> 6) * 2 + (oc >> 3)) * 8192 + vimg_off(s & 63, (8 * oc) & 63)) = NTL((const v4u*)(gv + (size_t)(row0 + s) * 512 + 128 * h + 8 * oc)); }
    }
    const int k = lane;
    LAS float* gtab = (LAS float*)(L + A_GS); LAS float* pretab = (LAS float*)(L + A_PRE); LAS float* tottab = pretab + 512;
    {   float wc[16];
#pragma unroll
        for (int r = 0; r < 16; ++r) wc[r] = w2[r * 256 + 64 * h + k];
        const float bk = gb[64 * h + k]; float run = 0.f;
#pragma unroll
        for (int i = 0; i < 16; ++i) { const int s = 16 * w + i; float x = bk;
#pragma unroll
            for (int q = 0; q < 4; ++q) { const f32x4v gl4 = *(const LAS f32x4v*)(glow + s * 16 + 4 * q);
#pragma unroll
                for (int e = 0; e < 4; ++e) x += gl4[e] * wc[4 * q + e]; }
            const float la = (fminf(x, 0.f) * LOG2E - lg2(1.f + ex2(-fabsf(x) * LOG2E))) * (1.f / 16.f);
            run += la; gtab[s * 64 + k] = run; }
        wt[w * 64 + k] = run;
    }
    __syncthreads(); STG(5);
    {   float pre = 0.f;
#pragma unroll
        for (int q = 0; q < 8; ++q) { const float t = wt[q * 64 + k]; if (q < w) pre += t; }
        pretab[w * 64 + k] = pre; if (w == 7) tottab[k] = pre + wt[7 * 64 + k];
    }
    __syncthreads();
    {
        bf16* gq = (bf16*)(ws + WS_XBC) + 64 * h; bf16* gk = (bf16*)(ws + WS_XBC + 8 * MiB) + 64 * h;
        v4u qv[2], kv[2];
#pragma unroll
        for (int i = 0; i < 2; ++i) { const int idx = tid + 512 * i, s = idx >> 3, oc = idx & 7; const size_t o = (size_t)(row0 + s) * 256 + 8 * oc; qv[i] = NTL((const v4u*)(gq + o)); kv[i] = NTL((const v4u*)(gk + o)); }
#pragma unroll
        for (int i = 0; i < 2; ++i) { const int idx = tid + 512 * i, s = idx >> 3, oc = idx & 7; const size_t o = (size_t)(row0 + s) * 256 + 8 * oc;
            float qf_[8], kf_[8], gs[8], tt[8], oq[8], ok[8], okk[8];
            ssd::unpack8(qv[i], qf_); ssd::unpack8(kv[i], kf_);
#pragma unroll
            for (int hq = 0; hq < 2; ++hq) { const f32x4v g4 = *(const LAS f32x4v*)(gtab + s * 64 + 8 * oc + 4 * hq), p4 = *(const LAS f32x4v*)(pretab + (s >> 4) * 64 + 8 * oc + 4 * hq), t4 = *(const LAS f32x4v*)(tottab + 8 * oc + 4 * hq);
#pragma unroll
                for (int e = 0; e < 4; ++e) { gs[4 * hq + e] = g4[e] + p4[e]; tt[4 * hq + e] = t4[e]; } }
#pragma unroll
            for (int e = 0; e < 8; ++e) { oq[e] = qf_[e] * ex2(gs[e]); ok[e] = kf_[e] * ex2(-gs[e]); okk[e] = kf_[e] * ex2(tt[e] - gs[e]); }
            st16_wtg(gq + o, ssd::pack8f(oq)); st16_wtg(gk + o, ssd::pack8f(ok));
            *(LAS v4u*)(L + A_KI + (s >> 6) * 8192 + vimg_off(s & 63, 8 * oc)) = ssd::pack8f(okk); }
        if (tid < 64) __hip_atomic_store((float*)(ws + WS_GDEC) + u * 64 + tid, tottab[tid], __ATOMIC_RELAXED, __HIP_MEMORY_SCOPE_AGENT);
    }
    __syncthreads(); STG(6);
    {
        const int vt = w >> 1, kh = w & 1;
        const unsigned vfb = ((lane >> 4) & 1) * 32 + (lane & 3) * 8 + (4 * hi + ((lane & 15) >> 2)) * 64;
        f32x16 acc = {};
#pragma unroll
        for (int ks = 0; ks < 8; ++ks) { const int sh = ks >> 2, k16 = ks & 3;
            const bf16x8 A = trpair(L + A_VI + (sh * 2 + (vt >> 1)) * 8192 + vfb + (vt & 1) * 4096 + k16 * 1024);
            const bf16x8 Bf = trpair(L + A_KI + sh * 8192 + vfb + kh * 4096 + k16 * 1024);
            acc = __builtin_amdgcn_mfma_f32_32x32x16_bf16(A, Bf, acc, 0, 0, 0); }
        float* loc = (float*)(ws + WS_GLOC) + (size_t)u * 8192;
#pragma unroll
        for (int r = 0; r < 16; ++r) __hip_atomic_store(loc + (32 * vt + crow(r, hi)) * 64 + 32 * kh + r32, acc[r], __ATOMIC_RELAXED, __HIP_MEMORY_SCOPE_AGENT);
    }
    __syncthreads(); STG(7);
}
__device__ __forceinline__ void pass_b(unsigned char* ws, int bx, int G, int tid) {
    asm volatile("" : "+v"(tid));
    if (tid >= 128) return;
    typedef float f32x2v __attribute__((ext_vector_type(2)));
    const float* loc = (const float*)(ws + WS_GLOC); const float* gdec = (const float*)(ws + WS_GDEC); bf16* prev = (bf16*)(ws + WS_GPREV);
    { const int e = bx * 256 + 2 * tid; const int bh = e >> 13, vk = e & 8191, k = e & 63; f32x2v S = {0.f, 0.f};
        for (int c0 = 0; c0 < 64; c0 += 32) { f32x2v lv[32], dd[32];
#pragma unroll
            for (int i = 0; i < 32; ++i) { const int u = bh * 64 + c0 + i; lv[i] = NTL((const f32x2v*)(loc + (size_t)u * 8192 + vk)); dd[i] = *(const f32x2v*)(gdec + u * 64 + k); }
#pragma unroll
            for (int i = 0; i < 32; ++i) { const int u = bh * 64 + c0 + i; __hip_atomic_store((unsigned*)(prev + (size_t)u * 8192 + vk), cvtpk(S[0], S[1]), __ATOMIC_RELAXED, __HIP_MEMORY_SCOPE_AGENT); S[0] = S[0] * ex2(dd[i][0]) + lv[i][0]; S[1] = S[1] * ex2(dd[i][1]) + lv[i][1]; } } }
}
__device__ __forceinline__ void pass_c_unit(LAS unsigned char* L, unsigned char* ws, const float* normw, int b, int h, int c, int tid) {
    asm volatile("" : "+v"(tid));
    const int w = __builtin_amdgcn_readfirstlane(tid >> 6);
    const int row0 = b * T + c * 128, u = (b * 4 + h) * 64 + c;
    LAS float* part = (LAS float*)(L + C_PART);
    const bf16* GQ = (const bf16*)(ws + WS_XBC); const bf16* GK = (const bf16*)(ws + WS_XBC + 8 * MiB); const bf16* GV = (const bf16*)(ws + WS_Z);
    {   const int s = tid >> 3, ch = tid & 7;
#pragma unroll
        for (int i = 0; i < 2; ++i) { const int ss = s + 64 * i; *(LAS v4u*)(L + C_BK + ch * BKCH + ss * 16) = NTL((const v4u*)(GK + (size_t)(row0 + ss) * 256 + 64 * h + 8 * ch)); }
#pragma unroll
        for (int i = 0; i < 4; ++i) { const int idx = tid + 512 * i, s2 = idx >> 4, oc = idx & 15;
            *(LAS v4u*)(L + C_VI + ((s2 >> 6) * 2 + (oc >> 3)) * 8192 + vimg_off(s2 & 63, (8 * oc) & 63)) = NTL((const v4u*)(GV + (size_t)(row0 + s2) * 512 + 128 * h + 8 * oc)); }
    }
    __syncthreads();
    asm volatile("" : "+v"(tid));
    const int lane = tid & 63, r32 = lane & 31, hi = lane >> 5;
    const int pair = w & 1, vt = w >> 1;
    const unsigned vfb = ((lane >> 4) & 1) * 32 + (lane & 3) * 8 + (4 * hi + ((lane & 15) >> 2)) * 64;
    const bf16* prevp = (const bf16*)(ws + WS_GPREV) + (size_t)u * 8192 + (size_t)(32 * vt + r32) * 64 + 8 * hi;
    f32x16 O[2];
#pragma unroll
    for (int i = 0; i < 2; ++i) { const int tb = i == 0 ? pair : 3 - pair;
        bf16x8 qf[4];
#pragma unroll
        for (int st = 0; st < 4; ++st) qf[st] = *(const bf16x8*)(GQ + (size_t)(row0 + 32 * tb + r32) * 256 + 64 * h + 16 * st + 8 * hi);
        f32x16 Oa = {};
        for (int sb = 0; sb <= tb; ++sb) {
            f32x16 X = {};
#pragma unroll
            for (int st = 0; st < 4; ++st) { const bf16x8 kf = *(const LAS bf16x8*)(L + C_BK + (2 * st + hi) * BKCH + (32 * sb + r32) * 16); X = __builtin_amdgcn_mfma_f32_32x32x16_bf16(kf, qf[st], X, 0, 0, 0); }
            unsigned pw[8];
            if (sb == tb) {
#pragma unroll
                for (int r = 0; r < 16; ++r) if (crow(r, hi) > r32) X[r] = 0.f; }
#pragma unroll
            for (int q = 0; q < 8; ++q) pw[q] = cvtpk(X[2 * q], X[2 * q + 1]);
            const LAS unsigned char* img = L + C_VI + ((sb >> 1) * 2 + (vt >> 1)) * 8192 + vfb + (vt & 1) * 4096 + (2 * (sb & 1)) * 1024;
#pragma unroll
            for (int kk = 0; kk < 2; ++kk) { const v4u pa_ = {pw[4 * kk], pw[4 * kk + 1], pw[4 * kk + 2], pw[4 * kk + 3]}; const bf16x8 pa = __builtin_bit_cast(bf16x8, pa_);
                Oa = __builtin_amdgcn_mfma_f32_32x32x16_bf16(pa, trpair(img + kk * 1024), Oa, 0, 0, 0); }
        }
        { bf16x8 pf[4];
#pragma unroll
          for (int st = 0; st < 4; ++st) pf[st] = *(const bf16x8*)(prevp + 16 * st);
          __builtin_amdgcn_sched_barrier(0);
#pragma unroll
          for (int st = 0; st < 4; ++st) Oa = __builtin_amdgcn_mfma_f32_32x32x16_bf16(qf[st], pf[st], Oa, 0, 0, 0); }
        O[i] = Oa;
        { float qs[16]; const int lx = lane;
#pragma unroll
          for (int r = 0; r < 16; ++r) qs[r] = Oa[r] * Oa[r];
#pragma unroll
          for (int o = 1; o < 32; o <<= 1) {
#pragma unroll
              for (int r = 0; r < 16; ++r) qs[r] += bperm(lx ^ o, qs[r]); }
#pragma unroll
          for (int r = 0; r < 16; ++r) if (r32 == 0) part[vt * 128 + 32 * tb + crow(r, hi)] = qs[r]; }
    }
    __syncthreads();
    const bf16* GR = (const bf16*)(ws + WS_GR); bf16* cat = (bf16*)(ws + WS_CAT);
    const int v = 32 * vt + r32; const float nw = normw[v];
    LAS unsigned char* st_ = L + C_VI + 32768 + w * 2048;
    v4u grv4[2][2];
#pragma unroll
    for (int i = 0; i < 2; ++i) { const int tb = i == 0 ? pair : 3 - pair;
#pragma unroll
        for (int q = 0; q < 2; ++q) { const int idx = lane + 64 * q; grv4[i][q] = NTL((const v4u*)(GR + (size_t)(row0 + 32 * tb + (idx >> 2)) * 512 + 128 * h + 32 * vt + 8 * (idx & 3))); } }
#pragma unroll
    for (int i = 0; i < 2; ++i) { const int tb = i == 0 ? pair : 3 - pair;
#pragma unroll
        for (int q = 0; q < 2; ++q) { const int idx = lane + 64 * q; *(LAS v4u*)(st_ + (idx >> 2) * 64 + (idx & 3) * 16) = grv4[i][q]; }
        float ov[16];
#pragma unroll
        for (int r = 0; r < 16; ++r) { const int tl = crow(r, hi), t = 32 * tb + tl; const float tot = (part[t] + part[128 + t]) + (part[256 + t] + part[384 + t]);
            const float rs = 1.0f / sqrtf(tot * (1.f / 128.f) + EPS);
            ov[r] = O[i][r] * rs * nw * silu_f(bf2f(*(const LAS unsigned short*)(st_ + tl * 64 + r32 * 2))); }
#pragma unroll
        for (int r = 0; r < 16; ++r) *(LAS bf16*)(st_ + crow(r, hi) * 64 + r32 * 2) = (bf16)f2bf(ov[r]);
#pragma unroll
        for (int q = 0; q < 2; ++q) { const int idx = lane + 64 * q; const v4u o4 = *(const LAS v4u*)(st_ + (idx >> 2) * 64 + (idx & 3) * 16);
            st16_wtg(cat + (size_t)(row0 + 32 * tb + (idx >> 2)) * D + 512 + 128 * h + 32 * vt + 8 * (idx & 3), o4); }
    }
    __syncthreads();
}
}
constexpr int NWAVES = 8;
constexpr int RING_OFF = 0, RING_BYTES = 131072;
constexpr int LDSCTL_OFF = RING_BYTES, MISC_OFF = LDSCTL_OFF + 320;
constexpr int LDS_BYTES = 147456;
constexpr int EPI_RED_OFF = LDSCTL_OFF + 1024;
static_assert(EPI_RED_OFF + 4096 + 1024 <= LDS_BYTES, "LDS map");
constexpr int CW_TMO = 0, CW_BAR = 4096;
constexpr size_t CTL_ZERO_BYTES = 64 * 1024;
static_assert((CW_BAR + 3456) * 4 <= (int)WS_KMAX && WS_KMAX + 512 <= WS_QCTR && WS_QCTR + 16 * 256 <= WS_CNTA && WS_CNTA + 2048 <= WS_FCNT && WS_FCNT + 64 * 256 <= CTL_ZERO_BYTES, "control map");
#ifndef GLA_STAGGER
#define GLA_STAGGER 1
#endif
#ifndef CONV_FIRST
#define CONV_FIRST 1
#endif
#ifndef LATE_WG
#define LATE_WG(bx) ((((bx) >> 3) & 3) == 3)
#endif
#ifndef SSD_STAGGER
#define SSD_STAGGER 1
#endif
#ifndef TWO_LISTS
#define TWO_LISTS 1
#endif
constexpr int PH_PRO = 0, PH_FINAL = 15, N_PHASES = 16;

#ifndef DIAG
#define DIAG 0
#endif
#ifndef DIAG_WAVE
#define DIAG_WAVE 1
#endif
#ifndef DIAG_MODE
#define DIAG_MODE 0
#endif
#ifndef DIAG_MASK_A
#define DIAG_MASK_A 0
#define DIAG_MASK_B 0
#endif
#if DIAG && defined(DIAG_PROBE)
#define PROBE(k) do { if (__builtin_amdgcn_mbcnt_hi(~0u, __builtin_amdgcn_mbcnt_lo(~0u, 0u)) == 0 && wave == 0) { const unsigned long long t_ = rt(); if (blockIdx.x == 0) __hip_atomic_store((unsigned long long*)(ws + WS_TS) + 17 + (k), t_, RLX_AGENT); atomicMax((unsigned long long*)(ws + WS_TS) + 40 + (k), t_); } } while (0)
#else
#define PROBE(k) do {} while (0)
#endif
struct Args { Bufs B; int ph_lo, ph_hi, li, pad; };

__device__ __forceinline__ void p0_transpose_item(const float* W, const float* gain, int K, int Nsrc, int Ndst, int mode, bf16* WT, LAS float* scr, int item, int lane) {
    const int nblk = Ndst / 32, kb = item / nblk, nb = item % nblk, k0 = 64 * kb, n0 = 32 * nb;
    const int n4 = 4 * (lane & 7), ksub = lane >> 3, nn = n0 + n4; const int s = mode == 0 ? nn : (mode == 1 ? src_col_ab(nn) : src_col_cd(nn));
    const float* src = W + (size_t)(k0 + ksub) * Nsrc + (s >= 0 ? s : 0);
    f32x4 v[8];
#pragma unroll
    for (int i = 0; i < 8; ++i) v[i] = __builtin_nontemporal_load((const f32x4*)(src + (size_t)(8 * i) * Nsrc));
    if (gain) {
#pragma unroll
        for (int i = 0; i < 8; ++i) v[i] = v[i] * gain[k0 + 8 * i + ksub]; }
#pragma unroll
    for (int i = 0; i < 8; ++i) { LAS float* d = scr + (8 * i + ksub) * 33 + n4; const f32x4 x = s >= 0 ? v[i] : (f32x4){0.f, 0.f, 0.f, 0.f}; d[0] = x[0]; d[1] = x[1]; d[2] = x[2]; d[3] = x[3]; }
    LDS_WAIT(); asm volatile("" ::: "memory");
    const int c = lane & 7;
#pragma unroll
    for (int j = 0; j < 4; ++j) { const int n = (lane >> 3) + 8 * j; const LAS float* sp = scr + (8 * c) * 33 + n;
        v4u o; o.x = pk2(sp[0 * 33], sp[1 * 33]); o.y = pk2(sp[2 * 33], sp[3 * 33]); o.z = pk2(sp[4 * 33], sp[5 * 33]); o.w = pk2(sp[6 * 33], sp[7 * 33]);
        st16_wtg(WT + (size_t)(n0 + n) * K + k0 + 8 * c, o); }
    LDS_WAIT(); asm volatile("" ::: "memory");
}
__device__ __forceinline__ float wave_sum(float v) { return red64_sum(v); }
constexpr int WI0 = 16 * 96, WI1 = 16 * 32, WI2 = 16 * 128, WI3 = 64 * 32, WI4 = 16 * 104, W_NITEMS = WI0 + WI1 + WI2 + WI3 + WI4 + WI1 + WI2 + WI3;
template <class AP> __device__ __forceinline__ void wconv_item(AP ap, const float* nmix, const float* nmlp, unsigned char* ws, LAS float* scr, int it, int lane) {
    int r = it;
    if (r < WI0) { p0_transpose_item(ap->B.in[I_WAB], nmix, D, AB_IN, NAB, 1, (bf16*)(ws + WS_WAB), scr, r, lane); return; } r -= WI0;
    if (r < WI1) { p0_transpose_item(ap->B.in[I_WOA], nullptr, D, D, D, 0, (bf16*)(ws + WS_WOA), scr, r, lane); return; } r -= WI1;
    if (r < WI2) { p0_transpose_item(ap->B.in[I_WUP], nmlp, D, FF, FF, 0, (bf16*)(ws + WS_WU0), scr, r, lane); return; } r -= WI2;
    if (r < WI3) { p0_transpose_item(ap->B.in[I_WDN], nullptr, FF, D, D, 0, (bf16*)(ws + WS_WD0), scr, r, lane); return; } r -= WI3;
    if (r < WI4) { p0_transpose_item(ap->B.in[I_WCD], nmix + D, D, CD_IN, NCDW, 2, (bf16*)(ws + WS_WCD), scr, r, lane); return; } r -= WI4;
    if (r < WI1) { p0_transpose_item(ap->B.in[I_WOC], nullptr, D, D, D, 0, (bf16*)(ws + WS_WOC), scr, r, lane); return; } r -= WI1;
    if (r < WI2) { p0_transpose_item(ap->B.in[I_WUP] + (size_t)D * FF, nmlp + D, D, FF, FF, 0, (bf16*)(ws + WS_WU1), scr, r, lane); return; } r -= WI2;
    p0_transpose_item(ap->B.in[I_WDN] + (size_t)FF * D, nullptr, FF, D, D, 0, (bf16*)(ws + WS_WD1), scr, r, lane);
}
template <int NB> __device__ __forceinline__ void p0_transpose_batch(const float* W, const float* gain, int K, int Nsrc, int Ndst, int mode, bf16* WT, LAS float* scr, int item, int lane) {
    const int nblk = Ndst / 32, kb = item / nblk, nb0 = item % nblk, k0 = 64 * kb;
    const int n4 = 4 * (lane & 7), ksub = lane >> 3;
    f32x4 v[NB][8]; int sv[NB];
#pragma unroll
    for (int b = 0; b < NB; ++b) { const int nn = 32 * (nb0 + b) + n4; const int s = mode == 0 ? nn : (mode == 1 ? src_col_ab(nn) : src_col_cd(nn)); sv[b] = s;
        const float* src = W + (size_t)(k0 + ksub) * Nsrc + (s >= 0 ? s : 0);
#pragma unroll
        for (int i = 0; i < 8; ++i) v[b][i] = __builtin_nontemporal_load((const f32x4*)(src + (size_t)(8 * i) * Nsrc)); }
    float g[8];
#pragma unroll
    for (int i = 0; i < 8; ++i) g[i] = gain ? gain[k0 + 8 * i + ksub] : 1.f;
    const int c = lane & 7;
#pragma unroll
    for (int b = 0; b < NB; ++b) {
#pragma unroll
        for (int i = 0; i < 8; ++i) { LAS float* d = scr + (8 * i + ksub) * 33 + n4; const f32x4 x = sv[b] >= 0 ? v[b][i] * g[i] : (f32x4){0.f, 0.f, 0.f, 0.f}; d[0] = x[0]; d[1] = x[1]; d[2] = x[2]; d[3] = x[3]; }
        LDS_WAIT(); asm volatile("" ::: "memory");
#pragma unroll
        for (int j = 0; j < 4; ++j) { const int n = (lane >> 3) + 8 * j; const LAS float* sp = scr + (8 * c) * 33 + n;
            v4u o; o.x = pk2(sp[0 * 33], sp[1 * 33]); o.y = pk2(sp[2 * 33], sp[3 * 33]); o.z = pk2(sp[4 * 33], sp[5 * 33]); o.w = pk2(sp[6 * 33], sp[7 * 33]);
            st16_wtg(WT + (size_t)(32 * (nb0 + b) + n) * K + k0 + 8 * c, o); }
        LDS_WAIT(); asm volatile("" ::: "memory"); }
}
template <int NB, class AP> __device__ __forceinline__ void wconv_batch(AP ap, const float* nmix, const float* nmlp, unsigned char* ws, LAS float* scr, int it, int lane) {
    static_assert(WI0 % NB == 0 && WI1 % NB == 0 && WI2 % NB == 0 && WI3 % NB == 0 && WI4 % NB == 0 && (NAB / 32) % NB == 0 && (D / 32) % NB == 0 && (FF / 32) % NB == 0 && (NCDW / 32) % NB == 0, "batch");
    const float* W; const float* gain; int K, Nsrc, Ndst, mode; size_t wo; int r = it;
    if (r < WI0) { W = ap->B.in[I_WAB]; gain = nmix; K = D; Nsrc = AB_IN; Ndst = NAB; mode = 1; wo = WS_WAB; }
    else if ((r -= WI0) < WI1) { W = ap->B.in[I_WOA]; gain = nullptr; K = D; Nsrc = D; Ndst = D; mode = 0; wo = WS_WOA; }
    else if ((r -= WI1) < WI2) { W = ap->B.in[I_WUP]; gain = nmlp; K = D; Nsrc = FF; Ndst = FF; mode = 0; wo = WS_WU0; }
    else if ((r -= WI2) < WI3) { W = ap->B.in[I_WDN]; gain = nullptr; K = FF; Nsrc = D; Ndst = D; mode = 0; wo = WS_WD0; }
    else if ((r -= WI3) < WI4) { W = ap->B.in[I_WCD]; gain = nmix + D; K = D; Nsrc = CD_IN; Ndst = NCDW; mode = 2; wo = WS_WCD; }
    else if ((r -= WI4) < WI1) { W = ap->B.in[I_WOC]; gain = nullptr; K = D; Nsrc = D; Ndst = D; mode = 0; wo = WS_WOC; }
    else if ((r -= WI1) < WI2) { W = ap->B.in[I_WUP] + (size_t)D * FF; gain = nmlp + D; K = D; Nsrc = FF; Ndst = FF; mode = 0; wo = WS_WU1; }
    else { r -= WI2; W = ap->B.in[I_WDN] + (size_t)FF * D; gain = nullptr; K = FF; Nsrc = D; Ndst = D; mode = 0; wo = WS_WD1; }
    p0_transpose_batch<NB>(W, gain, K, Nsrc, Ndst, mode, (bf16*)(ws + wo), scr, r, lane);
}
__device__ __forceinline__ void unit_done_signal(gu32* cnt, int tid) {
    asm volatile("s_waitcnt vmcnt(0)" ::: "memory"); __syncthreads();
    if (tid == 0) __hip_atomic_fetch_add(cnt, 1u, RLX_AGENT);
}
__device__ __forceinline__ void units_wait(gu32* cnt, unsigned want, int tid) {
    if (tid == 0) { unsigned sp = 0u; while (__hip_atomic_load(cnt, RLX_AGENT) < want) { __builtin_amdgcn_s_sleep(4); if (++sp > (1u << 22)) break; }
        __builtin_amdgcn_fence(__ATOMIC_ACQUIRE, "agent"); asm volatile("s_waitcnt vmcnt(0)" ::: "memory"); }
    __syncthreads();
}
#ifndef PANEL_SEAMS
#define PANEL_SEAMS 0
#endif
constexpr size_t WS_PCNT = 8 * 1024;
__device__ __forceinline__ void panel_barrier(gu32* cnt, unsigned want, int tid) {
    asm volatile("s_waitcnt vmcnt(0)" ::: "memory"); __syncthreads();
    if (tid == 0) {
        __builtin_amdgcn_fence(__ATOMIC_RELEASE, "agent"); asm volatile("s_waitcnt vmcnt(0)" ::: "memory");
        __hip_atomic_fetch_add(cnt, 1u, RLX_AGENT);
        unsigned sp = 0u; while (__hip_atomic_load(cnt, RLX_AGENT) < want) { __builtin_amdgcn_s_sleep(2); if (++sp > (1u << 22)) break; }
        __builtin_amdgcn_fence(__ATOMIC_ACQUIRE, "agent"); asm volatile("s_waitcnt vmcnt(0)" ::: "memory");
    }
    __syncthreads();
}

__global__ void __launch_bounds__(NWAVES * 64, 2) mk_fwd(Args a) {
    extern __shared__ __attribute__((aligned(16))) unsigned char lds[];
    LAS unsigned char* L = (LAS unsigned char*)lds;
    const int tid = threadIdx.x, wave0 = __builtin_amdgcn_readfirstlane(tid >> 6);
    unsigned char* ws0 = a.B.ws;
    for (int u = tid; u < (LDS_BYTES - LDSCTL_OFF) / 4; u += NWAVES * 64) ((LAS unsigned*)(L + LDSCTL_OFF))[u] = 0u;
    __syncthreads();
    XcdBarrier bar = xcd_barrier_post((unsigned*)(ws0 + WS_CTL) + CW_BAR + a.li * XCD_BAR_WORDS, (volatile LAS unsigned*)(L + MISC_OFF) + 8);

#if DIAG
    if (blockIdx.x == 0 && tid == 0) __hip_atomic_store((unsigned long long*)(ws0 + WS_TS), rt(), RLX_AGENT);
#endif
    for (int ph = a.ph_lo; ph < a.ph_hi; ++ph) {
        int lane_p = __builtin_amdgcn_mbcnt_hi(~0u, __builtin_amdgcn_mbcnt_lo(~0u, 0u)); asm volatile("" : "+v"(lane_p));
        typedef const __attribute__((address_space(4))) Args* KArgPtr;
        KArgPtr ap = (KArgPtr)__builtin_amdgcn_kernarg_segment_ptr(); asm volatile("" : "+s"(ap));
        unsigned char* ws = ap->B.ws;
        int bx_p = blockIdx.x, G = gridDim.x, wave = wave0; asm volatile("" : "+s"(bx_p), "+s"(G), "+s"(wave));
        const int gw = bx_p * NWAVES + wave, NGW = G * NWAVES;
        if (ph == PH_PRO) {
            LAS float* scr = (LAS float*)(L + RING_OFF + wave * 16384);
            constexpr int I0 = WI0;
            const float* nmix = ap->B.in[I_NMIX]; const float* nmlp = ap->B.in[I_NMLP];
            for (int it = gw; it < I0; it += NGW) wconv_item(ap, nmix, nmlp, ws, scr, it, lane_p);
            for (int m = gw; m < M; m += 2 * NGW) {
                const int m1 = m + NGW < M ? m + NGW : m;
                const GAS f32x4* xr0 = (const GAS f32x4*)(ap->B.in[I_X] + (size_t)m * D) + lane_p; const GAS f32x4* xr1 = (const GAS f32x4*)(ap->B.in[I_X] + (size_t)m1 * D) + lane_p;
                f32x4 v0[4], v1[4];
#pragma unroll
                for (int j = 0; j < 4; ++j) { v0[j] = __builtin_nontemporal_load(xr0 + 64 * j); v1[j] = __builtin_nontemporal_load(xr1 + 64 * j); }
#pragma unroll
                for (int q = 0; q < 2; ++q) { const int mm = q ? m1 : m; if (q && m1 == m) break;
                    GAS unsigned long long* o8 = (GAS unsigned long long*)((bf16*)(ws + WS_HB) + (size_t)mm * D) + lane_p; float sq = 0.f;
#pragma unroll
                    for (int j = 0; j < 4; ++j) { const f32x4 v = q ? v1[j] : v0[j]; sq += (v.x * v.x + v.y * v.y) + (v.z * v.z + v.w * v.w);
                        __hip_atomic_store((unsigned long long*)(o8 + 64 * j), (unsigned long long)pk2(v.x, v.y) | ((unsigned long long)pk2(v.z, v.w) << 32), RLX_AGENT); }
                    sq = wave_sum(sq);
                    if (lane_p < 4) ((float*)(ws + WS_SSQ))[(size_t)mm * 4 + lane_p] = lane_p == 0 ? sq : 0.f; }
            }
        } else if (ph == PH_FINAL) {
            const float* w = ap->B.in[I_NFIN];
            for (int m = gw; m < M; m += NGW) {
                GAS f32x4* hr = (GAS f32x4*)(ap->B.h + (size_t)m * D) + lane_p; f32x4 v[4]; float s = 0.f;
#pragma unroll
                for (int j = 0; j < 4; ++j) { v[j] = hr[64 * j]; s += (v[j].x * v[j].x + v[j].y * v[j].y) + (v[j].z * v[j].z + v[j].w * v[j].w); }
                const float r = 1.0f / sqrtf(wave_sum(s) * (1.f / D) + EPS);
#pragma unroll
                for (int j = 0; j < 4; ++j) { const f32x4 g = *((const f32x4*)w + lane_p + 64 * j); hr[64 * j] = v[j] * r * g; }
            }
        } else {
            const int layer = (ph - 1) / 7, kind = (ph - 1) % 7;
            if (kind == 2) {
#if DIAG
                if (blockIdx.x == 0 && __builtin_amdgcn_mbcnt_hi(~0u, __builtin_amdgcn_mbcnt_lo(~0u, 0u)) == 0 && wave == 0) __hip_atomic_store((unsigned long long*)(ws0 + WS_TS) + ph + 1, rt(), RLX_AGENT);
#endif
                continue; }
            if (kind == 0) {
                pg8::StaticOrder S;
                if (layer == 0) { pg8::Gemm g{(const bf16*)(ws + WS_HB), (const bf16*)(ws + WS_WAB), M, NAB, D}; S.init(M, NAB, G, bx_p);
                    pg8::EpiProj<0> E{ws, (const float*)(ws + WS_SSQ), (LAS float*)(L + EPI_RED_OFF)}; pg8::gemm_phase<pg8::EpiProj<0>, pg8::StaticOrder, true, true>(L + RING_OFF, g, S, E, (wave << 6) | lane_p); }
                else { pg8::Gemm g{(const bf16*)(ws + WS_HB), (const bf16*)(ws + WS_WCD), M, NCD, D}; S.init(M, NCD, G, bx_p);
                    pg8::EpiProj<1> E{ws, (const float*)(ws + WS_SSQ), (LAS float*)(L + EPI_RED_OFF)}; pg8::gemm_phase<pg8::EpiProj<1>, pg8::StaticOrder, true, true>(L + RING_OFF, g, S, E, (wave << 6) | lane_p); }
            } else if (kind == 1) {
                if (layer == 0) PROBE(0);
                int tid_p = (wave << 6) | lane_p; asm volatile("" : "+v"(tid_p));
                bool ssd_late = false;
                const bool gla_grp = (G & 15) == 0;
                int gla_at = (layer == 1) ? ((!gla_grp || ((bx_p >> 3) & 1) == 0) ? 0 : -1) : -1, q_it = 0;
#define GLA_A_STATIC() do { unsigned ndone = 0u;        \
                    if (gla_grp) { const int si_ = (bx_p & 7) + 8 * (bx_p >> 4), ns_ = G >> 1; \
                        for (int j_ = si_; j_ < 128; j_ += ns_) for (int h_ = 0; h_ < 4; ++h_) { if (ndone) __syncthreads(); gla::pass_a_unit(L, ws, ap->B.in[I_GW2], ap->B.in[I_GB], j_ >> 6, h_, j_ & 63, tid_p, h_ > 0); ++ndone; } } \
                    else for (int u = bx_p; u < 512; u += G) { if (ndone) __syncthreads(); gla::pass_a_unit(L, ws, ap->B.in[I_GW2], ap->B.in[I_GB], u >> 8, (u >> 6) & 3, u & 63, tid_p); ++ndone; } \
                    asm volatile("s_waitcnt vmcnt(0)" ::: "memory"); __syncthreads(); \
                    if (tid_p == 0 && ndone) __hip_atomic_fetch_add((gu32*)(ws + WS_CNTA) + 64, ndone, RLX_AGENT); gla_at = -1; } while (0)
                if (gla_at == 0) GLA_A_STATIC();
                if (layer == 1) PROBE(6);
                if (layer == 0) {
                    for (int u = bx_p; u < 256; u += G) { ssd::fl_unit(L, ws, ap->B.in[I_FBIAS], u >> 7, (u >> 6) & 1, u & 63, tid_p); unit_done_signal((gu32*)(ws + WS_CNTA) + 128, tid_p); }
                    PROBE(1);
#define SSD_A_STATIC() do { for (int v_ = bx_p; v_ < 256; v_ += G) { ssd::pass_a_unit(L, ws, ap->B.in[I_CONVW], ap->B.in[I_CONVB], ap->B.in[I_DTB], ap->B.in[I_ALOG], v_ >> 7, (v_ >> 6) & 1, v_ & 63, tid_p); \
                        unit_done_signal((gu32*)(ws + WS_CNTA), tid_p); } ssd_late = false; } while (0)
                    ssd_late = SSD_STAGGER && ((bx_p >> 3) & 1) && !LATE_WG(bx_p);
                    if (!ssd_late) SSD_A_STATIC();
                    units_wait((gu32*)(ws + WS_CNTA) + 128, 256u, tid_p);
                    PROBE(2);
                    if (CONV_FIRST && LATE_WG(bx_p)) {
                        LAS float* scr = (LAS float*)(L + RING_OFF + wave * 16384); gu32* wq = (gu32*)(ws + WS_QCTR) + 64 * 15;
                        for (;;) { unsigned i0 = 0u; if (lane_p == 0) i0 = __hip_atomic_fetch_add(wq, 4u, RLX_AGENT); i0 = __builtin_amdgcn_readfirstlane(i0) + WI0;
                            if (i0 >= (unsigned)W_NITEMS) break;
                            wconv_batch<4>(ap, ap->B.in[I_NMIX], ap->B.in[I_NMLP], ws, scr, (int)i0, lane_p); }
                    }
                }
                unsigned order = 0x76543210u;
                if (layer == 0) { order = 0u; const float* fbp = ap->B.in[I_FBIAS];
                    for (int hh = 0; hh < 8; ++hh) { const float bv = fbp[hh]; int rk = 0;
                        for (int h2 = 0; h2 < 8; ++h2) { const float b2 = fbp[h2]; rk += (b2 > bv || (b2 == bv && h2 < hh)) ? 1 : 0; }
                        order |= (unsigned)hh << (4 * rk); } }
                gu32* qc = (gu32*)(ws + WS_QCTR) + 64 * ph; gu32* qc1 = qc + 64;
                const unsigned n0 = (TWO_LISTS && layer == 0) ? 256u : 0u, n1 = 768u - n0; const bool typeB = !(TWO_LISTS && layer == 0) || LATE_WG(bx_p);
#define Q_GRAB(dst) do { unsigned r_; if (typeB) { r_ = __hip_atomic_fetch_add(qc1, 1u, RLX_AGENT); if (r_ < n1) dst = n0 + r_; else { r_ = n0 ? __hip_atomic_fetch_add(qc, 1u, RLX_AGENT) : n0; dst = r_ < n0 ? r_ : 0xFFFFFFFFu; } } \
                            else { r_ = __hip_atomic_fetch_add(qc, 1u, RLX_AGENT); if (r_ < n0) dst = r_; else { r_ = __hip_atomic_fetch_add(qc1, 1u, RLX_AGENT); dst = r_ < n1 ? n0 + r_ : 0xFFFFFFFFu; } } } while (0)
                volatile LAS unsigned* qslot = (volatile LAS unsigned*)(L + MISC_OFF) + 24;
                unsigned nxt = 0u; if (tid_p == 0) Q_GRAB(nxt);
                for (;;) {
                    if (gla_at >= 0 && q_it >= gla_at) { __syncthreads(); GLA_A_STATIC(); }
                    if (ssd_late && q_it >= 1) { __syncthreads(); SSD_A_STATIC(); }
                    ++q_it;
                    if (tid_p == 0) *qslot = nxt;
                    __syncthreads();
                    unsigned u = __builtin_amdgcn_readfirstlane(*qslot);
                    const unsigned nun = 512u;
                    if (u >= nun + 256u) break;
                    if (tid_p == 0) Q_GRAB(nxt);
                    if (u >= nun) {
                        units_wait((gu32*)(ws + WS_CNTA) + 64 * layer, layer ? 512u : 256u, tid_p);
                        if (layer == 0) ssd::pass_b(ws, (int)(u - nun), G, tid_p); else gla::pass_b(ws, (int)(u - nun), G, tid_p);
                        continue; }
                    const int rk = u >> 6, rem = u & 63, qb = 31 - (rem >> 1), bb = rem & 1, hh = (order >> (4 * rk)) & 7;
                    if (layer == 0) att::attn_unit<0>(L, ws, ap->B.in[I_FBIAS], (const float*)(ws + WS_KMAX), bb, hh, qb, tid_p);
                    else att::attn_unit<1>(L, ws, nullptr, nullptr, bb, hh, qb, tid_p);
                }
                if (gla_at >= 0) { __syncthreads(); GLA_A_STATIC(); }
                if (ssd_late) { __syncthreads(); SSD_A_STATIC(); }
                if (layer == 0) PROBE(3); else PROBE(7);
                if (layer == 0) PROBE(4); else PROBE(8);
                if (layer == 0 && (!CONV_FIRST || G <= 24)) {
                    LAS float* scr = (LAS float*)(L + RING_OFF + wave * 16384); gu32* wq = (gu32*)(ws + WS_QCTR) + 64 * 15;
                    const float* nmix = ap->B.in[I_NMIX]; const float* nmlp = ap->B.in[I_NMLP];
                    for (;;) { unsigned i0 = 0u; if (lane_p == 0) i0 = __hip_atomic_fetch_add(wq, 4u, RLX_AGENT); i0 = __builtin_amdgcn_readfirstlane(i0) + WI0;
                        if (i0 >= (unsigned)W_NITEMS) break;
                        for (unsigned q = 0; q < 4u && i0 + q < (unsigned)W_NITEMS; ++q) wconv_item(ap, nmix, nmlp, ws, scr, (int)(i0 + q), lane_p); }
                }
                if (layer == 0) PROBE(5);
            } else if (kind == 3 && layer == 1) {
                int tid_p = (wave << 6) | lane_p; asm volatile("" : "+v"(tid_p));
                for (int u = bx_p; u < 512; u += G) gla::pass_c_unit(L, ws, ap->B.in[I_GLAN], u >> 8, (u >> 6) & 3, u & 63, tid_p);
            } else if (kind == 3 && layer == 0) {
                int tid_p = (wave << 6) | lane_p; asm volatile("" : "+v"(tid_p));
                for (int u = bx_p; u < 256; u += G) ssd::pass_c_unit(L, ws, ap->B.in[I_SSD_D], ap->B.in[I_SSDN], u >> 7, (u >> 6) & 1, u & 63, tid_p);
            } else if (kind == 4 || kind == 6) {
                const bf16* A = kind == 4 ? (const bf16*)(ws + WS_CAT) : (const bf16*)(ws + WS_U);
                const bf16* Bt = (const bf16*)(ws + (kind == 4 ? (layer ? WS_WOC : WS_WOA) : (layer ? WS_WD1 : WS_WD0)));
                pg8::Gemm g{A, Bt, M, D, kind == 4 ? D : FF}; pg8::StaticOrder S; S.init(M, D, G, bx_p);
                if (ph == 14) {
                    pg8::EpiFinal E{(const bf16*)(ws + WS_HB), ap->B.h, ap->B.in[I_NFIN], (float*)(ws + WS_XBUF), (unsigned*)(ws + WS_FCNT), (LAS float*)(L + EPI_RED_OFF)};
                    pg8::gemm_phase<pg8::EpiFinal, pg8::StaticOrder, true, true>(L + RING_OFF, g, S, E, (wave << 6) | lane_p);
                } else {
                pg8::EpiRes E{(bf16*)(ws + WS_HB), (float*)(ws + WS_SSQ), (LAS float*)(L + EPI_RED_OFF)};
                pg8::gemm_phase<pg8::EpiRes, pg8::StaticOrder, true, true>(L + RING_OFF, g, S, E, (wave << 6) | lane_p);
                }
            } else if (kind == 5) {
                pg8::Gemm g{(const bf16*)(ws + WS_HB), (const bf16*)(ws + (layer ? WS_WU1 : WS_WU0)), M, FF, D}; pg8::StaticOrder S; S.init(M, FF, G, bx_p);
                pg8::EpiUp E{(bf16*)(ws + WS_U), (const float*)(ws + WS_SSQ), (LAS float*)(L + EPI_RED_OFF)};
                pg8::gemm_phase<pg8::EpiUp, pg8::StaticOrder, true, true>(L + RING_OFF, g, S, E, (wave << 6) | lane_p);
            }
        }
        if (PANEL_SEAMS && G == 256 && ((((PANEL_SEAMS) >> ph) & 1) != 0)) {
            const int panel = 8 * (bx_p & 7) + ((bx_p >> 3) & 7);
            panel_barrier((gu32*)(ws + WS_PCNT) + 16 * panel, ph == 5 ? 4u : ph == 6 ? 8u : ph == 12 ? 12u : 16u, (wave << 6) | lane_p);
        } else
        if (DIAG || ph + 1 < a.ph_hi) { XcdBarrier bl = bar; asm volatile("" : "+s"(bl.bar), "+s"(bl.x)); xcd_barrier(bl); }
#if DIAG
        if (blockIdx.x == 0 && __builtin_amdgcn_mbcnt_hi(~0u, __builtin_amdgcn_mbcnt_lo(~0u, 0u)) == 0 && wave == 0) __hip_atomic_store((unsigned long long*)(ws0 + WS_TS) + ph + 1, rt(), RLX_AGENT);
#endif
    }
#if DIAG
    {
        XcdBarrier bl = bar; xcd_barrier(bl);
        float ta = 0.f, tb = 0.f;
        for (int ph = 0; ph < 30; ++ph) { if (ph == 16) continue; const unsigned long long t0 = __hip_atomic_load((unsigned long long*)(ws0 + WS_TS) + ph, RLX_AGENT), t1 = __hip_atomic_load((unsigned long long*)(ws0 + WS_TS) + ph + 1, RLX_AGENT);
            const float d = (float)(t1 - t0); if ((DIAG_MASK_A >> ph) & 1) ta += d; if ((DIAG_MASK_B >> ph) & 1) tb += d; }
        if (DIAG_MASK_B == 0x40000000u) tb = 200.f * (float)__hip_atomic_load((unsigned*)(ws0 + WS_TS) + 100, RLX_AGENT);
        if ((DIAG_MASK_B & 0xFFFFFFF0u) == 0x60000000u) { const float n_ = (float)__hip_atomic_load((unsigned long long*)(ws0 + WS_TS) + 62, RLX_AGENT), a_ = (float)__hip_atomic_load((unsigned long long*)(ws0 + WS_TS) + 60, RLX_AGENT), b_ = (float)__hip_atomic_load((unsigned long long*)(ws0 + WS_TS) + 61, RLX_AGENT);
            const float c_ = (float)__hip_atomic_load((unsigned long long*)(ws0 + WS_TS) + 63, RLX_AGENT); tb = ((DIAG_MASK_B & 3) == 0 ? a_ : (DIAG_MASK_B & 3) == 1 ? b_ : (DIAG_MASK_B & 3) == 2 ? a_ + b_ : c_) / fmaxf(n_, 1.f) * 2.f; }
        if ((DIAG_MASK_B & 0xFFFFFFF0u) == 0x80000000u) tb = (float)(__hip_atomic_load((unsigned long long*)(ws0 + WS_TS) + 40 + (DIAG_MASK_B & 15), RLX_AGENT) - __hip_atomic_load((unsigned long long*)(ws0 + WS_TS) + ((DIAG_MASK_B & 15) >= 6 ? 9 : 2), RLX_AGENT));
        if ((DIAG_MASK_B & 0xFFFFFFF0u) == 0x70000000u) tb = 0.1f * (float)__hip_atomic_load((unsigned long long*)(ws0 + WS_TS) + 64 + (DIAG_MASK_B & 15), RLX_AGENT);
        if ((DIAG_MASK_B & 0xFFFFFFF0u) == 0x50000000u) tb = 0.1f * (float)__hip_atomic_load((unsigned long long*)(ws0 + WS_TS) + 60 + (DIAG_MASK_B & 3), RLX_AGENT);
        const float sc = 1.f + ta * 1e-6f; const int lane = __builtin_amdgcn_mbcnt_hi(~0u, __builtin_amdgcn_mbcnt_lo(~0u, 0u));
        LAS unsigned* tk = (LAS unsigned*)(L + MISC_OFF) + 16; int wv = 0; if (lane == 0) wv = (int)atomicAdd((unsigned*)tk, 1u); wv = __builtin_amdgcn_readfirstlane(wv);
        const int gw = blockIdx.x * NWAVES + wv, NGW = gridDim.x * NWAVES;
        for (int m = gw; m < M; m += NGW) { GAS f32x4* hr = (GAS f32x4*)(a.B.h + (size_t)m * D) + lane;
#pragma unroll
            for (int j = 0; j < 4; ++j) { f32x4 v = hr[64 * j] * sc; if (m == 0 && lane == 0 && j == 0) v.x += tb * 5e-4f; hr[64 * j] = v; } }
    }
#endif
}
static int g_grid = 0;
static void launch_mk(const Bufs& B, int lo, int hi, int li, hipStream_t stream) {
    Args a{}; a.B = B; a.ph_lo = lo; a.ph_hi = hi; a.li = li; a.pad = 0;
    hipLaunchKernelGGL(mk_fwd, dim3(g_grid), dim3(NWAVES * 64), LDS_BYTES, stream, a);
}
extern "C" void kernel_launch(void* const* d_in, const int* in_sizes, int n_in, void* d_out, int out_size, void* d_ws, size_t ws_size, hipStream_t stream) {
    if (n_in != 20 || out_size != M * D || ws_size < WS_END) { fprintf(stderr, "kernel_launch: unexpected shapes n_in %d out %d ws %zu\n", n_in, out_size, ws_size); return; }
    if (g_grid == 0) {
        int dev = 0, cus = 0, per_cu = 0;
        if (hipGetDevice(&dev) != hipSuccess || hipDeviceGetAttribute(&cus, hipDeviceAttributeMultiprocessorCount, dev) != hipSuccess) { g_grid = -1; return; }
        if (hipFuncSetAttribute((const void*)mk_fwd, hipFuncAttributeMaxDynamicSharedMemorySize, LDS_BYTES) != hipSuccess) { fprintf(stderr, "hipFuncSetAttribute failed\n"); g_grid = -1; return; }
        if (hipOccupancyMaxActiveBlocksPerMultiprocessor(&per_cu, (const void*)mk_fwd, NWAVES * 64, LDS_BYTES) != hipSuccess || per_cu < 1) fprintf(stderr, "occupancy query says %d\n", per_cu);
        (void)hipGetLastError();
        g_grid = cus;
    }
    if (g_grid < 0) return;
    Bufs B{};
    for (int i = 0; i < 20; ++i) B.in[i] = (const float*)d_in[i];
    B.h = (float*)d_out; B.ws = (unsigned char*)d_ws;
    hipMemsetAsync((char*)d_ws + WS_CTL, 0, DIAG ? (size_t)(1u << 20) : CTL_ZERO_BYTES, stream);
    launch_mk(B, 0, 15, 0, stream);
}
```
